# Optimizing an MI355X kernel written in HIP

```python
import jax, jax.numpy as jnp
from jax import lax
import numpy as np

D_MODEL = 1024
BATCH = 32
SEQ = 256
DEPTH = 2
DEC_BATCH = 2
DEC_SEQ = 2048
PAST_LEN = 256

GRID_W = 64
HEAD_DIM = 64
N_MOD = 9
D_FF = 2816
FFN_RES = 0.5
H_A = 8
NA_ROWS = 8
NA_COLS = 16
NA_KEY_COLS = 2 * NA_COLS
C_B = 512
CONV_W = 3
C_POOL = 512
POOL_WINDOWS = (2, 4, 8, 16)
N_POOL = 4
HQ_D = 8
HKV_D = 2
GQA_GROUP = HQ_D // HKV_D
ROPE_BASE = 10000.0
Q_BLOCK = 128
N_EVEN = (DEPTH + 1) // 2
N_ODD = DEPTH // 2
EVEN_IN = 3 * H_A * HEAD_DIM + 3 * C_B
EVEN_MIX = H_A * HEAD_DIM + C_B
ODD_IN = C_POOL + (HQ_D + 2 * HKV_D) * HEAD_DIM
ODD_MIX = C_POOL + HQ_D * HEAD_DIM
RMS_EPS = 1e-6
NEG_INF = -1e30

kernel_name = "hybrid_diffusion_prefix_trunk_step"


def rms_norm(x, g):
    xf = x.astype(jnp.float32)
    y = xf * lax.rsqrt(jnp.mean(xf * xf, axis=-1, keepdims=True) + RMS_EPS)
    return (y * g.astype(jnp.float32)).astype(x.dtype)


def modulate_norm(x, g, shift, scale):
    return rms_norm(x, g) * (1.0 + scale[:, None, :]) + shift[:, None, :]


def split_heads(t, n_heads):
    b, l, _ = t.shape
    return t.reshape(b, l, n_heads, HEAD_DIM).transpose(0, 2, 1, 3)


def merge_heads(t):
    b, h, l, d = t.shape
    return t.transpose(0, 2, 1, 3).reshape(b, l, h * d)


def swiglu(h, w1, w2):
    g, u = jnp.split(h @ w1, 2, axis=-1)
    return (jax.nn.silu(g) * u) @ w2


def axial_rope_tables(n_tokens):
    t = jnp.arange(n_tokens)
    row = (t // GRID_W).astype(jnp.float32)
    col = (t % GRID_W).astype(jnp.float32)
    n_freq = HEAD_DIM // 4
    inv = ROPE_BASE ** (-jnp.arange(n_freq, dtype=jnp.float32) / n_freq)
    ang = jnp.concatenate([row[:, None] * inv, col[:, None] * inv], axis=-1)
    return jnp.cos(ang), jnp.sin(ang)


def apply_rope(x, cos, sin):
    xr = x.astype(jnp.float32).reshape(*x.shape[:-1], HEAD_DIM // 2, 2)
    x0, x1 = xr[..., 0], xr[..., 1]
    out = jnp.stack([x0 * cos - x1 * sin, x0 * sin + x1 * cos], axis=-1)
    return out.reshape(x.shape).astype(x.dtype)


def dense_attention(q, k, v):
    b, hkv, g, lq, d = q.shape
    nb = lq // Q_BLOCK
    qb = q.reshape(b, hkv, g, nb, Q_BLOCK, d).transpose(3, 0, 1, 2, 4, 5)
    scale = HEAD_DIM ** -0.5

    def one_block(qi):
        s = jnp.einsum('bhgqd,bhkd->bhgqk', qi, k).astype(jnp.float32) * scale
        p = jax.nn.softmax(s, axis=-1).astype(v.dtype)
        return jnp.einsum('bhgqk,bhkd->bhgqd', p, v)

    o = lax.map(one_block, qb)
    return o.transpose(1, 2, 3, 0, 4, 5).reshape(b, hkv, g, lq, d)


def neighbourhood_attention(q, k, v, ck, cv, rpb):
    b, h, l, d = q.shape
    rows = l // GRID_W
    kr = min(NA_ROWS, rows)
    ncb = GRID_W // NA_COLS
    r = jnp.arange(rows)
    rs = jnp.clip(r - kr // 2, 0, rows - kr)
    rows_idx = rs[:, None] + jnp.arange(kr)[None, :]
    cq = jnp.arange(GRID_W).reshape(ncb, NA_COLS)
    cs_q = jnp.clip(cq - NA_COLS // 2, 0, GRID_W - NA_COLS)
    kb0 = jnp.clip(jnp.arange(ncb) * NA_COLS - NA_COLS // 2, 0, GRID_W - NA_KEY_COLS)
    cols_idx = kb0[:, None] + jnp.arange(NA_KEY_COLS)[None, :]
    kg = k.reshape(b, h, rows, GRID_W, d)
    vg = v.reshape(b, h, rows, GRID_W, d)
    ridx = rows_idx[:, None, :, None]
    cidx = cols_idx[None, :, None, :]
    kb = kg[:, :, ridx, cidx].reshape(b, h, rows, ncb, kr * NA_KEY_COLS, d)
    vb = vg[:, :, ridx, cidx].reshape(b, h, rows, ncb, kr * NA_KEY_COLS, d)
    kcol = cols_idx[:, None, :]
    valid = (kcol >= cs_q[..., None]) & (kcol < cs_q[..., None] + NA_COLS)
    col_off = jnp.clip(kcol - cq[..., None] + NA_COLS - 1, 0, 2 * NA_COLS - 2)
    row_off = rows_idx - r[:, None] + NA_ROWS - 1
    bias = rpb.astype(jnp.float32)[:, row_off[:, None, None, :, None], col_off[None, :, :, None, :]]
    bias = jnp.where(valid[None, None, :, :, None, :], bias, NEG_INF)
    bias = bias.reshape(h, rows, ncb, NA_COLS, kr * NA_KEY_COLS)
    qg = q.reshape(b, h, rows, ncb, NA_COLS, d)
    scale = HEAD_DIM ** -0.5
    s_loc = jnp.einsum('bhrjqd,bhrjkd->bhrjqk', qg, kb).astype(jnp.float32) * scale + bias[None]
    s_ctx = jnp.einsum('bhrjqd,bhkd->bhrjqk', qg, ck).astype(jnp.float32) * scale
    p = jax.nn.softmax(jnp.concatenate([s_loc, s_ctx], axis=-1), axis=-1).astype(v.dtype)
    n_loc = kr * NA_KEY_COLS
    o = (jnp.einsum('bhrjqk,bhrjkd->bhrjqd', p[..., :n_loc], vb)
         + jnp.einsum('bhrjqk,bhkd->bhrjqd', p[..., n_loc:], cv))
    return o.reshape(b, h, l, d)


def short_conv(x, w, bias):
    l = x.shape[1]
    pad = CONV_W // 2
    xp = jnp.pad(x, ((0, 0), (pad, CONV_W - 1 - pad), (0, 0)))
    y = xp[:, 0:l] * w[0]
    for j in range(1, CONV_W):
        y = y + xp[:, j:j + l] * w[j]
    return y + bias


def window_mean(csum, l, win):
    t = jnp.arange(l)
    lo = jnp.maximum(t - win // 2, 0)
    hi = jnp.minimum(t + win - win // 2, l)
    return (csum[:, hi] - csum[:, lo]) / (hi - lo).astype(jnp.float32)[None, :, None]


def even_mixer(h, w_in, rpb, conv_w, conv_b, w_out, ctx_kv):
    u = h @ w_in
    qa, ka, va, bg, cg, xb = jnp.split(u, 6, axis=-1)
    qa, ka, va = split_heads(qa, H_A), split_heads(ka, H_A), split_heads(va, H_A)
    if ctx_kv is None:
        a = dense_attention(qa[:, :, None], ka, va)[:, :, 0]
        new_kv = (ka, va)
    else:
        a = neighbourhood_attention(qa, ka, va, ctx_kv[0], ctx_kv[1], rpb)
        new_kv = None
    y_b = bg * short_conv(cg * xb, conv_w, conv_b)
    out = jnp.concatenate([merge_heads(a), y_b], axis=-1) @ w_out
    return out, new_kv


def odd_mixer(h, w_in, pool_w, pool_scale, q_norm, k_norm, w_out, ctx_kv):
    b, l, _ = h.shape
    u = h @ w_in
    uc, qd, kd, vd = jnp.split(u, [C_POOL, C_POOL + HQ_D * HEAD_DIM, C_POOL + (HQ_D + HKV_D) * HEAD_DIM], axis=-1)
    ug = uc.reshape(b, l, N_POOL, C_POOL // N_POOL)
    csum = jnp.concatenate([jnp.zeros_like(ug[:, :1], dtype=jnp.float32),
                            jnp.cumsum(ug.astype(jnp.float32), axis=1)], axis=1)
    pooled = jnp.stack([window_mean(csum[:, :, gi], l, w) for gi, w in enumerate(POOL_WINDOWS)], axis=2)
    pooled = (pooled - ug.astype(jnp.float32)).astype(h.dtype)
    yc = jnp.einsum('blgc,gce->blge', pooled, pool_w).reshape(b, l, C_POOL) * pool_scale
    q = rms_norm(split_heads(qd, HQ_D), q_norm)
    k = rms_norm(split_heads(kd, HKV_D), k_norm)
    v = split_heads(vd, HKV_D)
    if ctx_kv is None:
        k_all, v_all = k, v
        new_kv = (k, v)
    else:
        cos, sin = axial_rope_tables(l)
        q = apply_rope(q, cos, sin)
        k_all = jnp.concatenate([apply_rope(k, cos, sin), ctx_kv[0]], axis=2)
        v_all = jnp.concatenate([v, ctx_kv[1]], axis=2)
        new_kv = None
    o = dense_attention(q.reshape(b, HKV_D, GQA_GROUP, l, HEAD_DIM), k_all, v_all).reshape(b, HQ_D, l, HEAD_DIM)
    out = jnp.concatenate([yc, merge_heads(o)], axis=-1) @ w_out
    return out, new_kv


def trunk(x, cond, cache, mod_w, mod_b, norm_w, ffn_w1, ffn_w2,
          ev_w_in, ev_rpb, ev_conv_w, ev_conv_b, ev_w_out,
          od_w_in, od_pool_w, od_pool_scale, od_q_norm, od_k_norm, od_w_out):
    a_ks, a_vs, d_ks, d_vs = [], [], [], []
    for l in range(DEPTH):
        m = (jax.nn.silu(cond) @ mod_w[l] + mod_b[l]).reshape(cond.shape[0], N_MOD, D_MODEL)
        g = norm_w[l]
        hf = modulate_norm(x, g[0], m[:, 0], m[:, 1])
        x = x + FFN_RES * m[:, 2, None] * rms_norm(swiglu(hf, ffn_w1[l, 0], ffn_w2[l, 0]), g[1])
        hm = modulate_norm(x, g[2], m[:, 3], m[:, 4])
        i = l // 2
        if l % 2 == 0:
            ctx = None if cache is None else (cache[0][:, i], cache[1][:, i])
            out, kv = even_mixer(hm, ev_w_in[i], ev_rpb[i], ev_conv_w[i], ev_conv_b[i], ev_w_out[i], ctx)
            if kv is not None:
                a_ks.append(kv[0])
                a_vs.append(kv[1])
        else:
            ctx = None if cache is None else (cache[2][:, i], cache[3][:, i])
            out, kv = odd_mixer(hm, od_w_in[i], od_pool_w[i], od_pool_scale[i], od_q_norm[i], od_k_norm[i],
                                od_w_out[i], ctx)
            if kv is not None:
                d_ks.append(kv[0])
                d_vs.append(kv[1])
        x = x + m[:, 5, None] * rms_norm(out, g[3])
        hf = modulate_norm(x, g[4], m[:, 6], m[:, 7])
        x = x + FFN_RES * m[:, 8, None] * rms_norm(swiglu(hf, ffn_w1[l, 1], ffn_w2[l, 1]), g[5])
    return x, (a_ks, a_vs, d_ks, d_vs)


def setup_inputs(seed: int = 0) -> dict:
    key = jax.random.key(seed)
    ks = jax.random.split(key, 32)
    D = D_MODEL

    def nrm(k, shape, s):
        return jax.random.normal(k, shape, jnp.float32) * s

    return {
        "x_prompt": nrm(ks[0], (BATCH, SEQ, D), 1.0),
        "x_sample": nrm(ks[1], (DEC_BATCH, DEC_SEQ, D), 1.0),
        "cache_a_k": nrm(ks[2], (DEC_BATCH, N_EVEN, H_A, PAST_LEN, HEAD_DIM), 1.0),
        "cache_a_v": nrm(ks[3], (DEC_BATCH, N_EVEN, H_A, PAST_LEN, HEAD_DIM), 1.0),
        "cache_d_k": nrm(ks[4], (DEC_BATCH, N_ODD, HKV_D, PAST_LEN, HEAD_DIM), 1.0),
        "cache_d_v": nrm(ks[5], (DEC_BATCH, N_ODD, HKV_D, PAST_LEN, HEAD_DIM), 1.0),
        "c": nrm(ks[6], (DEC_BATCH, D), 1.0),
        "c_ctx": nrm(ks[7], (D,), 1.0),
        "mod_w": nrm(ks[8], (DEPTH, D, N_MOD * D), 0.5 * D ** -0.5),
        "mod_b": nrm(ks[9], (DEPTH, N_MOD * D), 0.01),
        "norm_w": 1.0 + nrm(ks[10], (DEPTH, 6, D), 0.05),
        "ffn_w1": nrm(ks[11], (DEPTH, 2, D, 2 * D_FF), D ** -0.5),
        "ffn_w2": nrm(ks[12], (DEPTH, 2, D_FF, D), D_FF ** -0.5),
        "ev_w_in": nrm(ks[13], (N_EVEN, D, EVEN_IN), D ** -0.5),
        "ev_rpb": nrm(ks[14], (N_EVEN, H_A, 2 * NA_ROWS - 1, 2 * NA_COLS - 1), 0.1),
        "ev_conv_w": nrm(ks[15], (N_EVEN, CONV_W, C_B), CONV_W ** -0.5),
        "ev_conv_b": nrm(ks[16], (N_EVEN, C_B), 0.01),
        "ev_w_out": nrm(ks[17], (N_EVEN, EVEN_MIX, D), EVEN_MIX ** -0.5),
        "od_w_in": nrm(ks[18], (N_ODD, D, ODD_IN), D ** -0.5),
        "od_pool_w": nrm(ks[19], (N_ODD, N_POOL, C_POOL // N_POOL, C_POOL // N_POOL), (C_POOL // N_POOL) ** -0.5),
        "od_pool_scale": 1.0 + nrm(ks[20], (N_ODD, C_POOL), 0.05),
        "od_q_norm": 1.0 + nrm(ks[21], (N_ODD, HEAD_DIM), 0.05),
        "od_k_norm": 1.0 + nrm(ks[22], (N_ODD, HEAD_DIM), 0.05),
        "od_w_out": nrm(ks[23], (N_ODD, ODD_MIX, D), ODD_MIX ** -0.5),
    }


def reference(x_prompt, x_sample, cache_a_k, cache_a_v, cache_d_k, cache_d_v, c, c_ctx,
              mod_w, mod_b, norm_w, ffn_w1, ffn_w2,
              ev_w_in, ev_rpb, ev_conv_w, ev_conv_b, ev_w_out,
              od_w_in, od_pool_w, od_pool_scale, od_q_norm, od_k_norm, od_w_out):
    weights = (mod_w, mod_b, norm_w, ffn_w1, ffn_w2,
               ev_w_in, ev_rpb, ev_conv_w, ev_conv_b, ev_w_out,
               od_w_in, od_pool_w, od_pool_scale, od_q_norm, od_k_norm, od_w_out)
    y_prompt, (a_ks, a_vs, d_ks, d_vs) = trunk(x_prompt, c_ctx[None, :], None, *weights)
    state_a_k = jnp.stack(a_ks, axis=1)
    state_a_v = jnp.stack(a_vs, axis=1)
    state_d_k = jnp.stack(d_ks, axis=1)
    state_d_v = jnp.stack(d_vs, axis=1)
    y_sample, _ = trunk(x_sample, c, (cache_a_k, cache_a_v, cache_d_k, cache_d_v), *weights)
    return (y_prompt, y_sample, state_a_k, state_a_v, state_d_k, state_d_v)
```

```cpp
#include <hip/hip_runtime.h>
#include <hip/hip_cooperative_groups.h>
#include <cstdio>
namespace cg = cooperative_groups;

typedef unsigned short u16;
using bf16x8 = __attribute__((ext_vector_type(8))) short;
using s16x4  = __attribute__((ext_vector_type(4))) short;
using f32x16 = __attribute__((ext_vector_type(16))) float;
#define DI __device__ __forceinline__
#define MFMA(a, b, c) __builtin_amdgcn_mfma_f32_32x32x16_bf16((a), (b), (c), 0, 0, 0)

constexpr int MTOK = 12288;
constexpr int MPR  = 8192;
constexpr int DM   = 1024;
constexpr int DFF  = 2816;
constexpr int NTHR = 512;
constexpr int LDS_BYTES = 131072;
constexpr int SROW = 72;

constexpr size_t OFF_SAK = 12582912, OFF_SAV = 16777216, OFF_SDK = 20971520, OFF_SDV = 22020096;

struct P {
  const float *x_prompt, *x_sample, *cache_a_k, *cache_a_v, *cache_d_k, *cache_d_v, *c, *c_ctx;
  const float *mod_w, *mod_b, *norm_w, *ffn_w1, *ffn_w2, *ev_w_in, *ev_rpb, *ev_conv_w, *ev_conv_b, *ev_w_out;
  const float *od_w_in, *od_pool_w, *od_pool_scale, *od_q_norm, *od_k_norm, *od_w_out;
  float* out;
  u16 *W1T, *W2T, *EVIN, *EVOUT, *ODIN, *ODOUT, *POOLW, *CAK, *CAVT, *CDK, *CDVT, *H, *ACTU, *VT, *KF;
  float *MOD, *X, *T;
  unsigned* BAR;
};
struct PA {
  const float* in[24];
  float* out;
  char* ws;
};
constexpr size_t al256(size_t b) { return (b + 255) & ~(size_t)255; }
constexpr size_t WO_W1T = 0;
constexpr size_t WO_W2T = WO_W1T + al256((size_t)4 * 5632 * 1024 * 2);
constexpr size_t WO_EVIN = WO_W2T + al256((size_t)4 * 1024 * 2816 * 2);
constexpr size_t WO_EVOUT = WO_EVIN + al256((size_t)3072 * 1024 * 2);
constexpr size_t WO_ODIN = WO_EVOUT + al256((size_t)1024 * 1024 * 2);
constexpr size_t WO_ODOUT = WO_ODIN + al256((size_t)1280 * 1024 * 2);
constexpr size_t WO_POOLW = WO_ODOUT + al256((size_t)1024 * 1024 * 2);
constexpr size_t WO_CAK = WO_POOLW + al256((size_t)512 * 512 * 2);
constexpr size_t WO_CAVT = WO_CAK + al256((size_t)262144 * 2);
constexpr size_t WO_CDK = WO_CAVT + al256((size_t)262144 * 2);
constexpr size_t WO_CDVT = WO_CDK + al256((size_t)65536 * 2);
constexpr size_t WO_H = WO_CDVT + al256((size_t)65536 * 2);
constexpr size_t WO_ACTU = WO_H + al256((size_t)12288 * 1024 * 2);
constexpr size_t WO_VT = WO_ACTU + al256((size_t)12288 * 3072 * 2);
constexpr size_t WO_MOD = WO_VT + al256((size_t)512 * 12288 * 2);
constexpr size_t WO_X = WO_MOD + al256((size_t)2 * 3 * 9216 * 4);
constexpr size_t WO_T = WO_X + al256((size_t)12288 * 1024 * 4);
constexpr size_t WO_BAR = WO_T + al256((size_t)12288 * 1024 * 4);
constexpr size_t WO_KF = WO_BAR + al256((size_t)3456 * 4);
constexpr size_t WO_END = WO_KF + al256((size_t)512 * 12288 * 2);

DI u16 f2bf(float x) { unsigned u = __float_as_uint(x); u += 0x7fffu + ((u >> 16) & 1u); return (u16)(u >> 16); }
DI float bf2f(u16 v) { return __uint_as_float(((unsigned)v) << 16); }
DI unsigned pack2(float a, float b) { unsigned r; asm("v_cvt_pk_bf16_f32 %0, %1, %2" : "=v"(r) : "v"(a), "v"(b)); return r; }
DI float wave_sum(float v) {
#pragma unroll
  for (int o = 32; o > 0; o >>= 1) v += __shfl_xor(v, o);
  return v;
}
DI float bflo(unsigned u) { return __uint_as_float(u << 16); }
DI float bfhi(unsigned u) { return __uint_as_float(u & 0xffff0000u); }

__device__ void mod_item(const P& p, int it, char* smem, int tidx) {
  float* sS = (float*)smem;
  float* red = sS + 3072;
  const int tid = tidx;
  const int l = it / 144, n0 = (it % 144) * 64;
  for (int i = tid; i < 3072; i += 256) {
    int r = i >> 10, k = i & 1023;
    float v = r == 0 ? p.c_ctx[k] : p.c[(r - 1) * 1024 + k];
    sS[i] = v / (1.f + expf(-v));
  }
  __syncthreads();
  const int kq = tid >> 4, cq = tid & 15;
  const float* w = p.mod_w + (size_t)l * 1024 * 9216 + (size_t)(kq * 64) * 9216 + n0 + cq * 4;
  float a00 = 0, a01 = 0, a02 = 0, a03 = 0, a10 = 0, a11 = 0, a12 = 0, a13 = 0, a20 = 0, a21 = 0, a22 = 0, a23 = 0;
#pragma unroll 1
  for (int k0 = 0; k0 < 64; k0 += 8) {
    float4 wv[8];
#pragma unroll
    for (int k = 0; k < 8; ++k) wv[k] = *(const float4*)(w + (size_t)(k0 + k) * 9216);
#pragma unroll
    for (int k = 0; k < 8; ++k) {
      float4 w4 = wv[k];
      float s0 = sS[kq * 64 + k0 + k], s1 = sS[1024 + kq * 64 + k0 + k], s2 = sS[2048 + kq * 64 + k0 + k];
      a00 += s0 * w4.x; a01 += s0 * w4.y; a02 += s0 * w4.z; a03 += s0 * w4.w;
      a10 += s1 * w4.x; a11 += s1 * w4.y; a12 += s1 * w4.z; a13 += s1 * w4.w;
      a20 += s2 * w4.x; a21 += s2 * w4.y; a22 += s2 * w4.z; a23 += s2 * w4.w;
    }
  }
  float* r0 = red + (kq * 3 + 0) * 64 + cq * 4;
  r0[0] = a00; r0[1] = a01; r0[2] = a02; r0[3] = a03;
  r0[64] = a10; r0[65] = a11; r0[66] = a12; r0[67] = a13;
  r0[128] = a20; r0[129] = a21; r0[130] = a22; r0[131] = a23;
  __syncthreads();
  if (tid < 192) {
    int r = tid >> 6, n = tid & 63;
    float s = p.mod_b[l * 9216 + n0 + n];
#pragma unroll
    for (int q = 0; q < 16; ++q) s += red[(q * 3 + r) * 64 + n];
    p.MOD[(l * 3 + r) * 9216 + n0 + n] = s;
  }
  __syncthreads();
}

struct TrItem { const float* src; u16* dst; int N, Kd, k0, n0, perm; };
DI TrItem tr_decode(const P& p, int idx) {
  TrItem t; t.perm = 0; int kt, nt;
  if (idx < 2816) { int mat = idx / 704, r = idx % 704; kt = r / 44; nt = r % 44; t.src = p.ffn_w1 + (size_t)mat * 1024 * 5632; t.N = 5632; t.Kd = 1024; t.dst = p.W1T + (size_t)mat * 5632 * 1024; t.perm = 1; }
  else if (idx < 4224) { int r0 = idx - 2816; int mat = r0 / 352, r = r0 % 352; kt = r / 8; nt = r % 8; t.src = p.ffn_w2 + (size_t)mat * 2816 * 1024; t.N = 1024; t.Kd = 2816; t.dst = p.W2T + (size_t)mat * 1024 * 2816; }
  else if (idx < 4608) { int r = idx - 4224; kt = r / 24; nt = r % 24; t.src = p.ev_w_in; t.N = 3072; t.Kd = 1024; t.dst = p.EVIN; }
  else if (idx < 4736) { int r = idx - 4608; kt = r / 8; nt = r % 8; t.src = p.ev_w_out; t.N = 1024; t.Kd = 1024; t.dst = p.EVOUT; }
  else if (idx < 4896) { int r = idx - 4736; kt = r / 10; nt = r % 10; t.src = p.od_w_in; t.N = 1280; t.Kd = 1024; t.dst = p.ODIN; }
  else if (idx < 5024) { int r = idx - 4896; kt = r / 8; nt = r % 8; t.src = p.od_w_out; t.N = 1024; t.Kd = 1024; t.dst = p.ODOUT; }
  else { int r = idx - 5024; int mat = r >> 1; kt = r & 1; nt = 0; t.src = p.od_pool_w + mat * 16384; t.N = 128; t.Kd = 512; t.dst = p.POOLW + (size_t)(mat * 128) * 512 + mat * 128; }
  t.k0 = kt * 64; t.n0 = nt * 128;
  return t;
}

__device__ void prep_phase(const P& p, char* smem_all, int bid, int G, int tid512, int part) {
  constexpr int N_MOD = 288, N_TR = 5032, N_CC = 448;
  const int half = tid512 >> 8, tid = tid512 & 255;
  char* smem = smem_all + half * 36864;
  if (part == 0) for (int pi = bid; pi < N_MOD / 2; pi += G) mod_item(p, 2 * pi + half, smem, tid);
  if (part == 1) {
    float* tl = (float*)smem;
    const int r = tid >> 5, c4 = (tid & 31) * 4;
    float4 v[8];
    int tp = bid;
    TrItem cur{};
    if (tp < N_TR / 2) {
      cur = tr_decode(p, 2 * tp + half);
      const float* sp = cur.src + (size_t)(cur.k0 + r) * cur.N + cur.n0 + c4;
#pragma unroll
      for (int q = 0; q < 8; ++q) v[q] = *(const float4*)(sp + (size_t)(8 * q) * cur.N);
    }
    for (; tp < N_TR / 2; tp += G) {
      float* tpp = tl + r * 129 + c4;
#pragma unroll
      for (int q = 0; q < 8; ++q) { tpp[q * 8 * 129] = v[q].x; tpp[q * 8 * 129 + 1] = v[q].y; tpp[q * 8 * 129 + 2] = v[q].z; tpp[q * 8 * 129 + 3] = v[q].w; }
      __syncthreads();
      const TrItem me = cur;
      if (tp + G < N_TR / 2) {
        cur = tr_decode(p, 2 * (tp + G) + half);
        const float* sp = cur.src + (size_t)(cur.k0 + r) * cur.N + cur.n0 + c4;
#pragma unroll
        for (int q = 0; q < 8; ++q) v[q] = *(const float4*)(sp + (size_t)(8 * q) * cur.N);
      }
#pragma unroll
      for (int q = 0; q < 4; ++q) {
        int nn = (tid >> 3) + 32 * q, kc = tid & 7;
        int n = me.n0 + nn, nd = n;
        if (me.perm) nd = n < DFF ? ((n >> 5) * 64 + (n & 31)) : ((((n - DFF) >> 5) * 64) + 32 + ((n - DFF) & 31));
        const float* t = tl + (kc * 8) * 129 + nn;
        uint4 o;
        o.x = pack2(t[0], t[129]); o.y = pack2(t[258], t[387]); o.z = pack2(t[516], t[645]); o.w = pack2(t[774], t[903]);
        *(uint4*)(me.dst + (size_t)nd * me.Kd + me.k0 + kc * 8) = o;
      }
      __syncthreads();
    }
  }
  if (part == 0) for (int pi = bid; pi < N_CC / 2; pi += G) {
    const int idx = 2 * pi + half;
    {
      int e0 = idx * 2048 + tid * 8;
#pragma unroll
      for (int j = 0; j < 8; ++j) {
        int e = e0 + j;
        if (e < 589824 && (e < 262144 || e >= 524288)) {
          const bool isA = e < 262144; const int q = isA ? e : e - 524288;
          const int x = q & 7, ln = (q >> 3) & 63, sub = (q >> 9) & 3, T = (q >> 11) & 7, bh = q >> 14;
          const int key = T * 32 + (ln & 31), d = sub * 16 + (ln >> 5) * 8 + x;
          const float v = (isA ? p.cache_a_k : p.cache_d_k)[(bh * 256 + key) * 64 + d];
          (isA ? p.CAK : p.CDK)[q] = f2bf(v);
        } else if (e < 655360) {
          const bool isA = e < 524288; const int q = isA ? e - 262144 : e - 589824;
          const int x = q & 7, ln = (q >> 3) & 63, sub = (q >> 9) & 3, T = (q >> 11) & 7, bh = q >> 14;
          const int dim = (sub >> 1) * 32 + (ln & 31), key = T * 32 + 16 * (sub & 1) + 8 * (x >> 2) + 4 * (ln >> 5) + (x & 3);
          const float v = (isA ? p.cache_a_v : p.cache_d_v)[(bh * 256 + key) * 64 + dim];
          (isA ? p.CAVT : p.CDVT)[q] = f2bf(v);
        }
        else { int q = e - 655360; int n = q >> 9, k = q & 511; if ((n >> 7) != (k >> 7)) p.POOLW[q] = 0; }
      }
    }
  }
}

template <int RMODE>
__device__ void r_phase(const P& p, bool first_unused, bool hasT_unused, const float* gT, const float* modg, int gate_idx, float gscale,
                        bool writeH, const float* g2, const float* modn, int shift_idx, int scale_idx, float* xdst, int gw, int W, int tidx) {
  const int lane = tidx & 63;
  constexpr bool first = RMODE == 0, hasT = RMODE != 0;
  constexpr int NR = 6;
  for (int t0 = gw; t0 < MTOK; t0 += NR * W) {
    float4 xf[NR][4];
    uint2 xq[NR][4], tq[NR][4];
#pragma unroll
    for (int r = 0; r < NR; ++r) {
      const int t = t0 + r * W;
      if (t < MTOK) {
        if (first) {
          const float* xs = t < MPR ? p.x_prompt + (size_t)t * DM : p.x_sample + (size_t)(t - MPR) * DM;
#pragma unroll
          for (int j = 0; j < 4; ++j) xf[r][j] = *(const float4*)(xs + lane * 4 + 256 * j);
        } else {
          const u16* xs = (const u16*)p.X + (size_t)t * DM;
          const u16* ts = (const u16*)p.T + (size_t)t * DM;
#pragma unroll
          for (int j = 0; j < 4; ++j) { xq[r][j] = *(const uint2*)(xs + lane * 4 + 256 * j); tq[r][j] = *(const uint2*)(ts + lane * 4 + 256 * j); }
        }
      }
    }
#pragma unroll
    for (int r = 0; r < NR; ++r) {
      const int t = t0 + r * W;
      if (t < MTOK) {
        const int ci = t < MPR ? 0 : 1 + ((t - MPR) >> 11);
        float4 x[4];
        if (first) {
#pragma unroll
          for (int j = 0; j < 4; ++j) x[j] = xf[r][j];
        } else {
#pragma unroll
          for (int j = 0; j < 4; ++j) x[j] = make_float4(bflo(xq[r][j].x), bfhi(xq[r][j].x), bflo(xq[r][j].y), bfhi(xq[r][j].y));
        }
        if (hasT) {
          float4 tv[4];
          float ss = 0.f;
#pragma unroll
          for (int j = 0; j < 4; ++j) {
            tv[j] = make_float4(bflo(tq[r][j].x), bfhi(tq[r][j].x), bflo(tq[r][j].y), bfhi(tq[r][j].y));
            ss += tv[j].x * tv[j].x + tv[j].y * tv[j].y + tv[j].z * tv[j].z + tv[j].w * tv[j].w;
          }
          ss = wave_sum(ss);
          const float rs = rsqrtf(ss * (1.f / 1024.f) + 1e-6f) * gscale;
          const float* mg = modg + ci * 9216 + gate_idx * 1024;
#pragma unroll
          for (int j = 0; j < 4; ++j) {
            int c = lane * 4 + 256 * j;
            float4 g4 = *(const float4*)(gT + c), m4 = *(const float4*)(mg + c);
            x[j].x += m4.x * (tv[j].x * rs * g4.x); x[j].y += m4.y * (tv[j].y * rs * g4.y);
            x[j].z += m4.z * (tv[j].z * rs * g4.z); x[j].w += m4.w * (tv[j].w * rs * g4.w);
          }
        }
        if (RMODE == 2) {
#pragma unroll
          for (int j = 0; j < 4; ++j) *(float4*)(xdst + (size_t)t * DM + lane * 4 + 256 * j) = x[j];
        } else {
#pragma unroll
          for (int j = 0; j < 4; ++j) {
            uint2 o; o.x = pack2(x[j].x, x[j].y); o.y = pack2(x[j].z, x[j].w);
            *(uint2*)((u16*)xdst + (size_t)t * DM + lane * 4 + 256 * j) = o;
          }
          float ss = 0.f;
#pragma unroll
          for (int j = 0; j < 4; ++j) ss += x[j].x * x[j].x + x[j].y * x[j].y + x[j].z * x[j].z + x[j].w * x[j].w;
          ss = wave_sum(ss);
          const float r2 = rsqrtf(ss * (1.f / 1024.f) + 1e-6f);
          const float* sh = modn + ci * 9216 + shift_idx * 1024;
          const float* sc = modn + ci * 9216 + scale_idx * 1024;
#pragma unroll
          for (int j = 0; j < 4; ++j) {
            int c = lane * 4 + 256 * j;
            float4 g4 = *(const float4*)(g2 + c), s4 = *(const float4*)(sc + c), h4 = *(const float4*)(sh + c);
            float h0 = x[j].x * r2 * g4.x * (1.f + s4.x) + h4.x;
            float h1 = x[j].y * r2 * g4.y * (1.f + s4.y) + h4.y;
            float h2 = x[j].z * r2 * g4.z * (1.f + s4.z) + h4.z;
            float h3 = x[j].w * r2 * g4.w * (1.f + s4.w) + h4.w;
            uint2 o; o.x = pack2(h0, h1); o.y = pack2(h2, h3);
            *(uint2*)(p.H + (size_t)t * DM + c) = o;
          }
        }
      }
    }
  }
}

enum { EPI_SWIGLU = 0, EPI_F32 = 1, EPI_EVIN = 2, EPI_ODIN = 3, EPI_POOL = 4 };
using f32x4 = __attribute__((ext_vector_type(4))) float;

DI int lds_byte2(int r, int c) {
  int st = (r >> 4) * 2 + (c >> 5), ob = (r & 15) * 64 + (c & 31) * 2;
  return st * 1024 + (ob ^ (((ob >> 9) & 1) << 5));
}
DI void stage_rc2(int b, int& R, int& C) {
  int st = b >> 10, sb = b & 1023, swz = sb ^ (((sb >> 9) & 1) << 5);
  R = (st >> 1) * 16 + (swz >> 6);
  C = (st & 1) * 32 + ((swz & 63) >> 1);
}
#define WAIT_V0() asm volatile("s_waitcnt vmcnt(0)" ::: "memory")

#define LDS_RD4(a, b, c, d, addr, o0, o1, o2, o3) asm volatile( \
    "ds_read_b128 %0, %4 offset:%5\n\tds_read_b128 %1, %4 offset:%6\n\tds_read_b128 %2, %4 offset:%7\n\tds_read_b128 %3, %4 offset:%8\n\ts_waitcnt lgkmcnt(0)" \
    : "=&v"(a), "=&v"(b), "=&v"(c), "=&v"(d) : "v"(addr), "n"(o0), "n"(o1), "n"(o2), "n"(o3) : "memory")
template <int EPI, int MF, bool TAIL = false>
__device__ __forceinline__ void gemm_phase(const P& p, const u16* __restrict__ A, const u16* __restrict__ Bt, int K,
                                           int nMT, int nNT, void* outp, int ldc, char* smem, int vbid, int G, int tidx, int tlimit = 1 << 30, int tbase = 0) {
  constexpr int TILE_B = 32768, STAGE_B = 65536;
  const int wid = __builtin_amdgcn_readfirstlane(tidx >> 6), lane = tidx & 63, wr = wid >> 2, wc = wid & 3, fr = lane & 15, fq = lane >> 4;
  int sOff0;
  { int R, C; stage_rc2(wid * 1024 + lane * 16, R, C); sOff0 = R * K + C; }
  const unsigned sOffB = (unsigned)sOff0 * 2u;
  const int aOff0 = lds_byte2(wr * (16 * MF) + fr, fq * 8);
  const int bOff0 = lds_byte2(wc * 64 + fr, fq * 8);
  const int ntiles = TAIL ? tlimit : min(nMT * nNT, tlimit), nt = K >> 6;
#define GLDS_STAGE(AB, BB, buf, kt) do { _Pragma("unroll") for (int i = 0; i < 4; ++i) { \
      if (wid + 8 * i < 4 * MF) __builtin_amdgcn_global_load_lds((const unsigned*)((const char*)((AB) + (size_t)(i * 64) * K + (kt) * 64) + sOffB), (unsigned*)(smem + (buf) * STAGE_B + wid * 1024 + i * 8192), 16, 0, 0); \
      __builtin_amdgcn_global_load_lds((const unsigned*)((const char*)((BB) + (size_t)(i * 64) * K + (kt) * 64) + sOffB), (unsigned*)(smem + (buf) * STAGE_B + TILE_B + wid * 1024 + i * 8192), 16, 0, 0); } } while (0)
#define TILE_COORDS(T, BR, BC) do { const int ts_ = TAIL ? tbase + ((T) >> 1) : (T); \
      const int grp_ = ts_ / (8 * nNT), r2_ = ts_ - grp_ * 8 * nNT; \
      BR = (grp_ * 8 + (r2_ & 7)) * (TAIL ? 192 : 32 * MF) + (TAIL ? ((T) & 1) * 96 : 0); BC = (r2_ >> 3) * 256; } while (0)
  if (vbid < ntiles) {
    int br_, bc_; TILE_COORDS(vbid, br_, bc_);
    GLDS_STAGE(A + (size_t)br_ * K, Bt + (size_t)bc_ * K, 0, 0);
  }
  for (int tile = vbid; tile < ntiles; tile += G) {
    int brow, bcol; TILE_COORDS(tile, brow, bcol);
    const u16* Ab = A + (size_t)brow * K;
    const u16* Bb = Bt + (size_t)bcol * K;
    f32x4 acc[MF][4];
#pragma unroll
    for (int m = 0; m < MF; ++m)
#pragma unroll
      for (int n = 0; n < 4; ++n) { acc[m][n][0] = 0.f; acc[m][n][1] = 0.f; acc[m][n][2] = 0.f; acc[m][n][3] = 0.f; }
#define LDS_RD(dst, base, off) asm volatile("ds_read_b128 %0, %1 offset:%2" : "=v"(dst) : "v"(base), "n"(off))
    bf16x8 A0[MF], B0[4], A1[MF], B1[4];
    const unsigned lbase = (unsigned)(size_t)(smem);
    WAIT_V0(); __syncthreads();
    if (nt > 1) GLDS_STAGE(Ab, Bb, 1, 1);
    asm volatile("s_waitcnt lgkmcnt(0)" ::: "memory");
    {
      const unsigned la = lbase + aOff0, lb = lbase + TILE_B + bOff0;
#pragma unroll
      for (int n = 0; n < 4; ++n) LDS_RD(B0[n], lb, n * 2048);
#pragma unroll
      for (int m = 0; m < MF; ++m) LDS_RD(A0[m], la, m * 2048);
    }
    for (int t = 0; t < nt; ++t) {
      const int cur = t & 1;
      const unsigned la = lbase + cur * STAGE_B + aOff0, lb = lbase + cur * STAGE_B + TILE_B + bOff0;
      const unsigned lan = lbase + (cur ^ 1) * STAGE_B + aOff0, lbn = lbase + (cur ^ 1) * STAGE_B + TILE_B + bOff0;
#pragma unroll
      for (int n = 0; n < 4; ++n) LDS_RD(B1[n], lb, n * 2048 + 1024);
#pragma unroll
      for (int m = 0; m < MF; ++m) LDS_RD(A1[m], la, m * 2048 + 1024);
      __builtin_amdgcn_sched_barrier(0);
#pragma unroll
      for (int m = 0; m < MF; ++m) {
        if (m == 0) asm volatile("s_waitcnt lgkmcnt(%5)" : "+v"(A0[0]), "+v"(B0[0]), "+v"(B0[1]), "+v"(B0[2]), "+v"(B0[3]) : "n"(4 + MF + MF - 1));
        else asm volatile("s_waitcnt lgkmcnt(%1)" : "+v"(A0[m]) : "n"(4 + MF + MF - 1 - m));
#pragma unroll
        for (int n = 0; n < 4; ++n) acc[m][n] = __builtin_amdgcn_mfma_f32_16x16x32_bf16(A0[m], B0[n], acc[m][n], 0, 0, 0);
        __builtin_amdgcn_sched_barrier(0);
      }
      if (MF == 3) asm volatile("s_waitcnt lgkmcnt(0)" : "+v"(A1[0]), "+v"(A1[1]), "+v"(A1[MF - 1]), "+v"(B1[0]), "+v"(B1[1]), "+v"(B1[2]), "+v"(B1[3]));
      else if (MF == 6) asm volatile("s_waitcnt lgkmcnt(0)" : "+v"(A1[0]), "+v"(A1[1]), "+v"(A1[2]), "+v"(A1[3]), "+v"(A1[4]), "+v"(A1[MF - 1]), "+v"(B1[0]), "+v"(B1[1]), "+v"(B1[2]), "+v"(B1[3]));
      else asm volatile("s_waitcnt lgkmcnt(0)" : "+v"(A1[0]), "+v"(A1[1]), "+v"(A1[2]), "+v"(A1[3]), "+v"(A1[4]), "+v"(A1[5]), "+v"(A1[MF - 2]), "+v"(A1[MF - 1]), "+v"(B1[0]), "+v"(B1[1]), "+v"(B1[2]), "+v"(B1[3]));
      WAIT_V0(); __syncthreads();
      if (t + 2 < nt) { GLDS_STAGE(Ab, Bb, cur, t + 2); }
      else if (t + 1 == nt && tile + G < ntiles) {
        int br_, bc_; TILE_COORDS(tile + G, br_, bc_);
        GLDS_STAGE(A + (size_t)br_ * K, Bt + (size_t)bc_ * K, 0, 0);
      }
      if (t + 1 < nt) {
#pragma unroll
        for (int n = 0; n < 4; ++n) LDS_RD(B0[n], lbn, n * 2048);
#pragma unroll
        for (int m = 0; m < MF; ++m) LDS_RD(A0[m], lan, m * 2048);
      }
      __builtin_amdgcn_sched_barrier(0);
#pragma unroll
      for (int m = 0; m < MF; ++m) {
#pragma unroll
        for (int n = 0; n < 4; ++n) acc[m][n] = __builtin_amdgcn_mfma_f32_16x16x32_bf16(A1[m], B1[n], acc[m][n], 0, 0, 0);
      }
      __builtin_amdgcn_sched_barrier(0);
    }
#undef LDS_RD
    int le = lane; asm volatile("" : "+v"(le));
    const int fre = le & 15, fqe = le >> 4;
    float* Ew = (float*)(smem + STAGE_B + wid * 4352);
    const int r0 = brow + wr * (16 * MF), c0 = bcol + wc * 64;
    constexpr int vlo = (EPI == EPI_EVIN) ? 1024 : 1152, vhi = (EPI == EPI_EVIN) ? 1536 : 1280;
    const bool isV = (EPI == EPI_EVIN || EPI == EPI_ODIN) && c0 >= vlo && c0 < vhi;
    float* sbase = nullptr; int hd = 0, nh = 8;
    if (EPI == EPI_EVIN) {
      if (c0 >= 512 && c0 < 1024) { sbase = p.out + OFF_SAK; hd = (c0 - 512) >> 6; }
      else if (c0 >= 1024 && c0 < 1536) { sbase = p.out + OFF_SAV; hd = (c0 - 1024) >> 6; }
    } else if (EPI == EPI_ODIN) {
      nh = 2;
      if (c0 >= 1152 && c0 < 1280) { sbase = p.out + OFF_SDV; hd = (c0 - 1152) >> 6; }
    }
    const int c4 = (le & 15) * 4;
    float4 psc = make_float4(1.f, 1.f, 1.f, 1.f);
    if (EPI == EPI_POOL) psc = *(const float4*)(p.od_pool_scale + c0 + c4);
    constexpr int ESZ = 2;
    char* orow = (EPI == EPI_SWIGLU)
        ? (char*)outp + ((size_t)(r0 + (le >> 3)) * ldc + (c0 >> 1) + (le & 7) * 4) * 2
        : (char*)outp + ((size_t)(r0 + (le >> 4)) * ldc + c0 + c4) * ESZ;
    const size_t rstride = (size_t)ldc * ESZ;
#pragma unroll
    for (int m = 0; m < MF; ++m) {
      asm volatile("" : "+v"(orow));
      const int rm = r0 + m * 16;
      float* srow = (sbase && rm < MPR) ? sbase + ((size_t)((rm >> 8) * nh + hd) * 256 + (rm & 255) + (le >> 4)) * 64 + c4 : nullptr;
      if (EPI == EPI_EVIN || EPI == EPI_ODIN) {
        if (isV) {
          const int t0 = rm + fqe * 4, kk16 = t0 & 15;
          u16* vb = p.VT + ((size_t)(((c0 - vlo) >> 6) * 384 + (t0 >> 5)) * 4 + ((t0 >> 4) & 1)) * 512 + (((kk16 >> 2) & 1) * 32) * 8 + (kk16 >> 3) * 4;
#pragma unroll
          for (int n = 0; n < 4; ++n) {
            const int dim = n * 16 + fre;
            uint2 o; o.x = pack2(acc[m][n][0], acc[m][n][1]); o.y = pack2(acc[m][n][2], acc[m][n][3]);
            *(uint2*)(vb + (dim >> 5) * 1024 + (dim & 31) * 8) = o;
          }
        }
      }
#pragma unroll
      for (int n = 0; n < 4; ++n)
#pragma unroll
        for (int j = 0; j < 4; ++j) Ew[(fqe * 4 + j) * 68 + n * 16 + fre] = acc[m][n][j];
      if (EPI == EPI_EVIN) {
        if (c0 >= 512 && c0 < 1024) {
#pragma unroll
          for (int ps = 0; ps < 2; ++ps) {
            const int slot = le + 64 * ps, row = slot >> 3, ch = slot & 7;
            const float4 a = *(const float4*)(Ew + row * 68 + ch * 8), b4 = *(const float4*)(Ew + row * 68 + ch * 8 + 4);
            uint4 o; o.x = pack2(a.x, a.y); o.y = pack2(a.z, a.w); o.z = pack2(b4.x, b4.y); o.w = pack2(b4.z, b4.w);
            const int t = rm + row;
            *(uint4*)(p.KF + ((size_t)(((c0 - 512) >> 6) * 384 + (t >> 5)) * 4 + (ch >> 1)) * 512 + ((ch & 1) * 32 + (t & 31)) * 8) = o;
          }
        }
      }
      if (EPI == EPI_SWIGLU) {
        const int jj = (le & 7) * 4;
        f32x4 g0, u0, g1, u1;
        LDS_RD4(g0, u0, g1, u1, (unsigned)(size_t)(Ew + (le >> 3) * 68 + jj), 0, 128, 2176, 2304);
#pragma unroll
        for (int ps = 0; ps < 2; ++ps) {
          const f32x4 g = ps ? g1 : g0, u = ps ? u1 : u0;
          float v0 = g[0] / (1.f + __expf(-g[0])) * u[0], v1 = g[1] / (1.f + __expf(-g[1])) * u[1];
          float v2 = g[2] / (1.f + __expf(-g[2])) * u[2], v3 = g[3] / (1.f + __expf(-g[3])) * u[3];
          uint2 o; o.x = pack2(v0, v1); o.y = pack2(v2, v3);
          *(uint2*)(orow + (size_t)(8 * ps) * rstride) = o;
        }
      } else {
        f32x4 q0, q1, q2, q3;
        LDS_RD4(q0, q1, q2, q3, (unsigned)(size_t)(Ew + (le >> 4) * 68 + c4), 0, 1088, 2176, 3264);
#pragma unroll
        for (int ps = 0; ps < 4; ++ps) {
          const f32x4 qv = ps == 0 ? q0 : (ps == 1 ? q1 : (ps == 2 ? q2 : q3));
          float4 v = make_float4(qv[0], qv[1], qv[2], qv[3]);
          if (EPI == EPI_F32) {
            uint2 o; o.x = pack2(v.x, v.y); o.y = pack2(v.z, v.w);
            *(uint2*)(orow + (size_t)(4 * ps) * rstride) = o;
          } else if (EPI == EPI_POOL) {
            uint2 o; o.x = pack2(v.x * psc.x, v.y * psc.y); o.y = pack2(v.z * psc.z, v.w * psc.w);
            *(uint2*)(orow + (size_t)(4 * ps) * rstride) = o;
          } else {
            uint2 o; o.x = pack2(v.x, v.y); o.y = pack2(v.z, v.w);
            *(uint2*)(orow + (size_t)(4 * ps) * rstride) = o;
            if (srow) *(float4*)(srow + (4 * ps) * 64) = v;
          }
        }
      }
      orow += 16 * rstride;
    }
  }
#undef GLDS_STAGE
#undef TILE_COORDS
  __syncthreads();
}

struct Seg { const u16* KF; const u16* VF; int n; };

template <bool BIAS>
__device__ __forceinline__ void attn_core(const u16* __restrict__ Q, int ldq, Seg s0, Seg s1, f32x16& o0, f32x16& o1, float& m, float& l,
                                          const float* __restrict__ rpb_h, int qr, int qc0, int rs, int tidx) {
  const int lane = tidx & 63, l31 = lane & 31, lh = lane >> 5;
  bf16x8 bq[4];
#pragma unroll
  for (int kk = 0; kk < 4; ++kk) bq[kk] = *(const bf16x8*)(Q + (size_t)l31 * ldq + kk * 16 + lh * 8);
  m = -1e30f; l = 0.f;
#pragma unroll
  for (int e = 0; e < 16; ++e) { o0[e] = 0.f; o1[e] = 0.f; }
  const int qc = qc0 + l31;
  const int cs = min(max(qc - 8, 0), 48);
  const int nt0 = s0.n >> 5, ntot = nt0 + (s1.n >> 5);
  const u16* k0p = s0.KF + lane * 8;
  const u16* k1p = s1.KF + lane * 8;
  const u16* v0p = s0.VF + lane * 8;
  const u16* v1p = s1.VF + lane * 8;
  bf16x8 kA[4], kB[4], vA[4], vB[4];
#define KLOAD(dst, i_) do { const int j_ = min((i_), ntot - 1); const bool n1_ = j_ >= nt0; \
    const u16* Kp_ = n1_ ? k1p + (size_t)(j_ - nt0) * 2048 : k0p + (size_t)j_ * 2048; \
    _Pragma("unroll") for (int kk = 0; kk < 4; ++kk) dst[kk] = *(const bf16x8*)(Kp_ + kk * 512); } while (0)
#define VLOAD(dst, i_) do { const int j_ = min((i_), ntot - 1); const bool n1_ = j_ >= nt0; \
    const u16* vp_ = n1_ ? v1p + (size_t)(j_ - nt0) * 2048 : v0p + (size_t)j_ * 2048; \
    _Pragma("unroll") for (int q = 0; q < 4; ++q) dst[q] = *(const bf16x8*)(vp_ + q * 512); } while (0)
#define ATT_STEP(kf, vf, i_, kd_, vd_) do { \
    const bool in1 = (i_) >= nt0; const int kt = in1 ? (i_) - nt0 : (i_); \
    f32x16 sc; _Pragma("unroll") for (int e = 0; e < 16; ++e) sc[e] = 0.f; \
    _Pragma("unroll") for (int kk = 0; kk < 4; ++kk) sc = MFMA(kf[kk], bq[kk], sc); \
    KLOAD(kf, (i_) + (kd_)); \
    float mx = -1e30f; \
    _Pragma("unroll") for (int e = 0; e < 16; ++e) { \
      float v = sc[e] * 0.125f; \
      if (BIAS) { if (in1) { \
          const float* brow_ = rpb_h + (rs + (kt >> 1) - qr + 7) * 31;     \
          int kc = (kt & 1) * 32 + 8 * (e >> 2) + 4 * lh + (e & 3); \
          bool valid = (kc >= cs) && (kc < cs + 16); \
          unsigned co = (unsigned)min(max(kc - qc + 15, 0), 30); \
          float bv = brow_[co]; \
          v = valid ? v + bv : -1e30f; } } \
      sc[e] = v; mx = fmaxf(mx, v); \
      if (BIAS && (e & 3) == 3) __builtin_amdgcn_sched_barrier(0); } \
    mx = fmaxf(mx, __shfl_xor(mx, 32)); \
    const float mnew = fmaxf(m, mx); \
    const float corr = __expf(m - mnew); \
    float rsum = 0.f; \
    _Pragma("unroll") for (int e = 0; e < 16; ++e) { float pv = __expf(sc[e] - mnew); sc[e] = pv; rsum += pv; } \
    rsum += __shfl_xor(rsum, 32); \
    l = l * corr + rsum; m = mnew; \
    _Pragma("unroll") for (int e = 0; e < 16; ++e) { o0[e] *= corr; o1[e] *= corr; } \
    uint4 t0, t1; \
    t0.x = pack2(sc[0], sc[1]); t0.y = pack2(sc[2], sc[3]); t0.z = pack2(sc[4], sc[5]); t0.w = pack2(sc[6], sc[7]); \
    t1.x = pack2(sc[8], sc[9]); t1.y = pack2(sc[10], sc[11]); t1.z = pack2(sc[12], sc[13]); t1.w = pack2(sc[14], sc[15]); \
    const bf16x8 pb0 = __builtin_bit_cast(bf16x8, t0), pb1 = __builtin_bit_cast(bf16x8, t1); \
    o0 = MFMA(vf[0], pb0, o0); o0 = MFMA(vf[1], pb1, o0); \
    o1 = MFMA(vf[2], pb0, o1); o1 = MFMA(vf[3], pb1, o1); \
    VLOAD(vf, (i_) + (vd_)); } while (0)
  KLOAD(kA, 0); VLOAD(vA, 0);
  if (!BIAS) { KLOAD(kB, 1); VLOAD(vB, 1); }
#pragma unroll 1
  for (int i = 0; i < ntot; i += 2) {
    if (BIAS) {
      ATT_STEP(kA, vA, i, 1, 1);
      ATT_STEP(kA, vA, i + 1, 1, 1);
    } else {
      ATT_STEP(kA, vA, i, 2, 2);
      ATT_STEP(kB, vB, i + 1, 2, 2);
    }
  }
#undef KLOAD
#undef VLOAD
#undef ATT_STEP
}

__device__ __forceinline__ void attn_store(const f32x16& o0, const f32x16& o1, float inv, u16* __restrict__ O, int ldo, int tidx) {
  const int lane = tidx & 63, l31 = lane & 31, lh = lane >> 5;
  u16* op = O + (size_t)l31 * ldo + 4 * lh;
#pragma unroll
  for (int q4 = 0; q4 < 4; ++q4) {
    uint2 a, b;
    a.x = pack2(o0[4 * q4] * inv, o0[4 * q4 + 1] * inv); a.y = pack2(o0[4 * q4 + 2] * inv, o0[4 * q4 + 3] * inv);
    b.x = pack2(o1[4 * q4] * inv, o1[4 * q4 + 1] * inv); b.y = pack2(o1[4 * q4 + 2] * inv, o1[4 * q4 + 3] * inv);
    *(uint2*)(op + 8 * q4) = a;
    *(uint2*)(op + 32 + 8 * q4) = b;
  }
}

template <bool BIAS>
__device__ __forceinline__ void attn_unit(const u16* __restrict__ Q, int ldq, Seg s0, Seg s1, u16* __restrict__ O, int ldo,
                                          const float* __restrict__ rpb_h, int qr, int qc0, int rs, int tidx) {
  f32x16 o0, o1; float m, l;
  attn_core<BIAS>(Q, ldq, s0, s1, o0, o1, m, l, rpb_h, qr, qc0, rs, tidx);
  attn_store(o0, o1, 1.f / l, O, ldo, tidx);
}

__device__ void mix_even(const P& p, int gw, int W, int tidx) {
  const int lane = tidx & 63;
  const u16* U = p.ACTU;
  u16* MO = p.H;
  for (int u0 = gw; u0 < 2048 + MTOK; u0 += W) {
   for (int sub = 0; sub < 2; ++sub) {
    int u;
    if (u0 < 1024) { if (sub) break; u = u0; }
    else if (u0 < 2048) { u = 1024 + 2 * (u0 - 1024) + sub; }
    else { if (sub) break; u = u0 + 1024; }
    if (u < 1024) {
      int b = u >> 9, h = (u >> 6) & 7, r = (u >> 1) & 31, hf = u & 1;
      int tb = MPR + b * 2048;
      int rs = min(max(r - 4, 0), 24);
      Seg s0 = { p.CAK + (size_t)((b * 8 + h) * 8) * 2048, p.CAVT + (size_t)((b * 8 + h) * 8) * 2048, 256 };
      const size_t lt = (size_t)(h * 384 + ((tb + rs * 64) >> 5)) * 2048;
      Seg s1 = { p.KF + lt, p.VT + lt, 512 };
      int q0 = tb + r * 64 + hf * 32;
      attn_unit<true>(U + (size_t)q0 * 3072 + h * 64, 3072, s0, s1, MO + (size_t)q0 * DM + h * 64, DM, p.ev_rpb + h * 465, r, hf * 32, rs, tidx);
    } else if (u < 3072) {
      int v = u - 1024; int b = v >> 6, h = (v >> 3) & 7, qb = v & 7;
      const size_t lt = (size_t)(h * 384 + b * 8) * 2048;
      Seg s0 = { p.KF + lt, p.VT + lt, 256 };
      Seg s1 = { s0.KF, s0.VF, 0 };
      int q0 = b * 256 + qb * 32;
      attn_unit<false>(U + (size_t)q0 * 3072 + h * 64, 3072, s0, s1, MO + (size_t)q0 * DM + h * 64, DM, nullptr, 0, 0, 0, tidx);
    } else {
      int t = u - 3072;
      int s, L;
      if (t < MPR) { s = t & 255; L = 256; } else { s = (t - MPR) & 2047; L = 2048; }
      const int c = lane * 8;
      float z[3][8];
#pragma unroll
      for (int d = 0; d < 3; ++d) {
        int sd = s + d - 1;
        if (sd >= 0 && sd < L) {
          const u16* row = U + (size_t)(t + d - 1) * 3072;
          uint4 cg4 = *(const uint4*)(row + 2048 + c), xb4 = *(const uint4*)(row + 2560 + c);
          z[d][0] = bflo(cg4.x) * bflo(xb4.x); z[d][1] = bfhi(cg4.x) * bfhi(xb4.x);
          z[d][2] = bflo(cg4.y) * bflo(xb4.y); z[d][3] = bfhi(cg4.y) * bfhi(xb4.y);
          z[d][4] = bflo(cg4.z) * bflo(xb4.z); z[d][5] = bfhi(cg4.z) * bfhi(xb4.z);
          z[d][6] = bflo(cg4.w) * bflo(xb4.w); z[d][7] = bfhi(cg4.w) * bfhi(xb4.w);
        } else {
#pragma unroll
          for (int j = 0; j < 8; ++j) z[d][j] = 0.f;
        }
      }
      uint4 bg4 = *(const uint4*)(U + (size_t)t * 3072 + 1536 + c);
      float bg[8] = { bflo(bg4.x), bfhi(bg4.x), bflo(bg4.y), bfhi(bg4.y), bflo(bg4.z), bfhi(bg4.z), bflo(bg4.w), bfhi(bg4.w) };
      float y[8];
#pragma unroll
      for (int j = 0; j < 8; ++j) {
        float w0 = p.ev_conv_w[c + j], w1 = p.ev_conv_w[512 + c + j], w2 = p.ev_conv_w[1024 + c + j];
        y[j] = bg[j] * (z[0][j] * w0 + z[1][j] * w1 + z[2][j] * w2 + p.ev_conv_b[c + j]);
      }
      uint4 o; o.x = pack2(y[0], y[1]); o.y = pack2(y[2], y[3]); o.z = pack2(y[4], y[5]); o.w = pack2(y[6], y[7]);
      *(uint4*)(MO + (size_t)t * DM + 512 + c) = o;
    }
   }
  }
}

__device__ void mix_odd_a(const P& p, int gw, int W, int tidx) {
  const int lane = tidx & 63;
  u16* U = p.ACTU;
  u16* POOLED = (u16*)p.T;
  const float invf = exp2f(-(float)((lane >> 1) & 15) * (13.287712379549449f / 16.f));
  for (int t = gw; t < MTOK; t += W) {
    const bool smp = t >= MPR;
    int s, L, base;
    if (!smp) { s = t & 255; L = 256; base = t - s; } else { s = (t - MPR) & 2047; L = 2048; base = t - s; }
    float cs_ = 1.f, sn_ = 0.f;
    if (smp) {
      float pos = (lane < 32) ? (float)(s >> 6) : (float)(s & 63);
      float ang = pos * invf;
      cs_ = cosf(ang); sn_ = sinf(ang);
    }
    u16* row = U + (size_t)t * 1280;
#pragma unroll 1
    for (int hd = 0; hd < 10; ++hd) {
      float v = bf2f(row[512 + hd * 64 + lane]);
      float ss = wave_sum(v * v);
      float w = hd < 8 ? p.od_q_norm[lane] : p.od_k_norm[lane];
      float nv = v * rsqrtf(ss * (1.f / 64.f) + 1e-6f) * w;
      float outv = nv;
      if (smp) {
        float pr = __shfl_xor(nv, 1);
        outv = (lane & 1) ? (pr * sn_ + nv * cs_) : (nv * cs_ - pr * sn_);
      } else if (hd >= 8) {
        int b = t >> 8;
        p.out[OFF_SDK + ((size_t)(b * 2 + (hd - 8)) * 256 + s) * 64 + lane] = nv;
      }
      if (hd < 8) row[512 + hd * 64 + lane] = f2bf(outv);
      else p.KF[((size_t)((hd - 8) * 384 + (t >> 5)) * 4 + (lane >> 4)) * 512 + (((lane >> 3) & 1) * 32 + (t & 31)) * 8 + (lane & 7)] = f2bf(outv);
    }
    {
      const int half = 1 << (lane >> 4);
      const int lo = max(s - half, 0), hi = min(s + half, L);
      const int c = lane * 8;
      float a[8];
#pragma unroll
      for (int j = 0; j < 8; ++j) a[j] = 0.f;
      for (int j = lo; j < hi; ++j) {
        uint4 v = *(const uint4*)(U + (size_t)(base + j) * 1280 + c);
        a[0] += bflo(v.x); a[1] += bfhi(v.x); a[2] += bflo(v.y); a[3] += bfhi(v.y);
        a[4] += bflo(v.z); a[5] += bfhi(v.z); a[6] += bflo(v.w); a[7] += bfhi(v.w);
      }
      const float rn = 1.f / (float)(hi - lo);
      uint4 sv = *(const uint4*)(U + (size_t)t * 1280 + c);
      uint4 o;
      o.x = pack2(a[0] * rn - bflo(sv.x), a[1] * rn - bfhi(sv.x));
      o.y = pack2(a[2] * rn - bflo(sv.y), a[3] * rn - bfhi(sv.y));
      o.z = pack2(a[4] * rn - bflo(sv.z), a[5] * rn - bfhi(sv.z));
      o.w = pack2(a[6] * rn - bflo(sv.w), a[7] * rn - bfhi(sv.w));
      *(uint4*)(POOLED + (size_t)t * 512 + c) = o;
    }
  }
}

__device__ void mix_odd_b(const P& p, int gw, int W, int tidx, char* smem) {
  const u16* U = p.ACTU;
  u16* MO = p.H;
  const int lane = tidx & 63, wave = tidx >> 6;
  for (int hu = gw; hu < 2048; hu += W) {
    const int v = hu >> 1, half = hu & 1;
    const int b = v >> 9, hq = (v >> 6) & 7, qb = v & 63, kvh = hq >> 2;
    const int tb = MPR + b * 2048;
    const size_t lt = (size_t)(kvh * 384 + (tb >> 5)) * 2048;
    Seg s0, s1;
    if (half == 0) {
      s0 = Seg{ p.CDK + (size_t)((b * 2 + kvh) * 8) * 2048, p.CDVT + (size_t)((b * 2 + kvh) * 8) * 2048, 256 };
      s1 = Seg{ p.KF + lt, p.VT + lt, 896 };
    } else {
      s0 = Seg{ p.KF + lt + (size_t)28 * 2048, p.VT + lt + (size_t)28 * 2048, 1152 };
      s1 = Seg{ p.KF + lt, p.VT + lt, 0 };
    }
    const int q0 = tb + qb * 32;
    f32x16 o0, o1; float m, l;
    attn_core<false>(U + (size_t)q0 * 1280 + 512 + hq * 64, 1280, s0, s1, o0, o1, m, l, nullptr, 0, 0, 0, tidx);
    float* cb = (float*)smem + (wave >> 1) * (34 * 64) + lane;
    if (half == 1) {
      cb[0] = m; cb[64] = l;
#pragma unroll
      for (int e = 0; e < 16; ++e) { cb[(2 + e) * 64] = o0[e]; cb[(18 + e) * 64] = o1[e]; }
    }
    __syncthreads();
    if (half == 0) {
      const float m2 = cb[0], l2 = cb[64];
      const float M = fmaxf(m, m2);
      const float a1 = __expf(m - M), a2 = __expf(m2 - M);
      const float inv = 1.f / (l * a1 + l2 * a2);
#pragma unroll
      for (int e = 0; e < 16; ++e) { o0[e] = o0[e] * a1 + cb[(2 + e) * 64] * a2; o1[e] = o1[e] * a1 + cb[(18 + e) * 64] * a2; }
      attn_store(o0, o1, inv, MO + (size_t)q0 * DM + 512 + hq * 64, DM, tidx);
    }
    __syncthreads();
  }
  for (int v = gw; v < 2048; v += W) {
    int b = v >> 6, hq = (v >> 3) & 7, qb = v & 7, kvh = hq >> 2;
    const size_t lt = (size_t)(kvh * 384 + b * 8) * 2048;
    Seg s0 = { p.KF + lt, p.VT + lt, 256 };
    Seg s1 = { s0.KF, s0.VF, 0 };
    int q0 = b * 256 + qb * 32;
    attn_unit<false>(U + (size_t)q0 * 1280 + 512 + hq * 64, 1280, s0, s1, MO + (size_t)q0 * DM + 512 + hq * 64, DM, nullptr, 0, 0, 0, tidx);
  }
}

#define XB_TMO      128
#define XB_XCNT(j)  (256  + 64 * (j))
#define XB_XSUB(j)  (1280 + 64 * (j))
#define XB_XGEN(j)  (2304 + 64 * (j))
#define XB_TOP      3328
#define XB_TOPGEN   3392
#define XCD_BAR_WORDS 3456
#define XB_SPIN_CAP (1u << 20)
#define LAS __attribute__((address_space(3)))
DI unsigned xb_ld(unsigned* p)              { return __hip_atomic_load(p, __ATOMIC_RELAXED, __HIP_MEMORY_SCOPE_AGENT); }
DI unsigned xb_add(unsigned* p, unsigned v) { return __hip_atomic_fetch_add(p, v, __ATOMIC_RELAXED, __HIP_MEMORY_SCOPE_AGENT); }
DI unsigned xb_xcc_id() { return (unsigned)__builtin_amdgcn_s_getreg((3 << 11) | 20) & 0xFu; }
#define XB_SPIN(cond, bar) do { unsigned _sp = 0; while (cond) { __builtin_amdgcn_s_sleep(1); \
    if ((++_sp & 255u) == 0u) { if (xb_ld(&(bar)[XB_TMO])) break; if (_sp > XB_SPIN_CAP) { atomicAdd(&(bar)[XB_TMO], 1u); break; } } } } while (0)
struct XcdBarrier { unsigned* bar; unsigned x; volatile LAS unsigned* st; };
DI XcdBarrier xcd_barrier_post(unsigned* bar, volatile LAS unsigned* st) {
  XcdBarrier b; b.bar = bar; b.x = xb_xcc_id(); b.st = st;
  if (threadIdx.x == 0) (void)xb_add(&bar[XB_XCNT(b.x)], 1u);
  return b;
}
DI void xcd_barrier_complete(unsigned* bar, unsigned x, unsigned& nloc, unsigned& nx) {
  const unsigned G = gridDim.x * gridDim.y * gridDim.z;
  unsigned sum, cnt, mine, sp = 0u;
  for (;;) {
    sum = 0u; cnt = 0u; mine = 0u;
#pragma unroll
    for (unsigned j = 0; j < 16; ++j) { const unsigned c = xb_ld(&bar[XB_XCNT(j)]); sum += c; cnt += (c > 0u) ? 1u : 0u; mine = (j == x) ? c : mine; }
    if (sum == G) break;
    __builtin_amdgcn_s_sleep(1);
    if ((++sp & 255u) == 0u) { if (xb_ld(&bar[XB_TMO])) break; if (sp > XB_SPIN_CAP) { atomicAdd(&bar[XB_TMO], 1u); break; } }
  }
  nloc = mine > 0u ? mine : 1u; nx = cnt > 0u ? cnt : 1u;
}
DI void xcd_barrier(const XcdBarrier& b) {
  asm volatile("s_waitcnt vmcnt(0)" ::: "memory");
  __syncthreads();
  if (threadIdx.x == 0) {
    unsigned* bar = b.bar;
    __builtin_amdgcn_s_waitcnt(0);
    unsigned nloc = b.st[0], nx = b.st[1];
    if (nloc == 0u) { xcd_barrier_complete(bar, b.x, nloc, nx); b.st[0] = nloc; b.st[1] = nx; }
    const unsigned old = xb_add(&bar[XB_XSUB(b.x)], 1u);
    const unsigned gen = old / nloc;
    if (old + 1u == (gen + 1u) * nloc) {
      __builtin_amdgcn_fence(__ATOMIC_RELEASE, "agent");
      asm volatile("s_waitcnt vmcnt(0)" ::: "memory");
      const unsigned og = xb_add(&bar[XB_TOP], 1u);
      const unsigned tg = og / nx;
      if (og + 1u == (tg + 1u) * nx) xb_add(&bar[XB_TOPGEN], 1u);
      else XB_SPIN(xb_ld(&bar[XB_TOPGEN]) == tg, bar);
      __builtin_amdgcn_fence(__ATOMIC_ACQUIRE, "agent");
      xb_add(&bar[XB_XGEN(b.x)], 1u);
      asm volatile("s_waitcnt vmcnt(0)" ::: "memory");
    } else {
      XB_SPIN(xb_ld(&bar[XB_XGEN(b.x)]) == gen, bar);
      __builtin_amdgcn_fence(__ATOMIC_ACQUIRE, "agent");
      asm volatile("s_waitcnt vmcnt(0)" ::: "memory");
    }
  }
  __syncthreads();
}

constexpr int N_PHASES = 22;
#define GRID_SYNC() xcd_barrier(xb)

#define LOADP() PAK pa = pak0; asm volatile("" : "+s"(pa)); P p; \
    p.x_prompt = pa->in[0]; p.x_sample = pa->in[1]; p.cache_a_k = pa->in[2]; p.cache_a_v = pa->in[3]; p.cache_d_k = pa->in[4]; p.cache_d_v = pa->in[5]; \
    p.c = pa->in[6]; p.c_ctx = pa->in[7]; p.mod_w = pa->in[8]; p.mod_b = pa->in[9]; p.norm_w = pa->in[10]; p.ffn_w1 = pa->in[11]; p.ffn_w2 = pa->in[12]; \
    p.ev_w_in = pa->in[13]; p.ev_rpb = pa->in[14]; p.ev_conv_w = pa->in[15]; p.ev_conv_b = pa->in[16]; p.ev_w_out = pa->in[17]; \
    p.od_w_in = pa->in[18]; p.od_pool_w = pa->in[19]; p.od_pool_scale = pa->in[20]; p.od_q_norm = pa->in[21]; p.od_k_norm = pa->in[22]; p.od_w_out = pa->in[23]; \
    p.out = pa->out; \
    { char* ws = pa->ws; \
      p.W1T = (u16*)(ws + WO_W1T); p.W2T = (u16*)(ws + WO_W2T); p.EVIN = (u16*)(ws + WO_EVIN); p.EVOUT = (u16*)(ws + WO_EVOUT); \
      p.ODIN = (u16*)(ws + WO_ODIN); p.ODOUT = (u16*)(ws + WO_ODOUT); p.POOLW = (u16*)(ws + WO_POOLW); \
      p.CAK = (u16*)(ws + WO_CAK); p.CAVT = (u16*)(ws + WO_CAVT); p.CDK = (u16*)(ws + WO_CDK); p.CDVT = (u16*)(ws + WO_CDVT); \
      p.H = (u16*)(ws + WO_H); p.ACTU = (u16*)(ws + WO_ACTU); p.VT = (u16*)(ws + WO_VT); \
      p.MOD = (float*)(ws + WO_MOD); p.X = (float*)(ws + WO_X); p.T = (float*)(ws + WO_T); p.BAR = (unsigned*)(ws + WO_BAR); p.KF = (u16*)(ws + WO_KF); }
typedef const __attribute__((address_space(4))) PA* PAK;
__global__ void __launch_bounds__(NTHR, 2) mega(PA pa_unused, int ph0, int ph1) {
  __shared__ __attribute__((aligned(1024))) char smem[LDS_BYTES];
  __shared__ uint4 xb_words;
  cg::grid_group grid = cg::this_grid();
  if (ph1 == 0x7fffffff) grid.sync();
  if (threadIdx.x == 0) xb_words = make_uint4(0u, 0u, 0u, 0u);
  __syncthreads();
  const PAK pak0 = (PAK)__builtin_amdgcn_kernarg_segment_ptr();
  const XcdBarrier xb = xcd_barrier_post((unsigned*)(pak0->ws + WO_BAR), (volatile LAS unsigned*)&xb_words);
  const int G = gridDim.x, bid = blockIdx.x;
  const int vbid = (G & 7) ? bid : ((bid & 7) * (G >> 3) + (bid >> 3));
  const int W = G * (NTHR / 64);
#ifndef REPMASK
#define REPMASK 0u
#endif
  for (int ph = ph0; ph < ph1; ++ph) {
   const int nrep = ((REPMASK >> ph) & 1u) ? 2 : 1;
   for (int rep = 0; rep < nrep; ++rep) {
    if (rep) { GRID_SYNC(); }
    int tidx = threadIdx.x;
    asm volatile("" : "+v"(tidx));
    const int gw = vbid * (NTHR / 64) + __builtin_amdgcn_readfirstlane(tidx >> 6);
    if (ph == 0) {
      LOADP();
      prep_phase(p, smem, bid, G, tidx, 0);
    } else if (ph == 21) {
      LOADP();
      r_phase<2>(p, false, true, p.norm_w + 11 * DM, p.MOD + 3 * 9216, 8, 0.5f, false, nullptr, nullptr, 0, 0, p.out, gw, W, tidx);
    } else {
      const int q = ph - 1;
      const int l = q / 10, s = q % 10;
#define NWMOD() const float* nw = p.norm_w + l * 6 * DM; const float* modl = p.MOD + l * 3 * 9216
      if (s == 3 || s == 7 || (s == 0 && l == 1)) {
        LOADP(); NWMOD();
        const float* gT = s == 0 ? p.norm_w + 5 * DM : (s == 3 ? nw + DM : nw + 3 * DM);
        const float* mg = s == 0 ? p.MOD : modl;
        const int gate = s == 0 ? 8 : (s == 3 ? 2 : 5);
        const float gs = s == 7 ? 1.0f : 0.5f;
        const float* g2 = s == 0 ? nw : (s == 3 ? nw + 2 * DM : nw + 4 * DM);
        const int shi = s == 0 ? 0 : (s == 3 ? 3 : 6);
        r_phase<1>(p, false, true, gT, mg, gate, gs, true, g2, modl, shi, shi + 1, p.X, gw, W, tidx);
      } else
      switch (s) {
        case 0: { LOADP(); NWMOD();
          prep_phase(p, smem, bid, G, tidx, 1);
          r_phase<0>(p, true, false, nullptr, nullptr, 0, 0.f, true, nw, modl, 0, 1, p.X, gw, W, tidx);
        } break;
        case 1: case 8: { LOADP();
          const int f = s == 1 ? 0 : 1;
          const u16* w1 = p.W1T + (size_t)(l * 2 + f) * 5632 * 1024;
          gemm_phase<EPI_SWIGLU, 6>(p, p.H, w1, 1024, 64, 22, p.ACTU, DFF, smem, vbid, G, tidx, 1280);
          gemm_phase<EPI_SWIGLU, 3, true>(p, p.H, w1, 1024, 64, 22, p.ACTU, DFF, smem, vbid, G, tidx, 256, 1280);
        } break;
        case 2: case 9: case 6: { LOADP();
          const u16* A_ = s == 6 ? p.H : p.ACTU;
          const u16* B_ = s == 6 ? (l == 0 ? p.EVOUT : p.ODOUT) : p.W2T + (size_t)(l * 2 + (s == 2 ? 0 : 1)) * 1024 * 2816;
          gemm_phase<EPI_F32, 6>(p, A_, B_, s == 6 ? 1024 : DFF, 64, 4, p.T, DM, smem, vbid, G, tidx);
        } break;
        case 4: { LOADP();
          if (l == 0) gemm_phase<EPI_EVIN, 6>(p, p.H, p.EVIN, 1024, 64, 12, p.ACTU, 3072, smem, vbid, G, tidx);
          else {
            gemm_phase<EPI_ODIN, 6>(p, p.H, p.ODIN, 1024, 64, 5, p.ACTU, 1280, smem, vbid, G, tidx, 256);
            gemm_phase<EPI_ODIN, 3, true>(p, p.H, p.ODIN, 1024, 64, 5, p.ACTU, 1280, smem, vbid, G, tidx, 128, 256);
            GRID_SYNC();
            mix_odd_a(p, gw, W, tidx);
          }
        } break;
        case 5: { LOADP();
          if (l == 0) mix_even(p, gw, W, tidx);
          else {
            gemm_phase<EPI_POOL, 6>(p, (const u16*)p.T, p.POOLW, 512, 64, 2, p.H, DM, smem, vbid, G, tidx);
            mix_odd_b(p, gw, W, tidx, smem);
          }
        } break;
      }
    }
   }
    if (ph + 1 < ph1) { GRID_SYNC(); }
#ifdef EXTRA_SYNCS
    if (ph == 1) { for (int es = 0; es < EXTRA_SYNCS; ++es) { GRID_SYNC(); } }
#endif
  }
}

extern "C" void kernel_launch(void* const* d_in, const int* in_sizes, int n_in, void* d_out, int out_size,
                              void* d_ws, size_t ws_size, hipStream_t stream) {
  static int grid_blocks = 0;
  if (!grid_blocks) {
    int dev = 0, cus = 0, per_cu = 0;
    hipGetDevice(&dev);
    hipDeviceGetAttribute(&cus, hipDeviceAttributeMultiprocessorCount, dev);
    hipOccupancyMaxActiveBlocksPerMultiprocessor(&per_cu, mega, NTHR, 0);
    if (per_cu > 1) per_cu = 1;
    if (per_cu < 1) per_cu = 1;
    grid_blocks = cus * per_cu;
  }
  PA p{};
  for (int i = 0; i < 24; ++i) p.in[i] = (const float*)d_in[i];
  p.out = (float*)d_out;
  p.ws = (char*)d_ws;
  if (WO_END > ws_size) { fprintf(stderr, "workspace too small: need %zu have %zu\n", (size_t)WO_END, ws_size); return; }
  (void)hipMemsetAsync(p.ws + WO_BAR, 0, (size_t)XCD_BAR_WORDS * 4, stream);
  int ph0 = 0, ph1 = N_PHASES;
  void* args[] = { &p, &ph0, &ph1 };
  hipError_t e = hipLaunchCooperativeKernel((void*)mega, dim3(grid_blocks), dim3(NTHR), args, 0, stream);
  if (e != hipSuccess) fprintf(stderr, "cooperative launch failed: %s (grid %d)\n", hipGetErrorString(e), grid_blocks);
}
```

```cpp
#include <hip/hip_runtime.h>
#include <hip/hip_cooperative_groups.h>
#include <cstdio>
namespace cg = cooperative_groups;

typedef unsigned short u16;
using bf16x8 = __attribute__((ext_vector_type(8))) short;
using s16x4  = __attribute__((ext_vector_type(4))) short;
using f32x16 = __attribute__((ext_vector_type(16))) float;
#define DI __device__ __forceinline__
#define MFMA(a, b, c) __builtin_amdgcn_mfma_f32_32x32x16_bf16((a), (b), (c), 0, 0, 0)

constexpr int MTOK = 12288;
constexpr int MPR  = 8192;
constexpr int DM   = 1024;
constexpr int DFF  = 2816;
constexpr int NTHR = 512;
constexpr int LDS_BYTES = 131072;
constexpr int SROW = 72;

constexpr size_t OFF_SAK = 12582912, OFF_SAV = 16777216, OFF_SDK = 20971520, OFF_SDV = 22020096;

struct P {
  const float *x_prompt, *x_sample, *cache_a_k, *cache_a_v, *cache_d_k, *cache_d_v, *c, *c_ctx;
  const float *mod_w, *mod_b, *norm_w, *ffn_w1, *ffn_w2, *ev_w_in, *ev_rpb, *ev_conv_w, *ev_conv_b, *ev_w_out;
  const float *od_w_in, *od_pool_w, *od_pool_scale, *od_q_norm, *od_k_norm, *od_w_out;
  float* out;
  u16 *W1T, *W2T, *EVIN, *EVOUT, *ODIN, *ODOUT, *POOLW, *CAK, *CAVT, *CDK, *CDVT, *H, *ACTU, *VT, *KF;
  float *MOD, *X, *T;
  unsigned* BAR;
};
struct PA {
  const float* in[24];
  float* out;
  char* ws;
};
constexpr size_t al256(size_t b) { return (b + 255) & ~(size_t)255; }
constexpr size_t WO_W1T = 0;
constexpr size_t WO_W2T = WO_W1T + al256((size_t)4 * 5632 * 1024 * 2);
constexpr size_t WO_EVIN = WO_W2T + al256((size_t)4 * 1024 * 2816 * 2);
constexpr size_t WO_EVOUT = WO_EVIN + al256((size_t)3072 * 1024 * 2);
constexpr size_t WO_ODIN = WO_EVOUT + al256((size_t)1024 * 1024 * 2);
constexpr size_t WO_ODOUT = WO_ODIN + al256((size_t)1280 * 1024 * 2);
constexpr size_t WO_POOLW = WO_ODOUT + al256((size_t)1024 * 1024 * 2);
constexpr size_t WO_CAK = WO_POOLW + al256((size_t)512 * 512 * 2);
constexpr size_t WO_CAVT = WO_CAK + al256((size_t)262144 * 2);
constexpr size_t WO_CDK = WO_CAVT + al256((size_t)262144 * 2);
constexpr size_t WO_CDVT = WO_CDK + al256((size_t)65536 * 2);
constexpr size_t WO_H = WO_CDVT + al256((size_t)65536 * 2);
constexpr size_t WO_ACTU = WO_H + al256((size_t)12288 * 1024 * 2);
constexpr size_t WO_VT = WO_ACTU + al256((size_t)12288 * 3072 * 2);
constexpr size_t WO_MOD = WO_VT + al256((size_t)512 * 12288 * 2);
constexpr size_t WO_X = WO_MOD + al256((size_t)2 * 3 * 9216 * 4);
constexpr size_t WO_T = WO_X + al256((size_t)12288 * 1024 * 4);
constexpr size_t WO_BAR = WO_T + al256((size_t)12288 * 1024 * 4);
constexpr size_t WO_KF = WO_BAR + al256((size_t)3456 * 4);
constexpr size_t WO_END = WO_KF + al256((size_t)512 * 12288 * 2);

DI u16 f2bf(float x) { unsigned u = __float_as_uint(x); u += 0x7fffu + ((u >> 16) & 1u); return (u16)(u >> 16); }
DI float bf2f(u16 v) { return __uint_as_float(((unsigned)v) << 16); }
DI unsigned pack2(float a, float b) { unsigned r; asm("v_cvt_pk_bf16_f32 %0, %1, %2" : "=v"(r) : "v"(a), "v"(b)); return r; }
DI float wave_sum(float v) {
#pragma unroll
  for (int o = 32; o > 0; o >>= 1) v += __shfl_xor(v, o);
  return v;
}
DI float bflo(unsigned u) { return __uint_as_float(u << 16); }
DI float bfhi(unsigned u) { return __uint_as_float(u & 0xffff0000u); }

__device__ void mod_item(const P& p, int it, char* smem, int tidx) {
  float* sS = (float*)smem;
  float* red = sS + 3072;
  const int tid = tidx;
  const int l = it / 144, n0 = (it % 144) * 64;
  for (int i = tid; i < 3072; i += 256) {
    int r = i >> 10, k = i & 1023;
    float v = r == 0 ? p.c_ctx[k] : p.c[(r - 1) * 1024 + k];
    sS[i] = v / (1.f + expf(-v));
  }
  __syncthreads();
  const int kq = tid >> 4, cq = tid & 15;
  const float* w = p.mod_w + (size_t)l * 1024 * 9216 + (size_t)(kq * 64) * 9216 + n0 + cq * 4;
  float a00 = 0, a01 = 0, a02 = 0, a03 = 0, a10 = 0, a11 = 0, a12 = 0, a13 = 0, a20 = 0, a21 = 0, a22 = 0, a23 = 0;
#pragma unroll 1
  for (int k0 = 0; k0 < 64; k0 += 8) {
    float4 wv[8];
#pragma unroll
    for (int k = 0; k < 8; ++k) wv[k] = *(const float4*)(w + (size_t)(k0 + k) * 9216);
#pragma unroll
    for (int k = 0; k < 8; ++k) {
      float4 w4 = wv[k];
      float s0 = sS[kq * 64 + k0 + k], s1 = sS[1024 + kq * 64 + k0 + k], s2 = sS[2048 + kq * 64 + k0 + k];
      a00 += s0 * w4.x; a01 += s0 * w4.y; a02 += s0 * w4.z; a03 += s0 * w4.w;
      a10 += s1 * w4.x; a11 += s1 * w4.y; a12 += s1 * w4.z; a13 += s1 * w4.w;
      a20 += s2 * w4.x; a21 += s2 * w4.y; a22 += s2 * w4.z; a23 += s2 * w4.w;
    }
  }
  float* r0 = red + (kq * 3 + 0) * 64 + cq * 4;
  r0[0] = a00; r0[1] = a01; r0[2] = a02; r0[3] = a03;
  r0[64] = a10; r0[65] = a11; r0[66] = a12; r0[67] = a13;
  r0[128] = a20; r0[129] = a21; r0[130] = a22; r0[131] = a23;
  __syncthreads();
  if (tid < 192) {
    int r = tid >> 6, n = tid & 63;
    float s = p.mod_b[l * 9216 + n0 + n];
#pragma unroll
    for (int q = 0; q < 16; ++q) s += red[(q * 3 + r) * 64 + n];
    p.MOD[(l * 3 + r) * 9216 + n0 + n] = s;
  }
  __syncthreads();
}

struct TrItem { const float* src; u16* dst; int N, Kd, k0, n0, perm; };
DI TrItem tr_decode(const P& p, int idx) {
  TrItem t; t.perm = 0; int kt, nt;
  if (idx < 2816) { int mat = idx / 704, r = idx % 704; kt = r / 44; nt = r % 44; t.src = p.ffn_w1 + (size_t)mat * 1024 * 5632; t.N = 5632; t.Kd = 1024; t.dst = p.W1T + (size_t)mat * 5632 * 1024; t.perm = 1; }
  else if (idx < 4224) { int r0 = idx - 2816; int mat = r0 / 352, r = r0 % 352; kt = r / 8; nt = r % 8; t.src = p.ffn_w2 + (size_t)mat * 2816 * 1024; t.N = 1024; t.Kd = 2816; t.dst = p.W2T + (size_t)mat * 1024 * 2816; }
  else if (idx < 4608) { int r = idx - 4224; kt = r / 24; nt = r % 24; t.src = p.ev_w_in; t.N = 3072; t.Kd = 1024; t.dst = p.EVIN; }
  else if (idx < 4736) { int r = idx - 4608; kt = r / 8; nt = r % 8; t.src = p.ev_w_out; t.N = 1024; t.Kd = 1024; t.dst = p.EVOUT; }
  else if (idx < 4896) { int r = idx - 4736; kt = r / 10; nt = r % 10; t.src = p.od_w_in; t.N = 1280; t.Kd = 1024; t.dst = p.ODIN; }
  else if (idx < 5024) { int r = idx - 4896; kt = r / 8; nt = r % 8; t.src = p.od_w_out; t.N = 1024; t.Kd = 1024; t.dst = p.ODOUT; }
  else { int r = idx - 5024; int mat = r >> 1; kt = r & 1; nt = 0; t.src = p.od_pool_w + mat * 16384; t.N = 128; t.Kd = 512; t.dst = p.POOLW + (size_t)(mat * 128) * 512 + mat * 128; }
  t.k0 = kt * 64; t.n0 = nt * 128;
  return t;
}

__device__ void prep_phase(const P& p, char* smem_all, int bid, int G, int tid512) {
  constexpr int N_MOD = 288, N_TR = 5032, N_CC = 448;
  const int half = tid512 >> 8, tid = tid512 & 255;
  char* smem = smem_all + half * 36864;
  for (int pi = bid; pi < N_MOD / 2; pi += G) mod_item(p, 2 * pi + half, smem, tid);
  {
    float* tl = (float*)smem;
    const int r = tid >> 5, c4 = (tid & 31) * 4;
    float4 v[8];
    int tp = bid;
    TrItem cur{};
    if (tp < N_TR / 2) {
      cur = tr_decode(p, 2 * tp + half);
      const float* sp = cur.src + (size_t)(cur.k0 + r) * cur.N + cur.n0 + c4;
#pragma unroll
      for (int q = 0; q < 8; ++q) v[q] = *(const float4*)(sp + (size_t)(8 * q) * cur.N);
    }
    for (; tp < N_TR / 2; tp += G) {
      float* tpp = tl + r * 129 + c4;
#pragma unroll
      for (int q = 0; q < 8; ++q) { tpp[q * 8 * 129] = v[q].x; tpp[q * 8 * 129 + 1] = v[q].y; tpp[q * 8 * 129 + 2] = v[q].z; tpp[q * 8 * 129 + 3] = v[q].w; }
      __syncthreads();
      const TrItem me = cur;
      if (tp + G < N_TR / 2) {
        cur = tr_decode(p, 2 * (tp + G) + half);
        const float* sp = cur.src + (size_t)(cur.k0 + r) * cur.N + cur.n0 + c4;
#pragma unroll
        for (int q = 0; q < 8; ++q) v[q] = *(const float4*)(sp + (size_t)(8 * q) * cur.N);
      }
#pragma unroll
      for (int q = 0; q < 4; ++q) {
        int nn = (tid >> 3) + 32 * q, kc = tid & 7;
        int n = me.n0 + nn, nd = n;
        if (me.perm) nd = n < DFF ? ((n >> 5) * 64 + (n & 31)) : ((((n - DFF) >> 5) * 64) + 32 + ((n - DFF) & 31));
        const float* t = tl + (kc * 8) * 129 + nn;
        uint4 o;
        o.x = pack2(t[0], t[129]); o.y = pack2(t[258], t[387]); o.z = pack2(t[516], t[645]); o.w = pack2(t[774], t[903]);
        *(uint4*)(me.dst + (size_t)nd * me.Kd + me.k0 + kc * 8) = o;
      }
      __syncthreads();
    }
  }
  for (int pi = bid; pi < N_CC / 2; pi += G) {
    const int idx = 2 * pi + half;
    {
      int e0 = idx * 2048 + tid * 8;
#pragma unroll
      for (int j = 0; j < 8; ++j) {
        int e = e0 + j;
        if (e < 589824 && (e < 262144 || e >= 524288)) {
          const bool isA = e < 262144; const int q = isA ? e : e - 524288;
          const int x = q & 7, ln = (q >> 3) & 63, sub = (q >> 9) & 3, T = (q >> 11) & 7, bh = q >> 14;
          const int key = T * 32 + (ln & 31), d = sub * 16 + (ln >> 5) * 8 + x;
          const float v = (isA ? p.cache_a_k : p.cache_d_k)[(bh * 256 + key) * 64 + d];
          (isA ? p.CAK : p.CDK)[q] = f2bf(v);
        } else if (e < 655360) {
          const bool isA = e < 524288; const int q = isA ? e - 262144 : e - 589824;
          const int x = q & 7, ln = (q >> 3) & 63, sub = (q >> 9) & 3, T = (q >> 11) & 7, bh = q >> 14;
          const int dim = (sub >> 1) * 32 + (ln & 31), key = T * 32 + 16 * (sub & 1) + 8 * (x >> 2) + 4 * (ln >> 5) + (x & 3);
          const float v = (isA ? p.cache_a_v : p.cache_d_v)[(bh * 256 + key) * 64 + dim];
          (isA ? p.CAVT : p.CDVT)[q] = f2bf(v);
        }
        else { int q = e - 655360; int n = q >> 9, k = q & 511; if ((n >> 7) != (k >> 7)) p.POOLW[q] = 0; }
      }
    }
  }
}

template <int RMODE>
__device__ void r_phase(const P& p, bool first_unused, bool hasT_unused, const float* gT, const float* modg, int gate_idx, float gscale,
                        bool writeH, const float* g2, const float* modn, int shift_idx, int scale_idx, float* xdst, int gw, int W, int tidx) {
  const int lane = tidx & 63;
  constexpr bool first = RMODE == 0, hasT = RMODE != 0;
  constexpr int NR = 6;
  for (int t0 = gw; t0 < MTOK; t0 += NR * W) {
    float4 xf[NR][4];
    uint2 xq[NR][4], tq[NR][4];
#pragma unroll
    for (int r = 0; r < NR; ++r) {
      const int t = t0 + r * W;
      if (t < MTOK) {
        if (first) {
          const float* xs = t < MPR ? p.x_prompt + (size_t)t * DM : p.x_sample + (size_t)(t - MPR) * DM;
#pragma unroll
          for (int j = 0; j < 4; ++j) xf[r][j] = *(const float4*)(xs + lane * 4 + 256 * j);
        } else {
          const u16* xs = (const u16*)p.X + (size_t)t * DM;
          const u16* ts = (const u16*)p.T + (size_t)t * DM;
#pragma unroll
          for (int j = 0; j < 4; ++j) { xq[r][j] = *(const uint2*)(xs + lane * 4 + 256 * j); tq[r][j] = *(const uint2*)(ts + lane * 4 + 256 * j); }
        }
      }
    }
#pragma unroll
    for (int r = 0; r < NR; ++r) {
      const int t = t0 + r * W;
      if (t < MTOK) {
        const int ci = t < MPR ? 0 : 1 + ((t - MPR) >> 11);
        float4 x[4];
        if (first) {
#pragma unroll
          for (int j = 0; j < 4; ++j) x[j] = xf[r][j];
        } else {
#pragma unroll
          for (int j = 0; j < 4; ++j) x[j] = make_float4(bflo(xq[r][j].x), bfhi(xq[r][j].x), bflo(xq[r][j].y), bfhi(xq[r][j].y));
        }
        if (hasT) {
          float4 tv[4];
          float ss = 0.f;
#pragma unroll
          for (int j = 0; j < 4; ++j) {
            tv[j] = make_float4(bflo(tq[r][j].x), bfhi(tq[r][j].x), bflo(tq[r][j].y), bfhi(tq[r][j].y));
            ss += tv[j].x * tv[j].x + tv[j].y * tv[j].y + tv[j].z * tv[j].z + tv[j].w * tv[j].w;
          }
          ss = wave_sum(ss);
          const float rs = rsqrtf(ss * (1.f / 1024.f) + 1e-6f) * gscale;
          const float* mg = modg + ci * 9216 + gate_idx * 1024;
#pragma unroll
          for (int j = 0; j < 4; ++j) {
            int c = lane * 4 + 256 * j;
            float4 g4 = *(const float4*)(gT + c), m4 = *(const float4*)(mg + c);
            x[j].x += m4.x * (tv[j].x * rs * g4.x); x[j].y += m4.y * (tv[j].y * rs * g4.y);
            x[j].z += m4.z * (tv[j].z * rs * g4.z); x[j].w += m4.w * (tv[j].w * rs * g4.w);
          }
        }
        if (RMODE == 2) {
#pragma unroll
          for (int j = 0; j < 4; ++j) *(float4*)(xdst + (size_t)t * DM + lane * 4 + 256 * j) = x[j];
        } else {
#pragma unroll
          for (int j = 0; j < 4; ++j) {
            uint2 o; o.x = pack2(x[j].x, x[j].y); o.y = pack2(x[j].z, x[j].w);
            *(uint2*)((u16*)xdst + (size_t)t * DM + lane * 4 + 256 * j) = o;
          }
          float ss = 0.f;
#pragma unroll
          for (int j = 0; j < 4; ++j) ss += x[j].x * x[j].x + x[j].y * x[j].y + x[j].z * x[j].z + x[j].w * x[j].w;
          ss = wave_sum(ss);
          const float r2 = rsqrtf(ss * (1.f / 1024.f) + 1e-6f);
          const float* sh = modn + ci * 9216 + shift_idx * 1024;
          const float* sc = modn + ci * 9216 + scale_idx * 1024;
#pragma unroll
          for (int j = 0; j < 4; ++j) {
            int c = lane * 4 + 256 * j;
            float4 g4 = *(const float4*)(g2 + c), s4 = *(const float4*)(sc + c), h4 = *(const float4*)(sh + c);
            float h0 = x[j].x * r2 * g4.x * (1.f + s4.x) + h4.x;
            float h1 = x[j].y * r2 * g4.y * (1.f + s4.y) + h4.y;
            float h2 = x[j].z * r2 * g4.z * (1.f + s4.z) + h4.z;
            float h3 = x[j].w * r2 * g4.w * (1.f + s4.w) + h4.w;
            uint2 o; o.x = pack2(h0, h1); o.y = pack2(h2, h3);
            *(uint2*)(p.H + (size_t)t * DM + c) = o;
          }
        }
      }
    }
  }
}

enum { EPI_SWIGLU = 0, EPI_F32 = 1, EPI_EVIN = 2, EPI_ODIN = 3, EPI_POOL = 4 };
using f32x4 = __attribute__((ext_vector_type(4))) float;

DI int lds_byte2(int r, int c) {
  int st = (r >> 4) * 2 + (c >> 5), ob = (r & 15) * 64 + (c & 31) * 2;
  return st * 1024 + (ob ^ (((ob >> 9) & 1) << 5));
}
DI void stage_rc2(int b, int& R, int& C) {
  int st = b >> 10, sb = b & 1023, swz = sb ^ (((sb >> 9) & 1) << 5);
  R = (st >> 1) * 16 + (swz >> 6);
  C = (st & 1) * 32 + ((swz & 63) >> 1);
}
#define WAIT_V0() asm volatile("s_waitcnt vmcnt(0)" ::: "memory")

#define LDS_RD4(a, b, c, d, addr, o0, o1, o2, o3) asm volatile( \
    "ds_read_b128 %0, %4 offset:%5\n\tds_read_b128 %1, %4 offset:%6\n\tds_read_b128 %2, %4 offset:%7\n\tds_read_b128 %3, %4 offset:%8\n\ts_waitcnt lgkmcnt(0)" \
    : "=&v"(a), "=&v"(b), "=&v"(c), "=&v"(d) : "v"(addr), "n"(o0), "n"(o1), "n"(o2), "n"(o3) : "memory")
template <int EPI, int MF, bool TAIL = false>
__device__ __forceinline__ void gemm_phase(const P& p, const u16* __restrict__ A, const u16* __restrict__ Bt, int K,
                                           int nMT, int nNT, void* outp, int ldc, char* smem, int vbid, int G, int tidx, int tlimit = 1 << 30, int tbase = 0) {
  constexpr int TILE_B = 32768, STAGE_B = 65536;
  const int wid = __builtin_amdgcn_readfirstlane(tidx >> 6), lane = tidx & 63, wr = wid >> 2, wc = wid & 3, fr = lane & 15, fq = lane >> 4;
  int sOff0;
  { int R, C; stage_rc2(wid * 1024 + lane * 16, R, C); sOff0 = R * K + C; }
  const unsigned sOffB = (unsigned)sOff0 * 2u;
  const int aOff0 = lds_byte2(wr * (16 * MF) + fr, fq * 8);
  const int bOff0 = lds_byte2(wc * 64 + fr, fq * 8);
  const int ntiles = TAIL ? tlimit : min(nMT * nNT, tlimit), nt = K >> 6;
#define GLDS_STAGE(AB, BB, buf, kt) do { _Pragma("unroll") for (int i = 0; i < 4; ++i) { \
      if (wid + 8 * i < 4 * MF) __builtin_amdgcn_global_load_lds((const unsigned*)((const char*)((AB) + (size_t)(i * 64) * K + (kt) * 64) + sOffB), (unsigned*)(smem + (buf) * STAGE_B + wid * 1024 + i * 8192), 16, 0, 0); \
      __builtin_amdgcn_global_load_lds((const unsigned*)((const char*)((BB) + (size_t)(i * 64) * K + (kt) * 64) + sOffB), (unsigned*)(smem + (buf) * STAGE_B + TILE_B + wid * 1024 + i * 8192), 16, 0, 0); } } while (0)
#define TILE_COORDS(T, BR, BC) do { const int ts_ = TAIL ? tbase + ((T) >> 1) : (T); \
      const int grp_ = ts_ / (8 * nNT), r2_ = ts_ - grp_ * 8 * nNT; \
      BR = (grp_ * 8 + (r2_ & 7)) * (TAIL ? 192 : 32 * MF) + (TAIL ? ((T) & 1) * 96 : 0); BC = (r2_ >> 3) * 256; } while (0)
  if (vbid < ntiles) {
    int br_, bc_; TILE_COORDS(vbid, br_, bc_);
    GLDS_STAGE(A + (size_t)br_ * K, Bt + (size_t)bc_ * K, 0, 0);
  }
  for (int tile = vbid; tile < ntiles; tile += G) {
    int brow, bcol; TILE_COORDS(tile, brow, bcol);
    const u16* Ab = A + (size_t)brow * K;
    const u16* Bb = Bt + (size_t)bcol * K;
    f32x4 acc[MF][4];
#pragma unroll
    for (int m = 0; m < MF; ++m)
#pragma unroll
      for (int n = 0; n < 4; ++n) { acc[m][n][0] = 0.f; acc[m][n][1] = 0.f; acc[m][n][2] = 0.f; acc[m][n][3] = 0.f; }
#define LDS_RD(dst, base, off) asm volatile("ds_read_b128 %0, %1 offset:%2" : "=v"(dst) : "v"(base), "n"(off))
    bf16x8 A0[MF], B0[4], A1[MF], B1[4];
    const unsigned lbase = (unsigned)(size_t)(smem);
    WAIT_V0(); __syncthreads();
    if (nt > 1) GLDS_STAGE(Ab, Bb, 1, 1);
    asm volatile("s_waitcnt lgkmcnt(0)" ::: "memory");
    {
      const unsigned la = lbase + aOff0, lb = lbase + TILE_B + bOff0;
#pragma unroll
      for (int n = 0; n < 4; ++n) LDS_RD(B0[n], lb, n * 2048);
#pragma unroll
      for (int m = 0; m < MF; ++m) LDS_RD(A0[m], la, m * 2048);
    }
    for (int t = 0; t < nt; ++t) {
      const int cur = t & 1;
      const unsigned la = lbase + cur * STAGE_B + aOff0, lb = lbase + cur * STAGE_B + TILE_B + bOff0;
      const unsigned lan = lbase + (cur ^ 1) * STAGE_B + aOff0, lbn = lbase + (cur ^ 1) * STAGE_B + TILE_B + bOff0;
#pragma unroll
      for (int n = 0; n < 4; ++n) LDS_RD(B1[n], lb, n * 2048 + 1024);
#pragma unroll
      for (int m = 0; m < MF; ++m) LDS_RD(A1[m], la, m * 2048 + 1024);
      __builtin_amdgcn_sched_barrier(0);
#pragma unroll
      for (int m = 0; m < MF; ++m) {
        if (m == 0) asm volatile("s_waitcnt lgkmcnt(%5)" : "+v"(A0[0]), "+v"(B0[0]), "+v"(B0[1]), "+v"(B0[2]), "+v"(B0[3]) : "n"(4 + MF + MF - 1));
        else asm volatile("s_waitcnt lgkmcnt(%1)" : "+v"(A0[m]) : "n"(4 + MF + MF - 1 - m));
#pragma unroll
        for (int n = 0; n < 4; ++n) acc[m][n] = __builtin_amdgcn_mfma_f32_16x16x32_bf16(A0[m], B0[n], acc[m][n], 0, 0, 0);
        __builtin_amdgcn_sched_barrier(0);
      }
      if (MF == 3) asm volatile("s_waitcnt lgkmcnt(0)" : "+v"(A1[0]), "+v"(A1[1]), "+v"(A1[MF - 1]), "+v"(B1[0]), "+v"(B1[1]), "+v"(B1[2]), "+v"(B1[3]));
      else if (MF == 6) asm volatile("s_waitcnt lgkmcnt(0)" : "+v"(A1[0]), "+v"(A1[1]), "+v"(A1[2]), "+v"(A1[3]), "+v"(A1[4]), "+v"(A1[MF - 1]), "+v"(B1[0]), "+v"(B1[1]), "+v"(B1[2]), "+v"(B1[3]));
      else asm volatile("s_waitcnt lgkmcnt(0)" : "+v"(A1[0]), "+v"(A1[1]), "+v"(A1[2]), "+v"(A1[3]), "+v"(A1[4]), "+v"(A1[5]), "+v"(A1[MF - 2]), "+v"(A1[MF - 1]), "+v"(B1[0]), "+v"(B1[1]), "+v"(B1[2]), "+v"(B1[3]));
      WAIT_V0(); __syncthreads();
      if (t + 2 < nt) { GLDS_STAGE(Ab, Bb, cur, t + 2); }
      else if (t + 1 == nt && tile + G < ntiles) {
        int br_, bc_; TILE_COORDS(tile + G, br_, bc_);
        GLDS_STAGE(A + (size_t)br_ * K, Bt + (size_t)bc_ * K, 0, 0);
      }
      if (t + 1 < nt) {
#pragma unroll
        for (int n = 0; n < 4; ++n) LDS_RD(B0[n], lbn, n * 2048);
#pragma unroll
        for (int m = 0; m < MF; ++m) LDS_RD(A0[m], lan, m * 2048);
      }
      __builtin_amdgcn_sched_barrier(0);
#pragma unroll
      for (int m = 0; m < MF; ++m) {
#pragma unroll
        for (int n = 0; n < 4; ++n) acc[m][n] = __builtin_amdgcn_mfma_f32_16x16x32_bf16(A1[m], B1[n], acc[m][n], 0, 0, 0);
      }
      __builtin_amdgcn_sched_barrier(0);
    }
#undef LDS_RD
    int le = lane; asm volatile("" : "+v"(le));
    const int fre = le & 15, fqe = le >> 4;
    float* Ew = (float*)(smem + STAGE_B + wid * 4352);
    const int r0 = brow + wr * (16 * MF), c0 = bcol + wc * 64;
    constexpr int vlo = (EPI == EPI_EVIN) ? 1024 : 1152, vhi = (EPI == EPI_EVIN) ? 1536 : 1280;
    const bool isV = (EPI == EPI_EVIN || EPI == EPI_ODIN) && c0 >= vlo && c0 < vhi;
    float* sbase = nullptr; int hd = 0, nh = 8;
    if (EPI == EPI_EVIN) {
      if (c0 >= 512 && c0 < 1024) { sbase = p.out + OFF_SAK; hd = (c0 - 512) >> 6; }
      else if (c0 >= 1024 && c0 < 1536) { sbase = p.out + OFF_SAV; hd = (c0 - 1024) >> 6; }
    } else if (EPI == EPI_ODIN) {
      nh = 2;
      if (c0 >= 1152 && c0 < 1280) { sbase = p.out + OFF_SDV; hd = (c0 - 1152) >> 6; }
    }
    const int c4 = (le & 15) * 4;
    float4 psc = make_float4(1.f, 1.f, 1.f, 1.f);
    if (EPI == EPI_POOL) psc = *(const float4*)(p.od_pool_scale + c0 + c4);
    constexpr int ESZ = 2;
    char* orow = (EPI == EPI_SWIGLU)
        ? (char*)outp + ((size_t)(r0 + (le >> 3)) * ldc + (c0 >> 1) + (le & 7) * 4) * 2
        : (char*)outp + ((size_t)(r0 + (le >> 4)) * ldc + c0 + c4) * ESZ;
    const size_t rstride = (size_t)ldc * ESZ;
#pragma unroll
    for (int m = 0; m < MF; ++m) {
      asm volatile("" : "+v"(orow));
      const int rm = r0 + m * 16;
      float* srow = (sbase && rm < MPR) ? sbase + ((size_t)((rm >> 8) * nh + hd) * 256 + (rm & 255) + (le >> 4)) * 64 + c4 : nullptr;
      if (EPI == EPI_EVIN || EPI == EPI_ODIN) {
        if (isV) {
          const int t0 = rm + fqe * 4, kk16 = t0 & 15;
          u16* vb = p.VT + ((size_t)(((c0 - vlo) >> 6) * 384 + (t0 >> 5)) * 4 + ((t0 >> 4) & 1)) * 512 + (((kk16 >> 2) & 1) * 32) * 8 + (kk16 >> 3) * 4;
#pragma unroll
          for (int n = 0; n < 4; ++n) {
            const int dim = n * 16 + fre;
            uint2 o; o.x = pack2(acc[m][n][0], acc[m][n][1]); o.y = pack2(acc[m][n][2], acc[m][n][3]);
            *(uint2*)(vb + (dim >> 5) * 1024 + (dim & 31) * 8) = o;
          }
        }
      }
      if (EPI != EPI_SWIGLU) {
#pragma unroll
      for (int n = 0; n < 4; ++n)
#pragma unroll
        for (int j = 0; j < 4; ++j) Ew[(fqe * 4 + j) * 68 + n * 16 + fre] = acc[m][n][j];
      }
      if (EPI == EPI_EVIN) {
        if (c0 >= 512 && c0 < 1024) {
#pragma unroll
          for (int ps = 0; ps < 2; ++ps) {
            const int slot = le + 64 * ps, row = slot >> 3, ch = slot & 7;
            const float4 a = *(const float4*)(Ew + row * 68 + ch * 8), b4 = *(const float4*)(Ew + row * 68 + ch * 8 + 4);
            uint4 o; o.x = pack2(a.x, a.y); o.y = pack2(a.z, a.w); o.z = pack2(b4.x, b4.y); o.w = pack2(b4.z, b4.w);
            const int t = rm + row;
            *(uint4*)(p.KF + ((size_t)(((c0 - 512) >> 6) * 384 + (t >> 5)) * 4 + (ch >> 1)) * 512 + ((ch & 1) * 32 + (t & 31)) * 8) = o;
          }
        }
      }
      if (EPI == EPI_SWIGLU) {
        u16* ab = (u16*)outp + (size_t)(rm + fqe * 4) * ldc + (c0 >> 1) + fre;
#pragma unroll
        for (int j = 0; j < 4; ++j)
#pragma unroll
          for (int n = 0; n < 2; ++n) {
            const float g = acc[m][n][j], u = acc[m][n + 2][j];
            ab[(size_t)j * ldc + n * 16] = (u16)pack2(g / (1.f + __expf(-g)) * u, 0.f);
          }
      } else {
        f32x4 q0, q1, q2, q3;
        LDS_RD4(q0, q1, q2, q3, (unsigned)(size_t)(Ew + (le >> 4) * 68 + c4), 0, 1088, 2176, 3264);
#pragma unroll
        for (int ps = 0; ps < 4; ++ps) {
          const f32x4 qv = ps == 0 ? q0 : (ps == 1 ? q1 : (ps == 2 ? q2 : q3));
          float4 v = make_float4(qv[0], qv[1], qv[2], qv[3]);
          if (EPI == EPI_F32) {
            uint2 o; o.x = pack2(v.x, v.y); o.y = pack2(v.z, v.w);
            *(uint2*)(orow + (size_t)(4 * ps) * rstride) = o;
          } else if (EPI == EPI_POOL) {
            uint2 o; o.x = pack2(v.x * psc.x, v.y * psc.y); o.y = pack2(v.z * psc.z, v.w * psc.w);
            *(uint2*)(orow + (size_t)(4 * ps) * rstride) = o;
          } else {
            uint2 o; o.x = pack2(v.x, v.y); o.y = pack2(v.z, v.w);
            *(uint2*)(orow + (size_t)(4 * ps) * rstride) = o;
            if (srow) *(float4*)(srow + (4 * ps) * 64) = v;
          }
        }
      }
      orow += 16 * rstride;
    }
  }
#undef GLDS_STAGE
#undef TILE_COORDS
  __syncthreads();
}

struct Seg { const u16* KF; const u16* VF; int n; };

template <bool BIAS>
__device__ __forceinline__ void attn_core(const u16* __restrict__ Q, int ldq, Seg s0, Seg s1, f32x16& o0, f32x16& o1, float& m, float& l,
                                          const float* __restrict__ rpb_h, int qr, int qc0, int rs, int tidx) {
  const int lane = tidx & 63, l31 = lane & 31, lh = lane >> 5;
  bf16x8 bq[4];
#pragma unroll
  for (int kk = 0; kk < 4; ++kk) bq[kk] = *(const bf16x8*)(Q + (size_t)l31 * ldq + kk * 16 + lh * 8);
  m = -1e30f; l = 0.f;
#pragma unroll
  for (int e = 0; e < 16; ++e) { o0[e] = 0.f; o1[e] = 0.f; }
  const int qc = qc0 + l31;
  const int cs = min(max(qc - 8, 0), 48);
  const int nt0 = s0.n >> 5, ntot = nt0 + (s1.n >> 5);
  const u16* k0p = s0.KF + lane * 8;
  const u16* k1p = s1.KF + lane * 8;
  const u16* v0p = s0.VF + lane * 8;
  const u16* v1p = s1.VF + lane * 8;
  bf16x8 kA[4], kB[4], vA[4], vB[4];
#define KLOAD(dst, i_) do { const int j_ = min((i_), ntot - 1); const bool n1_ = j_ >= nt0; \
    const u16* Kp_ = n1_ ? k1p + (size_t)(j_ - nt0) * 2048 : k0p + (size_t)j_ * 2048; \
    _Pragma("unroll") for (int kk = 0; kk < 4; ++kk) dst[kk] = *(const bf16x8*)(Kp_ + kk * 512); } while (0)
#define VLOAD(dst, i_) do { const int j_ = min((i_), ntot - 1); const bool n1_ = j_ >= nt0; \
    const u16* vp_ = n1_ ? v1p + (size_t)(j_ - nt0) * 2048 : v0p + (size_t)j_ * 2048; \
    _Pragma("unroll") for (int q = 0; q < 4; ++q) dst[q] = *(const bf16x8*)(vp_ + q * 512); } while (0)
#define ATT_STEP(kf, vf, i_, kd_, vd_) do { \
    const bool in1 = (i_) >= nt0; const int kt = in1 ? (i_) - nt0 : (i_); \
    f32x16 sc; _Pragma("unroll") for (int e = 0; e < 16; ++e) sc[e] = 0.f; \
    _Pragma("unroll") for (int kk = 0; kk < 4; ++kk) sc = MFMA(kf[kk], bq[kk], sc); \
    KLOAD(kf, (i_) + (kd_)); \
    float mx = -1e30f; \
    _Pragma("unroll") for (int e = 0; e < 16; ++e) { \
      float v = sc[e] * 0.125f; \
      if (BIAS) { if (in1) { \
          const float* brow_ = rpb_h + (rs + (kt >> 1) - qr + 7) * 31;     \
          int kc = (kt & 1) * 32 + 8 * (e >> 2) + 4 * lh + (e & 3); \
          bool valid = (kc >= cs) && (kc < cs + 16); \
          unsigned co = (unsigned)min(max(kc - qc + 15, 0), 30); \
          float bv = brow_[co]; \
          v = valid ? v + bv : -1e30f; } } \
      sc[e] = v; mx = fmaxf(mx, v); \
      if (BIAS && (e & 3) == 3) __builtin_amdgcn_sched_barrier(0); } \
    mx = fmaxf(mx, __shfl_xor(mx, 32)); \
    const float mnew = fmaxf(m, mx); \
    const float corr = __expf(m - mnew); \
    float rsum = 0.f; \
    _Pragma("unroll") for (int e = 0; e < 16; ++e) { float pv = __expf(sc[e] - mnew); sc[e] = pv; rsum += pv; } \
    rsum += __shfl_xor(rsum, 32); \
    l = l * corr + rsum; m = mnew; \
    _Pragma("unroll") for (int e = 0; e < 16; ++e) { o0[e] *= corr; o1[e] *= corr; } \
    uint4 t0, t1; \
    t0.x = pack2(sc[0], sc[1]); t0.y = pack2(sc[2], sc[3]); t0.z = pack2(sc[4], sc[5]); t0.w = pack2(sc[6], sc[7]); \
    t1.x = pack2(sc[8], sc[9]); t1.y = pack2(sc[10], sc[11]); t1.z = pack2(sc[12], sc[13]); t1.w = pack2(sc[14], sc[15]); \
    const bf16x8 pb0 = __builtin_bit_cast(bf16x8, t0), pb1 = __builtin_bit_cast(bf16x8, t1); \
    o0 = MFMA(vf[0], pb0, o0); o0 = MFMA(vf[1], pb1, o0); \
    o1 = MFMA(vf[2], pb0, o1); o1 = MFMA(vf[3], pb1, o1); \
    VLOAD(vf, (i_) + (vd_)); } while (0)
  KLOAD(kA, 0); VLOAD(vA, 0);
  if (!BIAS) { KLOAD(kB, 1); VLOAD(vB, 1); }
#pragma unroll 1
  for (int i = 0; i < ntot; i += 2) {
    if (BIAS) {
      ATT_STEP(kA, vA, i, 1, 1);
      ATT_STEP(kA, vA, i + 1, 1, 1);
    } else {
      ATT_STEP(kA, vA, i, 2, 2);
      ATT_STEP(kB, vB, i + 1, 2, 2);
    }
  }
#undef KLOAD
#undef VLOAD
#undef ATT_STEP
}

__device__ __forceinline__ void attn_store(const f32x16& o0, const f32x16& o1, float inv, u16* __restrict__ O, int ldo, int tidx) {
  const int lane = tidx & 63, l31 = lane & 31, lh = lane >> 5;
  u16* op = O + (size_t)l31 * ldo + 4 * lh;
#pragma unroll
  for (int q4 = 0; q4 < 4; ++q4) {
    uint2 a, b;
    a.x = pack2(o0[4 * q4] * inv, o0[4 * q4 + 1] * inv); a.y = pack2(o0[4 * q4 + 2] * inv, o0[4 * q4 + 3] * inv);
    b.x = pack2(o1[4 * q4] * inv, o1[4 * q4 + 1] * inv); b.y = pack2(o1[4 * q4 + 2] * inv, o1[4 * q4 + 3] * inv);
    *(uint2*)(op + 8 * q4) = a;
    *(uint2*)(op + 32 + 8 * q4) = b;
  }
}

template <bool BIAS>
__device__ __forceinline__ void attn_unit(const u16* __restrict__ Q, int ldq, Seg s0, Seg s1, u16* __restrict__ O, int ldo,
                                          const float* __restrict__ rpb_h, int qr, int qc0, int rs, int tidx) {
  f32x16 o0, o1; float m, l;
  attn_core<BIAS>(Q, ldq, s0, s1, o0, o1, m, l, rpb_h, qr, qc0, rs, tidx);
  attn_store(o0, o1, 1.f / l, O, ldo, tidx);
}

__device__ void mix_even(const P& p, int gw, int W, int tidx) {
  const int lane = tidx & 63;
  const u16* U = p.ACTU;
  u16* MO = p.H;
  for (int u0 = gw; u0 < 2048 + MTOK; u0 += W) {
   for (int sub = 0; sub < 2; ++sub) {
    int u;
    if (u0 < 1024) { if (sub) break; u = u0; }
    else if (u0 < 2048) { u = 1024 + 2 * (u0 - 1024) + sub; }
    else { if (sub) break; u = u0 + 1024; }
    if (u < 1024) {
      int b = u >> 9, h = (u >> 6) & 7, r = (u >> 1) & 31, hf = u & 1;
      int tb = MPR + b * 2048;
      int rs = min(max(r - 4, 0), 24);
      Seg s0 = { p.CAK + (size_t)((b * 8 + h) * 8) * 2048, p.CAVT + (size_t)((b * 8 + h) * 8) * 2048, 256 };
      const size_t lt = (size_t)(h * 384 + ((tb + rs * 64) >> 5)) * 2048;
      Seg s1 = { p.KF + lt, p.VT + lt, 512 };
      int q0 = tb + r * 64 + hf * 32;
      attn_unit<true>(U + (size_t)q0 * 3072 + h * 64, 3072, s0, s1, MO + (size_t)q0 * DM + h * 64, DM, p.ev_rpb + h * 465, r, hf * 32, rs, tidx);
    } else if (u < 3072) {
      int v = u - 1024; int b = v >> 6, h = (v >> 3) & 7, qb = v & 7;
      const size_t lt = (size_t)(h * 384 + b * 8) * 2048;
      Seg s0 = { p.KF + lt, p.VT + lt, 256 };
      Seg s1 = { s0.KF, s0.VF, 0 };
      int q0 = b * 256 + qb * 32;
      attn_unit<false>(U + (size_t)q0 * 3072 + h * 64, 3072, s0, s1, MO + (size_t)q0 * DM + h * 64, DM, nullptr, 0, 0, 0, tidx);
    } else {
      int t = u - 3072;
      int s, L;
      if (t < MPR) { s = t & 255; L = 256; } else { s = (t - MPR) & 2047; L = 2048; }
      const int c = lane * 8;
      float z[3][8];
#pragma unroll
      for (int d = 0; d < 3; ++d) {
        int sd = s + d - 1;
        if (sd >= 0 && sd < L) {
          const u16* row = U + (size_t)(t + d - 1) * 3072;
          uint4 cg4 = *(const uint4*)(row + 2048 + c), xb4 = *(const uint4*)(row + 2560 + c);
          z[d][0] = bflo(cg4.x) * bflo(xb4.x); z[d][1] = bfhi(cg4.x) * bfhi(xb4.x);
          z[d][2] = bflo(cg4.y) * bflo(xb4.y); z[d][3] = bfhi(cg4.y) * bfhi(xb4.y);
          z[d][4] = bflo(cg4.z) * bflo(xb4.z); z[d][5] = bfhi(cg4.z) * bfhi(xb4.z);
          z[d][6] = bflo(cg4.w) * bflo(xb4.w); z[d][7] = bfhi(cg4.w) * bfhi(xb4.w);
        } else {
#pragma unroll
          for (int j = 0; j < 8; ++j) z[d][j] = 0.f;
        }
      }
      uint4 bg4 = *(const uint4*)(U + (size_t)t * 3072 + 1536 + c);
      float bg[8] = { bflo(bg4.x), bfhi(bg4.x), bflo(bg4.y), bfhi(bg4.y), bflo(bg4.z), bfhi(bg4.z), bflo(bg4.w), bfhi(bg4.w) };
      float y[8];
#pragma unroll
      for (int j = 0; j < 8; ++j) {
        float w0 = p.ev_conv_w[c + j], w1 = p.ev_conv_w[512 + c + j], w2 = p.ev_conv_w[1024 + c + j];
        y[j] = bg[j] * (z[0][j] * w0 + z[1][j] * w1 + z[2][j] * w2 + p.ev_conv_b[c + j]);
      }
      uint4 o; o.x = pack2(y[0], y[1]); o.y = pack2(y[2], y[3]); o.z = pack2(y[4], y[5]); o.w = pack2(y[6], y[7]);
      *(uint4*)(MO + (size_t)t * DM + 512 + c) = o;
    }
   }
  }
}

__device__ void mix_odd_a(const P& p, int gw, int W, int tidx) {
  const int lane = tidx & 63;
  u16* U = p.ACTU;
  u16* POOLED = (u16*)p.T;
  const float invf = exp2f(-(float)((lane >> 1) & 15) * (13.287712379549449f / 16.f));
  for (int t = gw; t < MTOK; t += W) {
    const bool smp = t >= MPR;
    int s, L, base;
    if (!smp) { s = t & 255; L = 256; base = t - s; } else { s = (t - MPR) & 2047; L = 2048; base = t - s; }
    float cs_ = 1.f, sn_ = 0.f;
    if (smp) {
      float pos = (lane < 32) ? (float)(s >> 6) : (float)(s & 63);
      float ang = pos * invf;
      cs_ = cosf(ang); sn_ = sinf(ang);
    }
    u16* row = U + (size_t)t * 1280;
#pragma unroll 1
    for (int hd = 0; hd < 10; ++hd) {
      float v = bf2f(row[512 + hd * 64 + lane]);
      float ss = wave_sum(v * v);
      float w = hd < 8 ? p.od_q_norm[lane] : p.od_k_norm[lane];
      float nv = v * rsqrtf(ss * (1.f / 64.f) + 1e-6f) * w;
      float outv = nv;
      if (smp) {
        float pr = __shfl_xor(nv, 1);
        outv = (lane & 1) ? (pr * sn_ + nv * cs_) : (nv * cs_ - pr * sn_);
      } else if (hd >= 8) {
        int b = t >> 8;
        p.out[OFF_SDK + ((size_t)(b * 2 + (hd - 8)) * 256 + s) * 64 + lane] = nv;
      }
      if (hd < 8) row[512 + hd * 64 + lane] = f2bf(outv);
      else p.KF[((size_t)((hd - 8) * 384 + (t >> 5)) * 4 + (lane >> 4)) * 512 + (((lane >> 3) & 1) * 32 + (t & 31)) * 8 + (lane & 7)] = f2bf(outv);
    }
    {
      const int half = 1 << (lane >> 4);
      const int lo = max(s - half, 0), hi = min(s + half, L);
      const int c = lane * 8;
      float a[8];
#pragma unroll
      for (int j = 0; j < 8; ++j) a[j] = 0.f;
      for (int j = lo; j < hi; ++j) {
        uint4 v = *(const uint4*)(U + (size_t)(base + j) * 1280 + c);
        a[0] += bflo(v.x); a[1] += bfhi(v.x); a[2] += bflo(v.y); a[3] += bfhi(v.y);
        a[4] += bflo(v.z); a[5] += bfhi(v.z); a[6] += bflo(v.w); a[7] += bfhi(v.w);
      }
      const float rn = 1.f / (float)(hi - lo);
      uint4 sv = *(const uint4*)(U + (size_t)t * 1280 + c);
      uint4 o;
      o.x = pack2(a[0] * rn - bflo(sv.x), a[1] * rn - bfhi(sv.x));
      o.y = pack2(a[2] * rn - bflo(sv.y), a[3] * rn - bfhi(sv.y));
      o.z = pack2(a[4] * rn - bflo(sv.z), a[5] * rn - bfhi(sv.z));
      o.w = pack2(a[6] * rn - bflo(sv.w), a[7] * rn - bfhi(sv.w));
      *(uint4*)(POOLED + (size_t)t * 512 + c) = o;
    }
  }
}

__device__ void mix_odd_b(const P& p, int gw, int W, int tidx, char* smem) {
  const u16* U = p.ACTU;
  u16* MO = p.H;
  const int lane = tidx & 63, wave = tidx >> 6;
  for (int hu = gw; hu < 2048; hu += W) {
    const int v = hu >> 1, half = hu & 1;
    const int b = v >> 9, hq = (v >> 6) & 7, qb = v & 63, kvh = hq >> 2;
    const int tb = MPR + b * 2048;
    const size_t lt = (size_t)(kvh * 384 + (tb >> 5)) * 2048;
    Seg s0, s1;
    if (half == 0) {
      s0 = Seg{ p.CDK + (size_t)((b * 2 + kvh) * 8) * 2048, p.CDVT + (size_t)((b * 2 + kvh) * 8) * 2048, 256 };
      s1 = Seg{ p.KF + lt, p.VT + lt, 896 };
    } else {
      s0 = Seg{ p.KF + lt + (size_t)28 * 2048, p.VT + lt + (size_t)28 * 2048, 1152 };
      s1 = Seg{ p.KF + lt, p.VT + lt, 0 };
    }
    const int q0 = tb + qb * 32;
    f32x16 o0, o1; float m, l;
    attn_core<false>(U + (size_t)q0 * 1280 + 512 + hq * 64, 1280, s0, s1, o0, o1, m, l, nullptr, 0, 0, 0, tidx);
    float* cb = (float*)smem + (wave >> 1) * (34 * 64) + lane;
    if (half == 1) {
      cb[0] = m; cb[64] = l;
#pragma unroll
      for (int e = 0; e < 16; ++e) { cb[(2 + e) * 64] = o0[e]; cb[(18 + e) * 64] = o1[e]; }
    }
    __syncthreads();
    if (half == 0) {
      const float m2 = cb[0], l2 = cb[64];
      const float M = fmaxf(m, m2);
      const float a1 = __expf(m - M), a2 = __expf(m2 - M);
      const float inv = 1.f / (l * a1 + l2 * a2);
#pragma unroll
      for (int e = 0; e < 16; ++e) { o0[e] = o0[e] * a1 + cb[(2 + e) * 64] * a2; o1[e] = o1[e] * a1 + cb[(18 + e) * 64] * a2; }
      attn_store(o0, o1, inv, MO + (size_t)q0 * DM + 512 + hq * 64, DM, tidx);
    }
    __syncthreads();
  }
  for (int v = gw; v < 2048; v += W) {
    int b = v >> 6, hq = (v >> 3) & 7, qb = v & 7, kvh = hq >> 2;
    const size_t lt = (size_t)(kvh * 384 + b * 8) * 2048;
    Seg s0 = { p.KF + lt, p.VT + lt, 256 };
    Seg s1 = { s0.KF, s0.VF, 0 };
    int q0 = b * 256 + qb * 32;
    attn_unit<false>(U + (size_t)q0 * 1280 + 512 + hq * 64, 1280, s0, s1, MO + (size_t)q0 * DM + 512 + hq * 64, DM, nullptr, 0, 0, 0, tidx);
  }
}

#define XB_TMO      128
#define XB_XCNT(j)  (256  + 64 * (j))
#define XB_XSUB(j)  (1280 + 64 * (j))
#define XB_XGEN(j)  (2304 + 64 * (j))
#define XB_TOP      3328
#define XB_TOPGEN   3392
#define XCD_BAR_WORDS 3456
#define XB_SPIN_CAP (1u << 20)
#define LAS __attribute__((address_space(3)))
DI unsigned xb_ld(unsigned* p)              { return __hip_atomic_load(p, __ATOMIC_RELAXED, __HIP_MEMORY_SCOPE_AGENT); }
DI unsigned xb_add(unsigned* p, unsigned v) { return __hip_atomic_fetch_add(p, v, __ATOMIC_RELAXED, __HIP_MEMORY_SCOPE_AGENT); }
DI unsigned xb_xcc_id() { return (unsigned)__builtin_amdgcn_s_getreg((3 << 11) | 20) & 0xFu; }
#define XB_SPIN(cond, bar) do { unsigned _sp = 0; while (cond) { __builtin_amdgcn_s_sleep(1); \
    if ((++_sp & 255u) == 0u) { if (xb_ld(&(bar)[XB_TMO])) break; if (_sp > XB_SPIN_CAP) { atomicAdd(&(bar)[XB_TMO], 1u); break; } } } } while (0)
struct XcdBarrier { unsigned* bar; unsigned x; volatile LAS unsigned* st; };
DI XcdBarrier xcd_barrier_post(unsigned* bar, volatile LAS unsigned* st) {
  XcdBarrier b; b.bar = bar; b.x = xb_xcc_id(); b.st = st;
  if (threadIdx.x == 0) (void)xb_add(&bar[XB_XCNT(b.x)], 1u);
  return b;
}
DI void xcd_barrier_complete(unsigned* bar, unsigned x, unsigned& nloc, unsigned& nx) {
  const unsigned G = gridDim.x * gridDim.y * gridDim.z;
  unsigned sum, cnt, mine, sp = 0u;
  for (;;) {
    sum = 0u; cnt = 0u; mine = 0u;
#pragma unroll
    for (unsigned j = 0; j < 16; ++j) { const unsigned c = xb_ld(&bar[XB_XCNT(j)]); sum += c; cnt += (c > 0u) ? 1u : 0u; mine = (j == x) ? c : mine; }
    if (sum == G) break;
    __builtin_amdgcn_s_sleep(1);
    if ((++sp & 255u) == 0u) { if (xb_ld(&bar[XB_TMO])) break; if (sp > XB_SPIN_CAP) { atomicAdd(&bar[XB_TMO], 1u); break; } }
  }
  nloc = mine > 0u ? mine : 1u; nx = cnt > 0u ? cnt : 1u;
}
DI void xcd_barrier(const XcdBarrier& b) {
  asm volatile("s_waitcnt vmcnt(0)" ::: "memory");
  __syncthreads();
  if (threadIdx.x == 0) {
    unsigned* bar = b.bar;
    __builtin_amdgcn_s_waitcnt(0);
    unsigned nloc = b.st[0], nx = b.st[1];
    if (nloc == 0u) { xcd_barrier_complete(bar, b.x, nloc, nx); b.st[0] = nloc; b.st[1] = nx; }
    const unsigned old = xb_add(&bar[XB_XSUB(b.x)], 1u);
    const unsigned gen = old / nloc;
    if (old + 1u == (gen + 1u) * nloc) {
      __builtin_amdgcn_fence(__ATOMIC_RELEASE, "agent");
      asm volatile("s_waitcnt vmcnt(0)" ::: "memory");
      const unsigned og = xb_add(&bar[XB_TOP], 1u);
      const unsigned tg = og / nx;
      if (og + 1u == (tg + 1u) * nx) xb_add(&bar[XB_TOPGEN], 1u);
      else XB_SPIN(xb_ld(&bar[XB_TOPGEN]) == tg, bar);
      __builtin_amdgcn_fence(__ATOMIC_ACQUIRE, "agent");
      xb_add(&bar[XB_XGEN(b.x)], 1u);
      asm volatile("s_waitcnt vmcnt(0)" ::: "memory");
    } else {
      XB_SPIN(xb_ld(&bar[XB_XGEN(b.x)]) == gen, bar);
      __builtin_amdgcn_fence(__ATOMIC_ACQUIRE, "agent");
      asm volatile("s_waitcnt vmcnt(0)" ::: "memory");
    }
  }
  __syncthreads();
}

constexpr int N_PHASES = 22;
#define GRID_SYNC() xcd_barrier(xb)

#define LOADP() PAK pa = pak0; asm volatile("" : "+s"(pa)); P p; \
    p.x_prompt = pa->in[0]; p.x_sample = pa->in[1]; p.cache_a_k = pa->in[2]; p.cache_a_v = pa->in[3]; p.cache_d_k = pa->in[4]; p.cache_d_v = pa->in[5]; \
    p.c = pa->in[6]; p.c_ctx = pa->in[7]; p.mod_w = pa->in[8]; p.mod_b = pa->in[9]; p.norm_w = pa->in[10]; p.ffn_w1 = pa->in[11]; p.ffn_w2 = pa->in[12]; \
    p.ev_w_in = pa->in[13]; p.ev_rpb = pa->in[14]; p.ev_conv_w = pa->in[15]; p.ev_conv_b = pa->in[16]; p.ev_w_out = pa->in[17]; \
    p.od_w_in = pa->in[18]; p.od_pool_w = pa->in[19]; p.od_pool_scale = pa->in[20]; p.od_q_norm = pa->in[21]; p.od_k_norm = pa->in[22]; p.od_w_out = pa->in[23]; \
    p.out = pa->out; \
    { char* ws = pa->ws; \
      p.W1T = (u16*)(ws + WO_W1T); p.W2T = (u16*)(ws + WO_W2T); p.EVIN = (u16*)(ws + WO_EVIN); p.EVOUT = (u16*)(ws + WO_EVOUT); \
      p.ODIN = (u16*)(ws + WO_ODIN); p.ODOUT = (u16*)(ws + WO_ODOUT); p.POOLW = (u16*)(ws + WO_POOLW); \
      p.CAK = (u16*)(ws + WO_CAK); p.CAVT = (u16*)(ws + WO_CAVT); p.CDK = (u16*)(ws + WO_CDK); p.CDVT = (u16*)(ws + WO_CDVT); \
      p.H = (u16*)(ws + WO_H); p.ACTU = (u16*)(ws + WO_ACTU); p.VT = (u16*)(ws + WO_VT); \
      p.MOD = (float*)(ws + WO_MOD); p.X = (float*)(ws + WO_X); p.T = (float*)(ws + WO_T); p.BAR = (unsigned*)(ws + WO_BAR); p.KF = (u16*)(ws + WO_KF); }
typedef const __attribute__((address_space(4))) PA* PAK;
__global__ void __launch_bounds__(NTHR, 2) mega(PA pa_unused, int ph0, int ph1) {
  __shared__ __attribute__((aligned(1024))) char smem[LDS_BYTES];
  __shared__ uint4 xb_words;
  cg::grid_group grid = cg::this_grid();
  if (ph1 == 0x7fffffff) grid.sync();
  if (threadIdx.x == 0) xb_words = make_uint4(0u, 0u, 0u, 0u);
  __syncthreads();
  const PAK pak0 = (PAK)__builtin_amdgcn_kernarg_segment_ptr();
  const XcdBarrier xb = xcd_barrier_post((unsigned*)(pak0->ws + WO_BAR), (volatile LAS unsigned*)&xb_words);
  const int G = gridDim.x, bid = blockIdx.x;
  const int vbid = (G & 7) ? bid : ((bid & 7) * (G >> 3) + (bid >> 3));
  const int W = G * (NTHR / 64);
#ifndef REPMASK
#define REPMASK 0u
#endif
  for (int ph = ph0; ph < ph1; ++ph) {
   const int nrep = ((REPMASK >> ph) & 1u) ? 2 : 1;
   for (int rep = 0; rep < nrep; ++rep) {
    if (rep) { GRID_SYNC(); }
    int tidx = threadIdx.x;
    asm volatile("" : "+v"(tidx));
    const int gw = vbid * (NTHR / 64) + __builtin_amdgcn_readfirstlane(tidx >> 6);
    if (ph == 0) {
      LOADP();
      prep_phase(p, smem, bid, G, tidx);
    } else if (ph == 21) {
      LOADP();
      r_phase<2>(p, false, true, p.norm_w + 11 * DM, p.MOD + 3 * 9216, 8, 0.5f, false, nullptr, nullptr, 0, 0, p.out, gw, W, tidx);
    } else {
      const int q = ph - 1;
      const int l = q / 10, s = q % 10;
#define NWMOD() const float* nw = p.norm_w + l * 6 * DM; const float* modl = p.MOD + l * 3 * 9216
      if (s == 3 || s == 7 || (s == 0 && l == 1)) {
        LOADP(); NWMOD();
        const float* gT = s == 0 ? p.norm_w + 5 * DM : (s == 3 ? nw + DM : nw + 3 * DM);
        const float* mg = s == 0 ? p.MOD : modl;
        const int gate = s == 0 ? 8 : (s == 3 ? 2 : 5);
        const float gs = s == 7 ? 1.0f : 0.5f;
        const float* g2 = s == 0 ? nw : (s == 3 ? nw + 2 * DM : nw + 4 * DM);
        const int shi = s == 0 ? 0 : (s == 3 ? 3 : 6);
        r_phase<1>(p, false, true, gT, mg, gate, gs, true, g2, modl, shi, shi + 1, p.X, gw, W, tidx);
      } else
      switch (s) {
        case 0: { LOADP(); NWMOD();
          r_phase<0>(p, true, false, nullptr, nullptr, 0, 0.f, true, nw, modl, 0, 1, p.X, gw, W, tidx);
        } break;
        case 1: case 8: { LOADP();
          const int f = s == 1 ? 0 : 1;
          const u16* w1 = p.W1T + (size_t)(l * 2 + f) * 5632 * 1024;
          gemm_phase<EPI_SWIGLU, 6>(p, p.H, w1, 1024, 64, 22, p.ACTU, DFF, smem, vbid, G, tidx, 1280);
          gemm_phase<EPI_SWIGLU, 3, true>(p, p.H, w1, 1024, 64, 22, p.ACTU, DFF, smem, vbid, G, tidx, 256, 1280);
        } break;
        case 2: case 9: case 6: { LOADP();
          const u16* A_ = s == 6 ? p.H : p.ACTU;
          const u16* B_ = s == 6 ? (l == 0 ? p.EVOUT : p.ODOUT) : p.W2T + (size_t)(l * 2 + (s == 2 ? 0 : 1)) * 1024 * 2816;
          gemm_phase<EPI_F32, 6>(p, A_, B_, s == 6 ? 1024 : DFF, 64, 4, p.T, DM, smem, vbid, G, tidx);
        } break;
        case 4: { LOADP();
          if (l == 0) gemm_phase<EPI_EVIN, 6>(p, p.H, p.EVIN, 1024, 64, 12, p.ACTU, 3072, smem, vbid, G, tidx);
          else {
            gemm_phase<EPI_ODIN, 6>(p, p.H, p.ODIN, 1024, 64, 5, p.ACTU, 1280, smem, vbid, G, tidx, 256);
            gemm_phase<EPI_ODIN, 3, true>(p, p.H, p.ODIN, 1024, 64, 5, p.ACTU, 1280, smem, vbid, G, tidx, 128, 256);
            GRID_SYNC();
            mix_odd_a(p, gw, W, tidx);
          }
        } break;
        case 5: { LOADP();
          if (l == 0) mix_even(p, gw, W, tidx);
          else {
            gemm_phase<EPI_POOL, 6>(p, (const u16*)p.T, p.POOLW, 512, 64, 2, p.H, DM, smem, vbid, G, tidx);
            mix_odd_b(p, gw, W, tidx, smem);
          }
        } break;
      }
    }
   }
    if (ph + 1 < ph1) { GRID_SYNC(); }
#ifdef EXTRA_SYNCS
    if (ph == 1) { for (int es = 0; es < EXTRA_SYNCS; ++es) { GRID_SYNC(); } }
#endif
  }
}

extern "C" void kernel_launch(void* const* d_in, const int* in_sizes, int n_in, void* d_out, int out_size,
                              void* d_ws, size_t ws_size, hipStream_t stream) {
  static int grid_blocks = 0;
  if (!grid_blocks) {
    int dev = 0, cus = 0, per_cu = 0;
    hipGetDevice(&dev);
    hipDeviceGetAttribute(&cus, hipDeviceAttributeMultiprocessorCount, dev);
    hipOccupancyMaxActiveBlocksPerMultiprocessor(&per_cu, mega, NTHR, 0);
    if (per_cu > 1) per_cu = 1;
    if (per_cu < 1) per_cu = 1;
    grid_blocks = cus * per_cu;
  }
  PA p{};
  for (int i = 0; i < 24; ++i) p.in[i] = (const float*)d_in[i];
  p.out = (float*)d_out;
  p.ws = (char*)d_ws;
  if (WO_END > ws_size) { fprintf(stderr, "workspace too small: need %zu have %zu\n", (size_t)WO_END, ws_size); return; }
  (void)hipMemsetAsync(p.ws + WO_BAR, 0, (size_t)XCD_BAR_WORDS * 4, stream);
  int ph0 = 0, ph1 = N_PHASES;
  void* args[] = { &p, &ph0, &ph1 };
  hipError_t e = hipLaunchCooperativeKernel((void*)mega, dim3(grid_blocks), dim3(NTHR), args, 0, stream);
  if (e != hipSuccess) fprintf(stderr, "cooperative launch failed: %s (grid %d)\n", hipGetErrorString(e), grid_blocks);
}
```

```cpp
#include <hip/hip_runtime.h>
#include <hip/hip_cooperative_groups.h>
#include <cstdio>
namespace cg = cooperative_groups;

typedef unsigned short u16;
using bf16x8 = __attribute__((ext_vector_type(8))) short;
using s16x4  = __attribute__((ext_vector_type(4))) short;
using f32x16 = __attribute__((ext_vector_type(16))) float;
#define DI __device__ __forceinline__
#define MFMA(a, b, c) __builtin_amdgcn_mfma_f32_32x32x16_bf16((a), (b), (c), 0, 0, 0)

constexpr int MTOK = 12288;
constexpr int MPR  = 8192;
constexpr int DM   = 1024;
constexpr int DFF  = 2816;
constexpr int NTHR = 512;
constexpr int LDS_BYTES = 131072;
constexpr int SROW = 72;

constexpr size_t OFF_SAK = 12582912, OFF_SAV = 16777216, OFF_SDK = 20971520, OFF_SDV = 22020096;

struct P {
  const float *x_prompt, *x_sample, *cache_a_k, *cache_a_v, *cache_d_k, *cache_d_v, *c, *c_ctx;
  const float *mod_w, *mod_b, *norm_w, *ffn_w1, *ffn_w2, *ev_w_in, *ev_rpb, *ev_conv_w, *ev_conv_b, *ev_w_out;
  const float *od_w_in, *od_pool_w, *od_pool_scale, *od_q_norm, *od_k_norm, *od_w_out;
  float* out;
  u16 *W1T, *W2T, *EVIN, *EVOUT, *ODIN, *ODOUT, *POOLW, *CAK, *CAVT, *CDK, *CDVT, *H, *ACTU, *VT, *KF;
  float *MOD, *X, *T;
  unsigned* BAR;
};
struct PA {
  const float* in[24];
  float* out;
  char* ws;
};
constexpr size_t al256(size_t b) { return (b + 255) & ~(size_t)255; }
constexpr size_t WO_W1T = 0;
constexpr size_t WO_W2T = WO_W1T + al256((size_t)4 * 5632 * 1024 * 2);
constexpr size_t WO_EVIN = WO_W2T + al256((size_t)4 * 1024 * 2816 * 2);
constexpr size_t WO_EVOUT = WO_EVIN + al256((size_t)3072 * 1024 * 2);
constexpr size_t WO_ODIN = WO_EVOUT + al256((size_t)1024 * 1024 * 2);
constexpr size_t WO_ODOUT = WO_ODIN + al256((size_t)1280 * 1024 * 2);
constexpr size_t WO_POOLW = WO_ODOUT + al256((size_t)1024 * 1024 * 2);
constexpr size_t WO_CAK = WO_POOLW + al256((size_t)512 * 512 * 2);
constexpr size_t WO_CAVT = WO_CAK + al256((size_t)262144 * 2);
constexpr size_t WO_CDK = WO_CAVT + al256((size_t)262144 * 2);
constexpr size_t WO_CDVT = WO_CDK + al256((size_t)65536 * 2);
constexpr size_t WO_H = WO_CDVT + al256((size_t)65536 * 2);
constexpr size_t WO_ACTU = WO_H + al256((size_t)12288 * 1024 * 2);
constexpr size_t WO_VT = WO_ACTU + al256((size_t)12288 * 3072 * 2);
constexpr size_t WO_MOD = WO_VT + al256((size_t)512 * 12288 * 2);
constexpr size_t WO_X = WO_MOD + al256((size_t)2 * 3 * 9216 * 4);
constexpr size_t WO_T = WO_X + al256((size_t)12288 * 1024 * 4);
constexpr size_t WO_BAR = WO_T + al256((size_t)12288 * 1024 * 4);
constexpr size_t WO_KF = WO_BAR + al256((size_t)3456 * 4);
constexpr size_t WO_END = WO_KF + al256((size_t)512 * 12288 * 2);

DI u16 f2bf(float x) { unsigned u = __float_as_uint(x); u += 0x7fffu + ((u >> 16) & 1u); return (u16)(u >> 16); }
DI float bf2f(u16 v) { return __uint_as_float(((unsigned)v) << 16); }
DI unsigned pack2(float a, float b) { unsigned r; asm("v_cvt_pk_bf16_f32 %0, %1, %2" : "=v"(r) : "v"(a), "v"(b)); return r; }
DI float wave_sum(float v) {
#pragma unroll
  for (int o = 32; o > 0; o >>= 1) v += __shfl_xor(v, o);
  return v;
}
DI float bflo(unsigned u) { return __uint_as_float(u << 16); }
DI float bfhi(unsigned u) { return __uint_as_float(u & 0xffff0000u); }

__device__ void mod_item(const P& p, int it, char* smem, int tidx) {
  float* sS = (float*)smem;
  float* red = sS + 3072;
  const int tid = tidx;
  const int l = it / 144, n0 = (it % 144) * 64;
  for (int i = tid; i < 3072; i += 256) {
    int r = i >> 10, k = i & 1023;
    float v = r == 0 ? p.c_ctx[k] : p.c[(r - 1) * 1024 + k];
    sS[i] = v / (1.f + expf(-v));
  }
  __syncthreads();
  const int kq = tid >> 4, cq = tid & 15;
  const float* w = p.mod_w + (size_t)l * 1024 * 9216 + (size_t)(kq * 64) * 9216 + n0 + cq * 4;
  float a00 = 0, a01 = 0, a02 = 0, a03 = 0, a10 = 0, a11 = 0, a12 = 0, a13 = 0, a20 = 0, a21 = 0, a22 = 0, a23 = 0;
#pragma unroll 1
  for (int k0 = 0; k0 < 64; k0 += 8) {
    float4 wv[8];
#pragma unroll
    for (int k = 0; k < 8; ++k) wv[k] = *(const float4*)(w + (size_t)(k0 + k) * 9216);
#pragma unroll
    for (int k = 0; k < 8; ++k) {
      float4 w4 = wv[k];
      float s0 = sS[kq * 64 + k0 + k], s1 = sS[1024 + kq * 64 + k0 + k], s2 = sS[2048 + kq * 64 + k0 + k];
      a00 += s0 * w4.x; a01 += s0 * w4.y; a02 += s0 * w4.z; a03 += s0 * w4.w;
      a10 += s1 * w4.x; a11 += s1 * w4.y; a12 += s1 * w4.z; a13 += s1 * w4.w;
      a20 += s2 * w4.x; a21 += s2 * w4.y; a22 += s2 * w4.z; a23 += s2 * w4.w;
    }
  }
  float* r0 = red + (kq * 3 + 0) * 64 + cq * 4;
  r0[0] = a00; r0[1] = a01; r0[2] = a02; r0[3] = a03;
  r0[64] = a10; r0[65] = a11; r0[66] = a12; r0[67] = a13;
  r0[128] = a20; r0[129] = a21; r0[130] = a22; r0[131] = a23;
  __syncthreads();
  if (tid < 192) {
    int r = tid >> 6, n = tid & 63;
    float s = p.mod_b[l * 9216 + n0 + n];
#pragma unroll
    for (int q = 0; q < 16; ++q) s += red[(q * 3 + r) * 64 + n];
    p.MOD[(l * 3 + r) * 9216 + n0 + n] = s;
  }
  __syncthreads();
}

struct TrItem { const float* src; u16* dst; int N, Kd, k0, n0, perm; };
DI TrItem tr_decode(const P& p, int idx) {
  TrItem t; t.perm = 0; int kt, nt;
  if (idx < 2816) { int mat = idx / 704, r = idx % 704; kt = r / 44; nt = r % 44; t.src = p.ffn_w1 + (size_t)mat * 1024 * 5632; t.N = 5632; t.Kd = 1024; t.dst = p.W1T + (size_t)mat * 5632 * 1024; t.perm = 1; }
  else if (idx < 4224) { int r0 = idx - 2816; int mat = r0 / 352, r = r0 % 352; kt = r / 8; nt = r % 8; t.src = p.ffn_w2 + (size_t)mat * 2816 * 1024; t.N = 1024; t.Kd = 2816; t.dst = p.W2T + (size_t)mat * 1024 * 2816; }
  else if (idx < 4608) { int r = idx - 4224; kt = r / 24; nt = r % 24; t.src = p.ev_w_in; t.N = 3072; t.Kd = 1024; t.dst = p.EVIN; }
  else if (idx < 4736) { int r = idx - 4608; kt = r / 8; nt = r % 8; t.src = p.ev_w_out; t.N = 1024; t.Kd = 1024; t.dst = p.EVOUT; }
  else if (idx < 4896) { int r = idx - 4736; kt = r / 10; nt = r % 10; t.src = p.od_w_in; t.N = 1280; t.Kd = 1024; t.dst = p.ODIN; }
  else if (idx < 5024) { int r = idx - 4896; kt = r / 8; nt = r % 8; t.src = p.od_w_out; t.N = 1024; t.Kd = 1024; t.dst = p.ODOUT; }
  else { int r = idx - 5024; int mat = r >> 1; kt = r & 1; nt = 0; t.src = p.od_pool_w + mat * 16384; t.N = 128; t.Kd = 512; t.dst = p.POOLW + (size_t)(mat * 128) * 512 + mat * 128; }
  t.k0 = kt * 64; t.n0 = nt * 128;
  return t;
}

__device__ void prep_phase(const P& p, char* smem_all, int bid, int G, int tid512) {
  constexpr int N_MOD = 288, N_TR = 5032, N_CC = 448;
  const int half = tid512 >> 8, tid = tid512 & 255;
  char* smem = smem_all + half * 36864;
  for (int pi = bid; pi < N_MOD / 2; pi += G) mod_item(p, 2 * pi + half, smem, tid);
  {
    float* tl = (float*)smem;
    const int r = tid >> 5, c4 = (tid & 31) * 4;
    float4 v[8];
    int tp = bid;
    TrItem cur{};
    if (tp < N_TR / 2) {
      cur = tr_decode(p, 2 * tp + half);
      const float* sp = cur.src + (size_t)(cur.k0 + r) * cur.N + cur.n0 + c4;
#pragma unroll
      for (int q = 0; q < 8; ++q) v[q] = *(const float4*)(sp + (size_t)(8 * q) * cur.N);
    }
    for (; tp < N_TR / 2; tp += G) {
      float* tpp = tl + r * 129 + c4;
#pragma unroll
      for (int q = 0; q < 8; ++q) { tpp[q * 8 * 129] = v[q].x; tpp[q * 8 * 129 + 1] = v[q].y; tpp[q * 8 * 129 + 2] = v[q].z; tpp[q * 8 * 129 + 3] = v[q].w; }
      __syncthreads();
      const TrItem me = cur;
      if (tp + G < N_TR / 2) {
        cur = tr_decode(p, 2 * (tp + G) + half);
        const float* sp = cur.src + (size_t)(cur.k0 + r) * cur.N + cur.n0 + c4;
#pragma unroll
        for (int q = 0; q < 8; ++q) v[q] = *(const float4*)(sp + (size_t)(8 * q) * cur.N);
      }
#pragma unroll
      for (int q = 0; q < 4; ++q) {
        int nn = (tid >> 3) + 32 * q, kc = tid & 7;
        int n = me.n0 + nn, nd = n;
        if (me.perm) nd = n < DFF ? ((n >> 5) * 64 + (n & 31)) : ((((n - DFF) >> 5) * 64) + 32 + ((n - DFF) & 31));
        const float* t = tl + (kc * 8) * 129 + nn;
        uint4 o;
        o.x = pack2(t[0], t[129]); o.y = pack2(t[258], t[387]); o.z = pack2(t[516], t[645]); o.w = pack2(t[774], t[903]);
        *(uint4*)(me.dst + (size_t)nd * me.Kd + me.k0 + kc * 8) = o;
      }
      __syncthreads();
    }
  }
  for (int pi = bid; pi < N_CC / 2; pi += G) {
    const int idx = 2 * pi + half;
    {
      int e0 = idx * 2048 + tid * 8;
#pragma unroll
      for (int j = 0; j < 8; ++j) {
        int e = e0 + j;
        if (e < 589824 && (e < 262144 || e >= 524288)) {
          const bool isA = e < 262144; const int q = isA ? e : e - 524288;
          const int x = q & 7, ln = (q >> 3) & 63, sub = (q >> 9) & 3, T = (q >> 11) & 7, bh = q >> 14;
          const int key = T * 32 + (ln & 31), d = sub * 16 + (ln >> 5) * 8 + x;
          const float v = (isA ? p.cache_a_k : p.cache_d_k)[(bh * 256 + key) * 64 + d];
          (isA ? p.CAK : p.CDK)[q] = f2bf(v);
        } else if (e < 655360) {
          const bool isA = e < 524288; const int q = isA ? e - 262144 : e - 589824;
          const int x = q & 7, ln = (q >> 3) & 63, sub = (q >> 9) & 3, T = (q >> 11) & 7, bh = q >> 14;
          const int dim = (sub >> 1) * 32 + (ln & 31), key = T * 32 + 16 * (sub & 1) + 8 * (x >> 2) + 4 * (ln >> 5) + (x & 3);
          const float v = (isA ? p.cache_a_v : p.cache_d_v)[(bh * 256 + key) * 64 + dim];
          (isA ? p.CAVT : p.CDVT)[q] = f2bf(v);
        }
        else { int q = e - 655360; int n = q >> 9, k = q & 511; if ((n >> 7) != (k >> 7)) p.POOLW[q] = 0; }
      }
    }
  }
}

template <int RMODE>
__device__ void r_phase(const P& p, bool first_unused, bool hasT_unused, const float* gT, const float* modg, int gate_idx, float gscale,
                        bool writeH, const float* g2, const float* modn, int shift_idx, int scale_idx, float* xdst, int gw, int W, int tidx) {
  const int lane = tidx & 63;
  constexpr bool first = RMODE == 0, hasT = RMODE != 0;
  constexpr int NR = 6;
  for (int t0 = gw; t0 < MTOK; t0 += NR * W) {
    float4 xf[NR][4];
    uint2 xq[NR][4], tq[NR][4];
#pragma unroll
    for (int r = 0; r < NR; ++r) {
      const int t = t0 + r * W;
      if (t < MTOK) {
        if (first) {
          const float* xs = t < MPR ? p.x_prompt + (size_t)t * DM : p.x_sample + (size_t)(t - MPR) * DM;
#pragma unroll
          for (int j = 0; j < 4; ++j) xf[r][j] = *(const float4*)(xs + lane * 4 + 256 * j);
        } else {
          const u16* xs = (const u16*)p.X + (size_t)t * DM;
          const u16* ts = (const u16*)p.T + (size_t)t * DM;
#pragma unroll
          for (int j = 0; j < 4; ++j) { xq[r][j] = *(const uint2*)(xs + lane * 4 + 256 * j); tq[r][j] = *(const uint2*)(ts + lane * 4 + 256 * j); }
        }
      }
    }
#pragma unroll
    for (int r = 0; r < NR; ++r) {
      const int t = t0 + r * W;
      if (t < MTOK) {
        const int ci = t < MPR ? 0 : 1 + ((t - MPR) >> 11);
        float4 x[4];
        if (first) {
#pragma unroll
          for (int j = 0; j < 4; ++j) x[j] = xf[r][j];
        } else {
#pragma unroll
          for (int j = 0; j < 4; ++j) x[j] = make_float4(bflo(xq[r][j].x), bfhi(xq[r][j].x), bflo(xq[r][j].y), bfhi(xq[r][j].y));
        }
        if (hasT) {
          float4 tv[4];
          float ss = 0.f;
#pragma unroll
          for (int j = 0; j < 4; ++j) {
            tv[j] = make_float4(bflo(tq[r][j].x), bfhi(tq[r][j].x), bflo(tq[r][j].y), bfhi(tq[r][j].y));
            ss += tv[j].x * tv[j].x + tv[j].y * tv[j].y + tv[j].z * tv[j].z + tv[j].w * tv[j].w;
          }
          ss = wave_sum(ss);
          const float rs = rsqrtf(ss * (1.f / 1024.f) + 1e-6f) * gscale;
          const float* mg = modg + ci * 9216 + gate_idx * 1024;
#pragma unroll
          for (int j = 0; j < 4; ++j) {
            int c = lane * 4 + 256 * j;
            float4 g4 = *(const float4*)(gT + c), m4 = *(const float4*)(mg + c);
            x[j].x += m4.x * (tv[j].x * rs * g4.x); x[j].y += m4.y * (tv[j].y * rs * g4.y);
            x[j].z += m4.z * (tv[j].z * rs * g4.z); x[j].w += m4.w * (tv[j].w * rs * g4.w);
          }
        }
        if (RMODE == 2) {
#pragma unroll
          for (int j = 0; j < 4; ++j) *(float4*)(xdst + (size_t)t * DM + lane * 4 + 256 * j) = x[j];
        } else {
#pragma unroll
          for (int j = 0; j < 4; ++j) {
            uint2 o; o.x = pack2(x[j].x, x[j].y); o.y = pack2(x[j].z, x[j].w);
            *(uint2*)((u16*)xdst + (size_t)t * DM + lane * 4 + 256 * j) = o;
          }
          float ss = 0.f;
#pragma unroll
          for (int j = 0; j < 4; ++j) ss += x[j].x * x[j].x + x[j].y * x[j].y + x[j].z * x[j].z + x[j].w * x[j].w;
          ss = wave_sum(ss);
          const float r2 = rsqrtf(ss * (1.f / 1024.f) + 1e-6f);
          const float* sh = modn + ci * 9216 + shift_idx * 1024;
          const float* sc = modn + ci * 9216 + scale_idx * 1024;
#pragma unroll
          for (int j = 0; j < 4; ++j) {
            int c = lane * 4 + 256 * j;
            float4 g4 = *(const float4*)(g2 + c), s4 = *(const float4*)(sc + c), h4 = *(const float4*)(sh + c);
            float h0 = x[j].x * r2 * g4.x * (1.f + s4.x) + h4.x;
            float h1 = x[j].y * r2 * g4.y * (1.f + s4.y) + h4.y;
            float h2 = x[j].z * r2 * g4.z * (1.f + s4.z) + h4.z;
            float h3 = x[j].w * r2 * g4.w * (1.f + s4.w) + h4.w;
            uint2 o; o.x = pack2(h0, h1); o.y = pack2(h2, h3);
            *(uint2*)(p.H + (size_t)t * DM + c) = o;
          }
        }
      }
    }
  }
}

enum { EPI_SWIGLU = 0, EPI_F32 = 1, EPI_EVIN = 2, EPI_ODIN = 3, EPI_POOL = 4 };
using f32x4 = __attribute__((ext_vector_type(4))) float;

DI int lds_byte2(int r, int c) {
  int st = (r >> 4) * 2 + (c >> 5), ob = (r & 15) * 64 + (c & 31) * 2;
  return st * 1024 + (ob ^ (((ob >> 9) & 1) << 5));
}
DI void stage_rc2(int b, int& R, int& C) {
  int st = b >> 10, sb = b & 1023, swz = sb ^ (((sb >> 9) & 1) << 5);
  R = (st >> 1) * 16 + (swz >> 6);
  C = (st & 1) * 32 + ((swz & 63) >> 1);
}
#define WAIT_V0() asm volatile("s_waitcnt vmcnt(0)" ::: "memory")

#define LDS_RD4(a, b, c, d, addr, o0, o1, o2, o3) asm volatile( \
    "ds_read_b128 %0, %4 offset:%5\n\tds_read_b128 %1, %4 offset:%6\n\tds_read_b128 %2, %4 offset:%7\n\tds_read_b128 %3, %4 offset:%8\n\ts_waitcnt lgkmcnt(0)" \
    : "=&v"(a), "=&v"(b), "=&v"(c), "=&v"(d) : "v"(addr), "n"(o0), "n"(o1), "n"(o2), "n"(o3) : "memory")
template <int EPI, int MF, bool TAIL = false>
__device__ __forceinline__ void gemm_phase(const P& p, const u16* __restrict__ A, const u16* __restrict__ Bt, int K,
                                           int nMT, int nNT, void* outp, int ldc, char* smem, int vbid, int G, int tidx, int tlimit = 1 << 30, int tbase = 0) {
  constexpr int TILE_B = 32768, STAGE_B = 65536;
  const int wid = __builtin_amdgcn_readfirstlane(tidx >> 6), lane = tidx & 63, wr = wid >> 2, wc = wid & 3, fr = lane & 15, fq = lane >> 4;
  int sOff0;
  { int R, C; stage_rc2(wid * 1024 + lane * 16, R, C); sOff0 = R * K + C; }
  const unsigned sOffB = (unsigned)sOff0 * 2u;
  const int aOff0 = lds_byte2(wr * (16 * MF) + fr, fq * 8);
  const int bOff0 = lds_byte2(wc * 64 + fr, fq * 8);
  const int ntiles = TAIL ? tlimit : min(nMT * nNT, tlimit), nt = K >> 6;
#define GLDS_STAGE(AB, BB, buf, kt) do { _Pragma("unroll") for (int i = 0; i < 4; ++i) { \
      if (wid + 8 * i < 4 * MF) __builtin_amdgcn_global_load_lds((const unsigned*)((const char*)((AB) + (size_t)(i * 64) * K + (kt) * 64) + sOffB), (unsigned*)(smem + (buf) * STAGE_B + wid * 1024 + i * 8192), 16, 0, 0); \
      __builtin_amdgcn_global_load_lds((const unsigned*)((const char*)((BB) + (size_t)(i * 64) * K + (kt) * 64) + sOffB), (unsigned*)(smem + (buf) * STAGE_B + TILE_B + wid * 1024 + i * 8192), 16, 0, 0); } } while (0)
#define TILE_COORDS(T, BR, BC) do { const int ts_ = TAIL ? tbase + ((T) >> 1) : (T); \
      const int grp_ = ts_ / (8 * nNT), r2_ = ts_ - grp_ * 8 * nNT; \
      BR = (grp_ * 8 + (r2_ & 7)) * (TAIL ? 192 : 32 * MF) + (TAIL ? ((T) & 1) * 96 : 0); BC = (r2_ >> 3) * 256; } while (0)
  if (vbid < ntiles) {
    int br_, bc_; TILE_COORDS(vbid, br_, bc_);
    GLDS_STAGE(A + (size_t)br_ * K, Bt + (size_t)bc_ * K, 0, 0);
  }
  for (int tile = vbid; tile < ntiles; tile += G) {
    int brow, bcol; TILE_COORDS(tile, brow, bcol);
    const u16* Ab = A + (size_t)brow * K;
    const u16* Bb = Bt + (size_t)bcol * K;
    f32x4 acc[MF][4];
#pragma unroll
    for (int m = 0; m < MF; ++m)
#pragma unroll
      for (int n = 0; n < 4; ++n) { acc[m][n][0] = 0.f; acc[m][n][1] = 0.f; acc[m][n][2] = 0.f; acc[m][n][3] = 0.f; }
#define LDS_RD(dst, base, off) asm volatile("ds_read_b128 %0, %1 offset:%2" : "=v"(dst) : "v"(base), "n"(off))
    bf16x8 A0[MF], B0[4], A1[MF], B1[4];
    const unsigned lbase = (unsigned)(size_t)(smem);
    WAIT_V0(); __syncthreads();
    if (nt > 1) GLDS_STAGE(Ab, Bb, 1, 1);
    asm volatile("s_waitcnt lgkmcnt(0)" ::: "memory");
    {
      const unsigned la = lbase + aOff0, lb = lbase + TILE_B + bOff0;
#pragma unroll
      for (int n = 0; n < 4; ++n) LDS_RD(B0[n], lb, n * 2048);
#pragma unroll
      for (int m = 0; m < MF; ++m) LDS_RD(A0[m], la, m * 2048);
    }
    for (int t = 0; t < nt; ++t) {
      const int cur = t & 1;
      const unsigned la = lbase + cur * STAGE_B + aOff0, lb = lbase + cur * STAGE_B + TILE_B + bOff0;
      const unsigned lan = lbase + (cur ^ 1) * STAGE_B + aOff0, lbn = lbase + (cur ^ 1) * STAGE_B + TILE_B + bOff0;
#pragma unroll
      for (int n = 0; n < 4; ++n) LDS_RD(B1[n], lb, n * 2048 + 1024);
#pragma unroll
      for (int m = 0; m < MF; ++m) LDS_RD(A1[m], la, m * 2048 + 1024);
      __builtin_amdgcn_sched_barrier(0);
#pragma unroll
      for (int m = 0; m < MF; ++m) {
        if (m == 0) asm volatile("s_waitcnt lgkmcnt(%5)" : "+v"(A0[0]), "+v"(B0[0]), "+v"(B0[1]), "+v"(B0[2]), "+v"(B0[3]) : "n"(4 + MF + MF - 1));
        else asm volatile("s_waitcnt lgkmcnt(%1)" : "+v"(A0[m]) : "n"(4 + MF + MF - 1 - m));
#pragma unroll
        for (int n = 0; n < 4; ++n) acc[m][n] = __builtin_amdgcn_mfma_f32_16x16x32_bf16(A0[m], B0[n], acc[m][n], 0, 0, 0);
        __builtin_amdgcn_sched_barrier(0);
      }
      if (MF == 3) asm volatile("s_waitcnt lgkmcnt(0)" : "+v"(A1[0]), "+v"(A1[1]), "+v"(A1[MF - 1]), "+v"(B1[0]), "+v"(B1[1]), "+v"(B1[2]), "+v"(B1[3]));
      else if (MF == 6) asm volatile("s_waitcnt lgkmcnt(0)" : "+v"(A1[0]), "+v"(A1[1]), "+v"(A1[2]), "+v"(A1[3]), "+v"(A1[4]), "+v"(A1[MF - 1]), "+v"(B1[0]), "+v"(B1[1]), "+v"(B1[2]), "+v"(B1[3]));
      else asm volatile("s_waitcnt lgkmcnt(0)" : "+v"(A1[0]), "+v"(A1[1]), "+v"(A1[2]), "+v"(A1[3]), "+v"(A1[4]), "+v"(A1[5]), "+v"(A1[MF - 2]), "+v"(A1[MF - 1]), "+v"(B1[0]), "+v"(B1[1]), "+v"(B1[2]), "+v"(B1[3]));
      WAIT_V0(); __syncthreads();
      if (t + 2 < nt) { GLDS_STAGE(Ab, Bb, cur, t + 2); }
      else if (t + 1 == nt && tile + G < ntiles) {
        int br_, bc_; TILE_COORDS(tile + G, br_, bc_);
        GLDS_STAGE(A + (size_t)br_ * K, Bt + (size_t)bc_ * K, 0, 0);
      }
      if (t + 1 < nt) {
#pragma unroll
        for (int n = 0; n < 4; ++n) LDS_RD(B0[n], lbn, n * 2048);
#pragma unroll
        for (int m = 0; m < MF; ++m) LDS_RD(A0[m], lan, m * 2048);
      }
      __builtin_amdgcn_sched_barrier(0);
#pragma unroll
      for (int m = 0; m < MF; ++m) {
#pragma unroll
        for (int n = 0; n < 4; ++n) acc[m][n] = __builtin_amdgcn_mfma_f32_16x16x32_bf16(A1[m], B1[n], acc[m][n], 0, 0, 0);
      }
      __builtin_amdgcn_sched_barrier(0);
    }
#undef LDS_RD
    int le = lane; asm volatile("" : "+v"(le));
    const int fre = le & 15, fqe = le >> 4;
    float* Ew = (float*)(smem + STAGE_B + wid * 4352);
    const int r0 = brow + wr * (16 * MF), c0 = bcol + wc * 64;
    constexpr int vlo = (EPI == EPI_EVIN) ? 1024 : 1152, vhi = (EPI == EPI_EVIN) ? 1536 : 1280;
    const bool isV = (EPI == EPI_EVIN || EPI == EPI_ODIN) && c0 >= vlo && c0 < vhi;
    float* sbase = nullptr; int hd = 0, nh = 8;
    if (EPI == EPI_EVIN) {
      if (c0 >= 512 && c0 < 1024) { sbase = p.out + OFF_SAK; hd = (c0 - 512) >> 6; }
      else if (c0 >= 1024 && c0 < 1536) { sbase = p.out + OFF_SAV; hd = (c0 - 1024) >> 6; }
    } else if (EPI == EPI_ODIN) {
      nh = 2;
      if (c0 >= 1152 && c0 < 1280) { sbase = p.out + OFF_SDV; hd = (c0 - 1152) >> 6; }
    }
    const int c4 = (le & 15) * 4;
    float4 psc = make_float4(1.f, 1.f, 1.f, 1.f);
    if (EPI == EPI_POOL) psc = *(const float4*)(p.od_pool_scale + c0 + c4);
    constexpr int ESZ = 2;
    char* orow = (EPI == EPI_SWIGLU)
        ? (char*)outp + ((size_t)(r0 + (le >> 3)) * ldc + (c0 >> 1) + (le & 7) * 4) * 2
        : (char*)outp + ((size_t)(r0 + (le >> 4)) * ldc + c0 + c4) * ESZ;
    const size_t rstride = (size_t)ldc * ESZ;
#pragma unroll
    for (int m = 0; m < MF; ++m) {
      asm volatile("" : "+v"(orow));
      const int rm = r0 + m * 16;
      float* srow = (sbase && rm < MPR) ? sbase + ((size_t)((rm >> 8) * nh + hd) * 256 + (rm & 255) + (le >> 4)) * 64 + c4 : nullptr;
      if (EPI == EPI_EVIN || EPI == EPI_ODIN) {
        if (isV) {
          const int t0 = rm + fqe * 4, kk16 = t0 & 15;
          u16* vb = p.VT + ((size_t)(((c0 - vlo) >> 6) * 384 + (t0 >> 5)) * 4 + ((t0 >> 4) & 1)) * 512 + (((kk16 >> 2) & 1) * 32) * 8 + (kk16 >> 3) * 4;
#pragma unroll
          for (int n = 0; n < 4; ++n) {
            const int dim = n * 16 + fre;
            uint2 o; o.x = pack2(acc[m][n][0], acc[m][n][1]); o.y = pack2(acc[m][n][2], acc[m][n][3]);
            *(uint2*)(vb + (dim >> 5) * 1024 + (dim & 31) * 8) = o;
          }
        }
      }
      if (EPI != EPI_SWIGLU) {
#pragma unroll
      for (int n = 0; n < 4; ++n)
#pragma unroll
        for (int j = 0; j < 4; ++j) Ew[(fqe * 4 + j) * 68 + n * 16 + fre] = acc[m][n][j];
      }
      if (EPI == EPI_EVIN) {
        if (c0 >= 512 && c0 < 1024) {
#pragma unroll
          for (int ps = 0; ps < 2; ++ps) {
            const int slot = le + 64 * ps, row = slot >> 3, ch = slot & 7;
            const float4 a = *(const float4*)(Ew + row * 68 + ch * 8), b4 = *(const float4*)(Ew + row * 68 + ch * 8 + 4);
            uint4 o; o.x = pack2(a.x, a.y); o.y = pack2(a.z, a.w); o.z = pack2(b4.x, b4.y); o.w = pack2(b4.z, b4.w);
            const int t = rm + row;
            *(uint4*)(p.KF + ((size_t)(((c0 - 512) >> 6) * 384 + (t >> 5)) * 4 + (ch >> 1)) * 512 + ((ch & 1) * 32 + (t & 31)) * 8) = o;
          }
        }
      }
      if (EPI == EPI_SWIGLU) {
        u16* ab = (u16*)outp + (size_t)(rm + fqe * 4) * ldc + (c0 >> 1) + fre;
#pragma unroll
        for (int j = 0; j < 4; ++j)
#pragma unroll
          for (int n = 0; n < 2; ++n) {
            const float g = acc[m][n][j], u = acc[m][n + 2][j];
            ab[(size_t)j * ldc + n * 16] = (u16)pack2(g / (1.f + __expf(-g)) * u, 0.f);
          }
      } else {
        f32x4 q0, q1, q2, q3;
        LDS_RD4(q0, q1, q2, q3, (unsigned)(size_t)(Ew + (le >> 4) * 68 + c4), 0, 1088, 2176, 3264);
#pragma unroll
        for (int ps = 0; ps < 4; ++ps) {
          const f32x4 qv = ps == 0 ? q0 : (ps == 1 ? q1 : (ps == 2 ? q2 : q3));
          float4 v = make_float4(qv[0], qv[1], qv[2], qv[3]);
          if (EPI == EPI_F32) {
            uint2 o; o.x = pack2(v.x, v.y); o.y = pack2(v.z, v.w);
            *(uint2*)(orow + (size_t)(4 * ps) * rstride) = o;
          } else if (EPI == EPI_POOL) {
            uint2 o; o.x = pack2(v.x * psc.x, v.y * psc.y); o.y = pack2(v.z * psc.z, v.w * psc.w);
            *(uint2*)(orow + (size_t)(4 * ps) * rstride) = o;
          } else {
            uint2 o; o.x = pack2(v.x, v.y); o.y = pack2(v.z, v.w);
            *(uint2*)(orow + (size_t)(4 * ps) * rstride) = o;
            if (srow) *(float4*)(srow + (4 * ps) * 64) = v;
          }
        }
      }
      orow += 16 * rstride;
    }
  }
#undef GLDS_STAGE
#undef TILE_COORDS
  __syncthreads();
}

struct Seg { const u16* KF; const u16* VF; int n; };

template <bool BIAS>
__device__ __forceinline__ void attn_core(const u16* __restrict__ Q, int ldq, Seg s0, Seg s1, f32x16& o0, f32x16& o1, float& m, float& l,
                                          const float* __restrict__ rpb_h, int qr, int qc0, int rs, int tidx) {
  const int lane = tidx & 63, l31 = lane & 31, lh = lane >> 5;
  bf16x8 bq[4];
#pragma unroll
  for (int kk = 0; kk < 4; ++kk) bq[kk] = *(const bf16x8*)(Q + (size_t)l31 * ldq + kk * 16 + lh * 8);
  m = -1e30f; l = 0.f;
#pragma unroll
  for (int e = 0; e < 16; ++e) { o0[e] = 0.f; o1[e] = 0.f; }
  const int qc = qc0 + l31;
  const int cs = min(max(qc - 8, 0), 48);
  const int nt0 = s0.n >> 5, ntot = nt0 + (s1.n >> 5);
  const u16* k0p = s0.KF + lane * 8;
  const u16* k1p = s1.KF + lane * 8;
  const u16* v0p = s0.VF + lane * 8;
  const u16* v1p = s1.VF + lane * 8;
  bf16x8 kA[4], kB[4], vA[4], vB[4];
#define KLOAD(dst, i_) do { const int j_ = min((i_), ntot - 1); const bool n1_ = j_ >= nt0; \
    const u16* Kp_ = n1_ ? k1p + (size_t)(j_ - nt0) * 2048 : k0p + (size_t)j_ * 2048; \
    _Pragma("unroll") for (int kk = 0; kk < 4; ++kk) dst[kk] = *(const bf16x8*)(Kp_ + kk * 512); } while (0)
#define VLOAD(dst, i_) do { const int j_ = min((i_), ntot - 1); const bool n1_ = j_ >= nt0; \
    const u16* vp_ = n1_ ? v1p + (size_t)(j_ - nt0) * 2048 : v0p + (size_t)j_ * 2048; \
    _Pragma("unroll") for (int q = 0; q < 4; ++q) dst[q] = *(const bf16x8*)(vp_ + q * 512); } while (0)
#define ATT_STEP(kf, vf, i_, kd_, vd_) do { \
    const bool in1 = (i_) >= nt0; const int kt = in1 ? (i_) - nt0 : (i_); \
    f32x16 sc; _Pragma("unroll") for (int e = 0; e < 16; ++e) sc[e] = 0.f; \
    _Pragma("unroll") for (int kk = 0; kk < 4; ++kk) sc = MFMA(kf[kk], bq[kk], sc); \
    KLOAD(kf, (i_) + (kd_)); \
    float mx = -1e30f; \
    _Pragma("unroll") for (int e = 0; e < 16; ++e) { \
      float v = sc[e] * 0.125f; \
      if (BIAS) { if (in1) { \
          const float* brow_ = rpb_h + (rs + (kt >> 1) - qr + 7) * 31;     \
          int kc = (kt & 1) * 32 + 8 * (e >> 2) + 4 * lh + (e & 3); \
          bool valid = (kc >= cs) && (kc < cs + 16); \
          unsigned co = (unsigned)min(max(kc - qc + 15, 0), 30); \
          float bv = brow_[co]; \
          v = valid ? v + bv : -1e30f; } } \
      sc[e] = v; mx = fmaxf(mx, v); \
      if (BIAS && (e & 3) == 3) __builtin_amdgcn_sched_barrier(0); } \
    mx = fmaxf(mx, __shfl_xor(mx, 32)); \
    const float mnew = fmaxf(m, mx); \
    const float corr = __expf(m - mnew); \
    float rsum = 0.f; \
    _Pragma("unroll") for (int e = 0; e < 16; ++e) { float pv = __expf(sc[e] - mnew); sc[e] = pv; rsum += pv; } \
    rsum += __shfl_xor(rsum, 32); \
    l = l * corr + rsum; m = mnew; \
    _Pragma("unroll") for (int e = 0; e < 16; ++e) { o0[e] *= corr; o1[e] *= corr; } \
    uint4 t0, t1; \
    t0.x = pack2(sc[0], sc[1]); t0.y = pack2(sc[2], sc[3]); t0.z = pack2(sc[4], sc[5]); t0.w = pack2(sc[6], sc[7]); \
    t1.x = pack2(sc[8], sc[9]); t1.y = pack2(sc[10], sc[11]); t1.z = pack2(sc[12], sc[13]); t1.w = pack2(sc[14], sc[15]); \
    const bf16x8 pb0 = __builtin_bit_cast(bf16x8, t0), pb1 = __builtin_bit_cast(bf16x8, t1); \
    o0 = MFMA(vf[0], pb0, o0); o0 = MFMA(vf[1], pb1, o0); \
    o1 = MFMA(vf[2], pb0, o1); o1 = MFMA(vf[3], pb1, o1); \
    VLOAD(vf, (i_) + (vd_)); } while (0)
  KLOAD(kA, 0); VLOAD(vA, 0);
  if (!BIAS) { KLOAD(kB, 1); VLOAD(vB, 1); }
#pragma unroll 1
  for (int i = 0; i < ntot; i += 2) {
    if (BIAS) {
      ATT_STEP(kA, vA, i, 1, 1);
      ATT_STEP(kA, vA, i + 1, 1, 1);
    } else {
      ATT_STEP(kA, vA, i, 2, 2);
      ATT_STEP(kB, vB, i + 1, 2, 2);
    }
  }
#undef KLOAD
#undef VLOAD
#undef ATT_STEP
}

__device__ __forceinline__ void attn_store(const f32x16& o0, const f32x16& o1, float inv, u16* __restrict__ O, int ldo, int tidx) {
  const int lane = tidx & 63, l31 = lane & 31, lh = lane >> 5;
  u16* op = O + (size_t)l31 * ldo + 4 * lh;
#pragma unroll
  for (int q4 = 0; q4 < 4; ++q4) {
    uint2 a, b;
    a.x = pack2(o0[4 * q4] * inv, o0[4 * q4 + 1] * inv); a.y = pack2(o0[4 * q4 + 2] * inv, o0[4 * q4 + 3] * inv);
    b.x = pack2(o1[4 * q4] * inv, o1[4 * q4 + 1] * inv); b.y = pack2(o1[4 * q4 + 2] * inv, o1[4 * q4 + 3] * inv);
    *(uint2*)(op + 8 * q4) = a;
    *(uint2*)(op + 32 + 8 * q4) = b;
  }
}

template <bool BIAS>
__device__ __forceinline__ void attn_unit(const u16* __restrict__ Q, int ldq, Seg s0, Seg s1, u16* __restrict__ O, int ldo,
                                          const float* __restrict__ rpb_h, int qr, int qc0, int rs, int tidx) {
  f32x16 o0, o1; float m, l;
  attn_core<BIAS>(Q, ldq, s0, s1, o0, o1, m, l, rpb_h, qr, qc0, rs, tidx);
  attn_store(o0, o1, 1.f / l, O, ldo, tidx);
}

__device__ void mix_even(const P& p, int gw, int W, int tidx) {
  const int lane = tidx & 63;
  const u16* U = p.ACTU;
  u16* MO = p.H;
  for (int u0 = gw; u0 < 2048 + MTOK; u0 += W) {
   for (int sub = 0; sub < 2; ++sub) {
    int u;
    if (u0 < 1024) { if (sub) break; u = u0; }
    else if (u0 < 2048) { u = 1024 + 2 * (u0 - 1024) + sub; }
    else { if (sub) break; u = u0 + 1024; }
    if (u < 1024) {
      int b = u >> 9, h = (u >> 6) & 7, r = (u >> 1) & 31, hf = u & 1;
      int tb = MPR + b * 2048;
      int rs = min(max(r - 4, 0), 24);
      Seg s0 = { p.CAK + (size_t)((b * 8 + h) * 8) * 2048, p.CAVT + (size_t)((b * 8 + h) * 8) * 2048, 256 };
      const size_t lt = (size_t)(h * 384 + ((tb + rs * 64) >> 5)) * 2048;
      Seg s1 = { p.KF + lt, p.VT + lt, 512 };
      int q0 = tb + r * 64 + hf * 32;
      attn_unit<true>(U + (size_t)q0 * 3072 + h * 64, 3072, s0, s1, MO + (size_t)q0 * DM + h * 64, DM, p.ev_rpb + h * 465, r, hf * 32, rs, tidx);
    } else if (u < 3072) {
      int v = u - 1024; int b = v >> 6, h = (v >> 3) & 7, qb = v & 7;
      const size_t lt = (size_t)(h * 384 + b * 8) * 2048;
      Seg s0 = { p.KF + lt, p.VT + lt, 256 };
      Seg s1 = { s0.KF, s0.VF, 0 };
      int q0 = b * 256 + qb * 32;
      attn_unit<false>(U + (size_t)q0 * 3072 + h * 64, 3072, s0, s1, MO + (size_t)q0 * DM + h * 64, DM, nullptr, 0, 0, 0, tidx);
    } else {
      int t = u - 3072;
      int s, L;
      if (t < MPR) { s = t & 255; L = 256; } else { s = (t - MPR) & 2047; L = 2048; }
      const int c = lane * 8;
      float z[3][8];
#pragma unroll
      for (int d = 0; d < 3; ++d) {
        int sd = s + d - 1;
        if (sd >= 0 && sd < L) {
          const u16* row = U + (size_t)(t + d - 1) * 3072;
          uint4 cg4 = *(const uint4*)(row + 2048 + c), xb4 = *(const uint4*)(row + 2560 + c);
          z[d][0] = bflo(cg4.x) * bflo(xb4.x); z[d][1] = bfhi(cg4.x) * bfhi(xb4.x);
          z[d][2] = bflo(cg4.y) * bflo(xb4.y); z[d][3] = bfhi(cg4.y) * bfhi(xb4.y);
          z[d][4] = bflo(cg4.z) * bflo(xb4.z); z[d][5] = bfhi(cg4.z) * bfhi(xb4.z);
          z[d][6] = bflo(cg4.w) * bflo(xb4.w); z[d][7] = bfhi(cg4.w) * bfhi(xb4.w);
        } else {
#pragma unroll
          for (int j = 0; j < 8; ++j) z[d][j] = 0.f;
        }
      }
      uint4 bg4 = *(const uint4*)(U + (size_t)t * 3072 + 1536 + c);
      float bg[8] = { bflo(bg4.x), bfhi(bg4.x), bflo(bg4.y), bfhi(bg4.y), bflo(bg4.z), bfhi(bg4.z), bflo(bg4.w), bfhi(bg4.w) };
      float y[8];
#pragma unroll
      for (int j = 0; j < 8; ++j) {
        float w0 = p.ev_conv_w[c + j], w1 = p.ev_conv_w[512 + c + j], w2 = p.ev_conv_w[1024 + c + j];
        y[j] = bg[j] * (z[0][j] * w0 + z[1][j] * w1 + z[2][j] * w2 + p.ev_conv_b[c + j]);
      }
      uint4 o; o.x = pack2(y[0], y[1]); o.y = pack2(y[2], y[3]); o.z = pack2(y[4], y[5]); o.w = pack2(y[6], y[7]);
      *(uint4*)(MO + (size_t)t * DM + 512 + c) = o;
    }
   }
  }
}

__device__ void mix_odd_a(const P& p, int gw, int W, int tidx) {
  const int lane = tidx & 63;
  u16* U = p.ACTU;
  u16* POOLED = (u16*)p.T;
  const float invf = exp2f(-(float)((lane >> 1) & 15) * (13.287712379549449f / 16.f));
  for (int t = gw; t < MTOK; t += W) {
    const bool smp = t >= MPR;
    int s, L, base;
    if (!smp) { s = t & 255; L = 256; base = t - s; } else { s = (t - MPR) & 2047; L = 2048; base = t - s; }
    float cs_ = 1.f, sn_ = 0.f;
    if (smp) {
      float pos = (lane < 32) ? (float)(s >> 6) : (float)(s & 63);
      float ang = pos * invf;
      cs_ = cosf(ang); sn_ = sinf(ang);
    }
    u16* row = U + (size_t)t * 1280;
#pragma unroll 1
    for (int hd = 0; hd < 10; ++hd) {
      float v = bf2f(row[512 + hd * 64 + lane]);
      float ss = wave_sum(v * v);
      float w = hd < 8 ? p.od_q_norm[lane] : p.od_k_norm[lane];
      float nv = v * rsqrtf(ss * (1.f / 64.f) + 1e-6f) * w;
      float outv = nv;
      if (smp) {
        float pr = __shfl_xor(nv, 1);
        outv = (lane & 1) ? (pr * sn_ + nv * cs_) : (nv * cs_ - pr * sn_);
      } else if (hd >= 8) {
        int b = t >> 8;
        p.out[OFF_SDK + ((size_t)(b * 2 + (hd - 8)) * 256 + s) * 64 + lane] = nv;
      }
      if (hd < 8) row[512 + hd * 64 + lane] = f2bf(outv);
      else p.KF[((size_t)((hd - 8) * 384 + (t >> 5)) * 4 + (lane >> 4)) * 512 + (((lane >> 3) & 1) * 32 + (t & 31)) * 8 + (lane & 7)] = f2bf(outv);
    }
    {
      const int half = 1 << (lane >> 4);
      const int lo = max(s - half, 0), hi = min(s + half, L);
      const int c = lane * 8;
      float a[8];
#pragma unroll
      for (int j = 0; j < 8; ++j) a[j] = 0.f;
      for (int j = lo; j < hi; ++j) {
        uint4 v = *(const uint4*)(U + (size_t)(base + j) * 1280 + c);
        a[0] += bflo(v.x); a[1] += bfhi(v.x); a[2] += bflo(v.y); a[3] += bfhi(v.y);
        a[4] += bflo(v.z); a[5] += bfhi(v.z); a[6] += bflo(v.w); a[7] += bfhi(v.w);
      }
      const float rn = 1.f / (float)(hi - lo);
      uint4 sv = *(const uint4*)(U + (size_t)t * 1280 + c);
      uint4 o;
      o.x = pack2(a[0] * rn - bflo(sv.x), a[1] * rn - bfhi(sv.x));
      o.y = pack2(a[2] * rn - bflo(sv.y), a[3] * rn - bfhi(sv.y));
      o.z = pack2(a[4] * rn - bflo(sv.z), a[5] * rn - bfhi(sv.z));
      o.w = pack2(a[6] * rn - bflo(sv.w), a[7] * rn - bfhi(sv.w));
      *(uint4*)(POOLED + (size_t)t * 512 + c) = o;
    }
  }
}

__device__ void mix_odd_b(const P& p, int gw, int W, int tidx, char* smem) {
  const u16* U = p.ACTU;
  u16* MO = p.H;
  const int lane = tidx & 63, wave = tidx >> 6;
  for (int hu = gw; hu < 2048; hu += W) {
    const int v = hu >> 1, half = hu & 1;
    const int b = v >> 9, hq = (v >> 6) & 7, qb = v & 63, kvh = hq >> 2;
    const int tb = MPR + b * 2048;
    const size_t lt = (size_t)(kvh * 384 + (tb >> 5)) * 2048;
    Seg s0, s1;
    if (half == 0) {
      s0 = Seg{ p.CDK + (size_t)((b * 2 + kvh) * 8) * 2048, p.CDVT + (size_t)((b * 2 + kvh) * 8) * 2048, 256 };
      s1 = Seg{ p.KF + lt, p.VT + lt, 896 };
    } else {
      s0 = Seg{ p.KF + lt + (size_t)28 * 2048, p.VT + lt + (size_t)28 * 2048, 1152 };
      s1 = Seg{ p.KF + lt, p.VT + lt, 0 };
    }
    const int q0 = tb + qb * 32;
    f32x16 o0, o1; float m, l;
    attn_core<false>(U + (size_t)q0 * 1280 + 512 + hq * 64, 1280, s0, s1, o0, o1, m, l, nullptr, 0, 0, 0, tidx);
    float* cb = (float*)smem + (wave >> 1) * (34 * 64) + lane;
    if (half == 1) {
      cb[0] = m; cb[64] = l;
#pragma unroll
      for (int e = 0; e < 16; ++e) { cb[(2 + e) * 64] = o0[e]; cb[(18 + e) * 64] = o1[e]; }
    }
    __syncthreads();
    if (half == 0) {
      const float m2 = cb[0], l2 = cb[64];
      const float M = fmaxf(m, m2);
      const float a1 = __expf(m - M), a2 = __expf(m2 - M);
      const float inv = 1.f / (l * a1 + l2 * a2);
#pragma unroll
      for (int e = 0; e < 16; ++e) { o0[e] = o0[e] * a1 + cb[(2 + e) * 64] * a2; o1[e] = o1[e] * a1 + cb[(18 + e) * 64] * a2; }
      attn_store(o0, o1, inv, MO + (size_t)q0 * DM + 512 + hq * 64, DM, tidx);
    }
    __syncthreads();
  }
  for (int v = gw; v < 2048; v += W) {
    int b = v >> 6, hq = (v >> 3) & 7, qb = v & 7, kvh = hq >> 2;
    const size_t lt = (size_t)(kvh * 384 + b * 8) * 2048;
    Seg s0 = { p.KF + lt, p.VT + lt, 256 };
    Seg s1 = { s0.KF, s0.VF, 0 };
    int q0 = b * 256 + qb * 32;
    attn_unit<false>(U + (size_t)q0 * 1280 + 512 + hq * 64, 1280, s0, s1, MO + (size_t)q0 * DM + 512 + hq * 64, DM, nullptr, 0, 0, 0, tidx);
  }
}

#define XB_TMO      128
#define XB_XCNT(j)  (256  + 64 * (j))
#define XB_XSUB(j)  (1280 + 64 * (j))
#define XB_XGEN(j)  (2304 + 64 * (j))
#define XB_TOP      3328
#define XB_TOPGEN   3392
#define XCD_BAR_WORDS 3456
#define XB_SPIN_CAP (1u << 20)
#define LAS __attribute__((address_space(3)))
DI unsigned xb_ld(unsigned* p)              { return __hip_atomic_load(p, __ATOMIC_RELAXED, __HIP_MEMORY_SCOPE_AGENT); }
DI unsigned xb_add(unsigned* p, unsigned v) { return __hip_atomic_fetch_add(p, v, __ATOMIC_RELAXED, __HIP_MEMORY_SCOPE_AGENT); }
DI unsigned xb_xcc_id() { return (unsigned)__builtin_amdgcn_s_getreg((3 << 11) | 20) & 0xFu; }
#define XB_SPIN(cond, bar) do { unsigned _sp = 0; while (cond) { __builtin_amdgcn_s_sleep(1); \
    if ((++_sp & 255u) == 0u) { if (xb_ld(&(bar)[XB_TMO])) break; if (_sp > XB_SPIN_CAP) { atomicAdd(&(bar)[XB_TMO], 1u); break; } } } } while (0)
struct XcdBarrier { unsigned* bar; unsigned x; volatile LAS unsigned* st; };
DI XcdBarrier xcd_barrier_post(unsigned* bar, volatile LAS unsigned* st) {
  XcdBarrier b; b.bar = bar; b.x = xb_xcc_id(); b.st = st;
  if (threadIdx.x == 0) (void)xb_add(&bar[XB_XCNT(b.x)], 1u);
  return b;
}
DI void xcd_barrier_complete(unsigned* bar, unsigned x, unsigned& nloc, unsigned& nx) {
  const unsigned G = gridDim.x * gridDim.y * gridDim.z;
  unsigned sum, cnt, mine, sp = 0u;
  for (;;) {
    sum = 0u; cnt = 0u; mine = 0u;
#pragma unroll
    for (unsigned j = 0; j < 16; ++j) { const unsigned c = xb_ld(&bar[XB_XCNT(j)]); sum += c; cnt += (c > 0u) ? 1u : 0u; mine = (j == x) ? c : mine; }
    if (sum == G) break;
    __builtin_amdgcn_s_sleep(1);
    if ((++sp & 255u) == 0u) { if (xb_ld(&bar[XB_TMO])) break; if (sp > XB_SPIN_CAP) { atomicAdd(&bar[XB_TMO], 1u); break; } }
  }
  nloc = mine > 0u ? mine : 1u; nx = cnt > 0u ? cnt : 1u;
}
DI void xcd_barrier(const XcdBarrier& b) {
  asm volatile("s_waitcnt vmcnt(0)" ::: "memory");
  __syncthreads();
  if (threadIdx.x == 0) {
    unsigned* bar = b.bar;
    __builtin_amdgcn_s_waitcnt(0);
    unsigned nloc = b.st[0], nx = b.st[1];
    if (nloc == 0u) { xcd_barrier_complete(bar, b.x, nloc, nx); b.st[0] = nloc; b.st[1] = nx; }
    const unsigned old = xb_add(&bar[XB_XSUB(b.x)], 1u);
    const unsigned gen = old / nloc;
    if (old + 1u == (gen + 1u) * nloc) {
      __builtin_amdgcn_fence(__ATOMIC_RELEASE, "agent");
      asm volatile("s_waitcnt vmcnt(0)" ::: "memory");
      const unsigned og = xb_add(&bar[XB_TOP], 1u);
      const unsigned tg = og / nx;
      if (og + 1u == (tg + 1u) * nx) xb_add(&bar[XB_TOPGEN], 1u);
      else XB_SPIN(xb_ld(&bar[XB_TOPGEN]) == tg, bar);
      __builtin_amdgcn_fence(__ATOMIC_ACQUIRE, "agent");
      xb_add(&bar[XB_XGEN(b.x)], 1u);
      asm volatile("s_waitcnt vmcnt(0)" ::: "memory");
    } else {
      XB_SPIN(xb_ld(&bar[XB_XGEN(b.x)]) == gen, bar);
      __builtin_amdgcn_fence(__ATOMIC_ACQUIRE, "agent");
      asm volatile("s_waitcnt vmcnt(0)" ::: "memory");
    }
  }
  __syncthreads();
}

constexpr int N_PHASES = 22;
#define GRID_SYNC() xcd_barrier(xb)

#define LOADP() PAK pa = pak0; asm volatile("" : "+s"(pa)); P p; \
    p.x_prompt = pa->in[0]; p.x_sample = pa->in[1]; p.cache_a_k = pa->in[2]; p.cache_a_v = pa->in[3]; p.cache_d_k = pa->in[4]; p.cache_d_v = pa->in[5]; \
    p.c = pa->in[6]; p.c_ctx = pa->in[7]; p.mod_w = pa->in[8]; p.mod_b = pa->in[9]; p.norm_w = pa->in[10]; p.ffn_w1 = pa->in[11]; p.ffn_w2 = pa->in[12]; \
    p.ev_w_in = pa->in[13]; p.ev_rpb = pa->in[14]; p.ev_conv_w = pa->in[15]; p.ev_conv_b = pa->in[16]; p.ev_w_out = pa->in[17]; \
    p.od_w_in = pa->in[18]; p.od_pool_w = pa->in[19]; p.od_pool_scale = pa->in[20]; p.od_q_norm = pa->in[21]; p.od_k_norm = pa->in[22]; p.od_w_out = pa->in[23]; \
    p.out = pa->out; \
    { char* ws = pa->ws; \
      p.W1T = (u16*)(ws + WO_W1T); p.W2T = (u16*)(ws + WO_W2T); p.EVIN = (u16*)(ws + WO_EVIN); p.EVOUT = (u16*)(ws + WO_EVOUT); \
      p.ODIN = (u16*)(ws + WO_ODIN); p.ODOUT = (u16*)(ws + WO_ODOUT); p.POOLW = (u16*)(ws + WO_POOLW); \
      p.CAK = (u16*)(ws + WO_CAK); p.CAVT = (u16*)(ws + WO_CAVT); p.CDK = (u16*)(ws + WO_CDK); p.CDVT = (u16*)(ws + WO_CDVT); \
      p.H = (u16*)(ws + WO_H); p.ACTU = (u16*)(ws + WO_ACTU); p.VT = (u16*)(ws + WO_VT); \
      p.MOD = (float*)(ws + WO_MOD); p.X = (float*)(ws + WO_X); p.T = (float*)(ws + WO_T); p.BAR = (unsigned*)(ws + WO_BAR); p.KF = (u16*)(ws + WO_KF); }
typedef const __attribute__((address_space(4))) PA* PAK;
__global__ void __launch_bounds__(NTHR, 2) mega(PA pa_unused, int ph0, int ph1) {
  __shared__ __attribute__((aligned(1024))) char smem[LDS_BYTES];
  __shared__ uint4 xb_words;
  cg::grid_group grid = cg::this_grid();
  if (ph1 == 0x7fffffff) grid.sync();
  if (threadIdx.x == 0) xb_words = make_uint4(0u, 0u, 0u, 0u);
  __syncthreads();
  const PAK pak0 = (PAK)__builtin_amdgcn_kernarg_segment_ptr();
  const XcdBarrier xb = xcd_barrier_post((unsigned*)(pak0->ws + WO_BAR), (volatile LAS unsigned*)&xb_words);
  const int G = gridDim.x, bid = blockIdx.x;
  const int vbid = (G & 7) ? bid : ((bid & 7) * (G >> 3) + (bid >> 3));
  const int W = G * (NTHR / 64);
#ifndef REPMASK
#define REPMASK 0u
#endif
  for (int ph = ph0; ph < ph1; ++ph) {
   const int nrep = ((REPMASK >> ph) & 1u) ? 2 : 1;
   for (int rep = 0; rep < nrep; ++rep) {
    if (rep) { GRID_SYNC(); }
    int tidx = threadIdx.x;
    asm volatile("" : "+v"(tidx));
    const int gw = vbid * (NTHR / 64) + __builtin_amdgcn_readfirstlane(tidx >> 6);
    if (ph == 0) {
      LOADP();
      prep_phase(p, smem, bid, G, tidx);
    } else if (ph == 21) {
      LOADP();
      r_phase<2>(p, false, true, p.norm_w + 11 * DM, p.MOD + 3 * 9216, 8, 0.5f, false, nullptr, nullptr, 0, 0, p.out, gw, W, tidx);
    } else {
      const int q = ph - 1;
      const int l = q / 10, s = q % 10;
#define NWMOD() const float* nw = p.norm_w + l * 6 * DM; const float* modl = p.MOD + l * 3 * 9216
      if (s == 3 || s == 7 || (s == 0 && l == 1)) {
        LOADP(); NWMOD();
        const float* gT = s == 0 ? p.norm_w + 5 * DM : (s == 3 ? nw + DM : nw + 3 * DM);
        const float* mg = s == 0 ? p.MOD : modl;
        const int gate = s == 0 ? 8 : (s == 3 ? 2 : 5);
        const float gs = s == 7 ? 1.0f : 0.5f;
        const float* g2 = s == 0 ? nw : (s == 3 ? nw + 2 * DM : nw + 4 * DM);
        const int shi = s == 0 ? 0 : (s == 3 ? 3 : 6);
        r_phase<1>(p, false, true, gT, mg, gate, gs, true, g2, modl, shi, shi + 1, p.X, gw, W, tidx);
      } else
      switch (s) {
        case 0: { LOADP(); NWMOD();
          r_phase<0>(p, true, false, nullptr, nullptr, 0, 0.f, true, nw, modl, 0, 1, p.X, gw, W, tidx);
        } break;
        case 1: case 8: { LOADP();
          const int f = s == 1 ? 0 : 1;
          const u16* w1 = p.W1T + (size_t)(l * 2 + f) * 5632 * 1024;
          gemm_phase<EPI_SWIGLU, 6>(p, p.H, w1, 1024, 64, 22, p.ACTU, DFF, smem, vbid, G, tidx, 1280);
          gemm_phase<EPI_SWIGLU, 3, true>(p, p.H, w1, 1024, 64, 22, p.ACTU, DFF, smem, vbid, G, tidx, 256, 1280);
        } break;
        case 2: case 9: case 6: { LOADP();
          const u16* A_ = s == 6 ? p.H : p.ACTU;
          const u16* B_ = s == 6 ? (l == 0 ? p.EVOUT : p.ODOUT) : p.W2T + (size_t)(l * 2 + (s == 2 ? 0 : 1)) * 1024 * 2816;
          gemm_phase<EPI_F32, 6>(p, A_, B_, s == 6 ? 1024 : DFF, 64, 4, p.T, DM, smem, vbid, G, tidx);
        } break;
        case 4: { LOADP();
          if (l == 0) gemm_phase<EPI_EVIN, 6>(p, p.H, p.EVIN, 1024, 64, 12, p.ACTU, 3072, smem, vbid, G, tidx);
          else {
            gemm_phase<EPI_ODIN, 6>(p, p.H, p.ODIN, 1024, 64, 5, p.ACTU, 1280, smem, vbid, G, tidx, 256);
            gemm_phase<EPI_ODIN, 3, true>(p, p.H, p.ODIN, 1024, 64, 5, p.ACTU, 1280, smem, vbid, G, tidx, 128, 256);
            GRID_SYNC();
            mix_odd_a(p, gw, W, tidx);
          }
        } break;
        case 5: { LOADP();
          if (l == 0) mix_even(p, gw, W, tidx);
          else {
            gemm_phase<EPI_POOL, 3>(p, (const u16*)p.T, p.POOLW, 512, 128, 2, p.H, DM, smem, vbid, G, tidx);
            mix_odd_b(p, gw, W, tidx, smem);
          }
        } break;
      }
    }
   }
    if (ph + 1 < ph1) { GRID_SYNC(); }
#ifdef EXTRA_SYNCS
    if (ph == 1) { for (int es = 0; es < EXTRA_SYNCS; ++es) { GRID_SYNC(); } }
#endif
  }
}

extern "C" void kernel_launch(void* const* d_in, const int* in_sizes, int n_in, void* d_out, int out_size,
                              void* d_ws, size_t ws_size, hipStream_t stream) {
  static int grid_blocks = 0;
  if (!grid_blocks) {
    int dev = 0, cus = 0, per_cu = 0;
    hipGetDevice(&dev);
    hipDeviceGetAttribute(&cus, hipDeviceAttributeMultiprocessorCount, dev);
    hipOccupancyMaxActiveBlocksPerMultiprocessor(&per_cu, mega, NTHR, 0);
    if (per_cu > 1) per_cu = 1;
    if (per_cu < 1) per_cu = 1;
    grid_blocks = cus * per_cu;
  }
  PA p{};
  for (int i = 0; i < 24; ++i) p.in[i] = (const float*)d_in[i];
  p.out = (float*)d_out;
  p.ws = (char*)d_ws;
  if (WO_END > ws_size) { fprintf(stderr, "workspace too small: need %zu have %zu\n", (size_t)WO_END, ws_size); return; }
  (void)hipMemsetAsync(p.ws + WO_BAR, 0, (size_t)XCD_BAR_WORDS * 4, stream);
  int ph0 = 0, ph1 = N_PHASES;
  void* args[] = { &p, &ph0, &ph1 };
  hipError_t e = hipLaunchCooperativeKernel((void*)mega, dim3(grid_blocks), dim3(NTHR), args, 0, stream);
  if (e != hipSuccess) fprintf(stderr, "cooperative launch failed: %s (grid %d)\n", hipGetErrorString(e), grid_blocks);
}
```

```cpp
#include <hip/hip_runtime.h>
#include <hip/hip_cooperative_groups.h>
#include <cstdio>
namespace cg = cooperative_groups;

typedef unsigned short u16;
using bf16x8 = __attribute__((ext_vector_type(8))) short;
using s16x4  = __attribute__((ext_vector_type(4))) short;
using f32x16 = __attribute__((ext_vector_type(16))) float;
#define DI __device__ __forceinline__
#define MFMA(a, b, c) __builtin_amdgcn_mfma_f32_32x32x16_bf16((a), (b), (c), 0, 0, 0)

constexpr int MTOK = 12288;
constexpr int MPR  = 8192;
constexpr int DM   = 1024;
constexpr int DFF  = 2816;
constexpr int NTHR = 512;
constexpr int LDS_BYTES = 131072;
constexpr int SROW = 72;

constexpr size_t OFF_SAK = 12582912, OFF_SAV = 16777216, OFF_SDK = 20971520, OFF_SDV = 22020096;

struct P {
  const float *x_prompt, *x_sample, *cache_a_k, *cache_a_v, *cache_d_k, *cache_d_v, *c, *c_ctx;
  const float *mod_w, *mod_b, *norm_w, *ffn_w1, *ffn_w2, *ev_w_in, *ev_rpb, *ev_conv_w, *ev_conv_b, *ev_w_out;
  const float *od_w_in, *od_pool_w, *od_pool_scale, *od_q_norm, *od_k_norm, *od_w_out;
  float* out;
  u16 *W1T, *W2T, *EVIN, *EVOUT, *ODIN, *ODOUT, *POOLW, *CAK, *CAVT, *CDK, *CDVT, *H, *ACTU, *VT, *KF;
  float *MOD, *X, *T;
  unsigned* BAR;
  float* XCH;
};
struct PA {
  const float* in[24];
  float* out;
  char* ws;
};
constexpr size_t al256(size_t b) { return (b + 255) & ~(size_t)255; }
constexpr size_t WO_W1T = 0;
constexpr size_t WO_W2T = WO_W1T + al256((size_t)4 * 5632 * 1024 * 2);
constexpr size_t WO_EVIN = WO_W2T + al256((size_t)4 * 1024 * 2816 * 2);
constexpr size_t WO_EVOUT = WO_EVIN + al256((size_t)3072 * 1024 * 2);
constexpr size_t WO_ODIN = WO_EVOUT + al256((size_t)1024 * 1024 * 2);
constexpr size_t WO_ODOUT = WO_ODIN + al256((size_t)1280 * 1024 * 2);
constexpr size_t WO_POOLW = WO_ODOUT + al256((size_t)1024 * 1024 * 2);
constexpr size_t WO_CAK = WO_POOLW + al256((size_t)512 * 512 * 2);
constexpr size_t WO_CAVT = WO_CAK + al256((size_t)262144 * 2);
constexpr size_t WO_CDK = WO_CAVT + al256((size_t)262144 * 2);
constexpr size_t WO_CDVT = WO_CDK + al256((size_t)65536 * 2);
constexpr size_t WO_H = WO_CDVT + al256((size_t)65536 * 2);
constexpr size_t WO_ACTU = WO_H + al256((size_t)12288 * 1024 * 2);
constexpr size_t WO_VT = WO_ACTU + al256((size_t)12288 * 3072 * 2);
constexpr size_t WO_MOD = WO_VT + al256((size_t)512 * 12288 * 2);
constexpr size_t WO_X = WO_MOD + al256((size_t)2 * 3 * 9216 * 4);
constexpr size_t WO_T = WO_X + al256((size_t)12288 * 1024 * 4);
constexpr size_t WO_BAR = WO_T + al256((size_t)12288 * 1024 * 4);
constexpr size_t WO_KF = WO_BAR + al256((size_t)(3456 + 2048) * 4);
constexpr size_t WO_XCH = WO_KF + al256((size_t)512 * 12288 * 2);
constexpr size_t WO_END = WO_XCH + al256((size_t)2 * 12288 * 4 * 4);

DI u16 f2bf(float x) { unsigned u = __float_as_uint(x); u += 0x7fffu + ((u >> 16) & 1u); return (u16)(u >> 16); }
DI float bf2f(u16 v) { return __uint_as_float(((unsigned)v) << 16); }
DI unsigned pack2(float a, float b) { unsigned r; asm("v_cvt_pk_bf16_f32 %0, %1, %2" : "=v"(r) : "v"(a), "v"(b)); return r; }
DI float wave_sum(float v) {
#pragma unroll
  for (int o = 32; o > 0; o >>= 1) v += __shfl_xor(v, o);
  return v;
}
DI float bflo(unsigned u) { return __uint_as_float(u << 16); }
DI float bfhi(unsigned u) { return __uint_as_float(u & 0xffff0000u); }

__device__ void mod_item(const P& p, int it, char* smem, int tidx) {
  float* sS = (float*)smem;
  float* red = sS + 3072;
  const int tid = tidx;
  const int l = it / 144, n0 = (it % 144) * 64;
  for (int i = tid; i < 3072; i += 256) {
    int r = i >> 10, k = i & 1023;
    float v = r == 0 ? p.c_ctx[k] : p.c[(r - 1) * 1024 + k];
    sS[i] = v / (1.f + expf(-v));
  }
  __syncthreads();
  const int kq = tid >> 4, cq = tid & 15;
  const float* w = p.mod_w + (size_t)l * 1024 * 9216 + (size_t)(kq * 64) * 9216 + n0 + cq * 4;
  float a00 = 0, a01 = 0, a02 = 0, a03 = 0, a10 = 0, a11 = 0, a12 = 0, a13 = 0, a20 = 0, a21 = 0, a22 = 0, a23 = 0;
#pragma unroll 1
  for (int k0 = 0; k0 < 64; k0 += 8) {
    float4 wv[8];
#pragma unroll
    for (int k = 0; k < 8; ++k) wv[k] = *(const float4*)(w + (size_t)(k0 + k) * 9216);
#pragma unroll
    for (int k = 0; k < 8; ++k) {
      float4 w4 = wv[k];
      float s0 = sS[kq * 64 + k0 + k], s1 = sS[1024 + kq * 64 + k0 + k], s2 = sS[2048 + kq * 64 + k0 + k];
      a00 += s0 * w4.x; a01 += s0 * w4.y; a02 += s0 * w4.z; a03 += s0 * w4.w;
      a10 += s1 * w4.x; a11 += s1 * w4.y; a12 += s1 * w4.z; a13 += s1 * w4.w;
      a20 += s2 * w4.x; a21 += s2 * w4.y; a22 += s2 * w4.z; a23 += s2 * w4.w;
    }
  }
  float* r0 = red + (kq * 3 + 0) * 64 + cq * 4;
  r0[0] = a00; r0[1] = a01; r0[2] = a02; r0[3] = a03;
  r0[64] = a10; r0[65] = a11; r0[66] = a12; r0[67] = a13;
  r0[128] = a20; r0[129] = a21; r0[130] = a22; r0[131] = a23;
  __syncthreads();
  if (tid < 192) {
    int r = tid >> 6, n = tid & 63;
    float s = p.mod_b[l * 9216 + n0 + n];
#pragma unroll
    for (int q = 0; q < 16; ++q) s += red[(q * 3 + r) * 64 + n];
    p.MOD[(l * 3 + r) * 9216 + n0 + n] = s;
  }
  __syncthreads();
}

struct TrItem { const float* src; u16* dst; int N, Kd, k0, n0, perm; };
DI TrItem tr_decode(const P& p, int idx) {
  TrItem t; t.perm = 0; int kt, nt;
  if (idx < 2816) { int mat = idx / 704, r = idx % 704; kt = r / 44; nt = r % 44; t.src = p.ffn_w1 + (size_t)mat * 1024 * 5632; t.N = 5632; t.Kd = 1024; t.dst = p.W1T + (size_t)mat * 5632 * 1024; t.perm = 1; }
  else if (idx < 4224) { int r0 = idx - 2816; int mat = r0 / 352, r = r0 % 352; kt = r / 8; nt = r % 8; t.src = p.ffn_w2 + (size_t)mat * 2816 * 1024; t.N = 1024; t.Kd = 2816; t.dst = p.W2T + (size_t)mat * 1024 * 2816; }
  else if (idx < 4608) { int r = idx - 4224; kt = r / 24; nt = r % 24; t.src = p.ev_w_in; t.N = 3072; t.Kd = 1024; t.dst = p.EVIN; }
  else if (idx < 4736) { int r = idx - 4608; kt = r / 8; nt = r % 8; t.src = p.ev_w_out; t.N = 1024; t.Kd = 1024; t.dst = p.EVOUT; }
  else if (idx < 4896) { int r = idx - 4736; kt = r / 10; nt = r % 10; t.src = p.od_w_in; t.N = 1280; t.Kd = 1024; t.dst = p.ODIN; }
  else if (idx < 5024) { int r = idx - 4896; kt = r / 8; nt = r % 8; t.src = p.od_w_out; t.N = 1024; t.Kd = 1024; t.dst = p.ODOUT; }
  else { int r = idx - 5024; int mat = r >> 1; kt = r & 1; nt = 0; t.src = p.od_pool_w + mat * 16384; t.N = 128; t.Kd = 512; t.dst = p.POOLW + (size_t)(mat * 128) * 512 + mat * 128; }
  t.k0 = kt * 64; t.n0 = nt * 128;
  return t;
}

__device__ void prep_phase(const P& p, char* smem_all, int bid, int G, int tid512) {
  constexpr int N_MOD = 288, N_TR = 5032, N_CC = 448;
  const int half = tid512 >> 8, tid = tid512 & 255;
  char* smem = smem_all + half * 36864;
  for (int pi = bid; pi < N_MOD / 2; pi += G) mod_item(p, 2 * pi + half, smem, tid);
  {
    float* tl = (float*)smem;
    const int r = tid >> 5, c4 = (tid & 31) * 4;
    float4 v[8];
    int tp = bid;
    TrItem cur{};
    if (tp < N_TR / 2) {
      cur = tr_decode(p, 2 * tp + half);
      const float* sp = cur.src + (size_t)(cur.k0 + r) * cur.N + cur.n0 + c4;
#pragma unroll
      for (int q = 0; q < 8; ++q) v[q] = *(const float4*)(sp + (size_t)(8 * q) * cur.N);
    }
    for (; tp < N_TR / 2; tp += G) {
      float* tpp = tl + r * 129 + c4;
#pragma unroll
      for (int q = 0; q < 8; ++q) { tpp[q * 8 * 129] = v[q].x; tpp[q * 8 * 129 + 1] = v[q].y; tpp[q * 8 * 129 + 2] = v[q].z; tpp[q * 8 * 129 + 3] = v[q].w; }
      __syncthreads();
      const TrItem me = cur;
      if (tp + G < N_TR / 2) {
        cur = tr_decode(p, 2 * (tp + G) + half);
        const float* sp = cur.src + (size_t)(cur.k0 + r) * cur.N + cur.n0 + c4;
#pragma unroll
        for (int q = 0; q < 8; ++q) v[q] = *(const float4*)(sp + (size_t)(8 * q) * cur.N);
      }
#pragma unroll
      for (int q = 0; q < 4; ++q) {
        int nn = (tid >> 3) + 32 * q, kc = tid & 7;
        int n = me.n0 + nn, nd = n;
        if (me.perm) nd = n < DFF ? ((n >> 5) * 64 + (n & 31)) : ((((n - DFF) >> 5) * 64) + 32 + ((n - DFF) & 31));
        const float* t = tl + (kc * 8) * 129 + nn;
        uint4 o;
        o.x = pack2(t[0], t[129]); o.y = pack2(t[258], t[387]); o.z = pack2(t[516], t[645]); o.w = pack2(t[774], t[903]);
        *(uint4*)(me.dst + (size_t)nd * me.Kd + me.k0 + kc * 8) = o;
      }
      __syncthreads();
    }
  }
  for (int pi = bid; pi < N_CC / 2; pi += G) {
    const int idx = 2 * pi + half;
    {
      int e0 = idx * 2048 + tid * 8;
#pragma unroll 1
      for (int j = 0; j < 8; ++j) {
        int e = e0 + j;
        if (e < 589824 && (e < 262144 || e >= 524288)) {
          const bool isA = e < 262144; const int q = isA ? e : e - 524288;
          const int x = q & 7, ln = (q >> 3) & 63, sub = (q >> 9) & 3, T = (q >> 11) & 7, bh = q >> 14;
          const int key = T * 32 + (ln & 31), d = sub * 16 + (ln >> 5) * 8 + x;
          const float v = (isA ? p.cache_a_k : p.cache_d_k)[(bh * 256 + key) * 64 + d];
          (isA ? p.CAK : p.CDK)[q] = f2bf(v);
        } else if (e < 655360) {
          const bool isA = e < 524288; const int q = isA ? e - 262144 : e - 589824;
          const int x = q & 7, ln = (q >> 3) & 63, sub = (q >> 9) & 3, T = (q >> 11) & 7, bh = q >> 14;
          const int dim = (sub >> 1) * 32 + (ln & 31), key = T * 32 + 16 * (sub & 1) + 8 * (x >> 2) + 4 * (ln >> 5) + (x & 3);
          const float v = (isA ? p.cache_a_v : p.cache_d_v)[(bh * 256 + key) * 64 + dim];
          (isA ? p.CAVT : p.CDVT)[q] = f2bf(v);
        }
        else { int q = e - 655360; int n = q >> 9, k = q & 511; if ((n >> 7) != (k >> 7)) p.POOLW[q] = 0; }
      }
    }
  }
}

template <int RMODE>
__device__ void r_phase(const P& p, bool first_unused, bool hasT_unused, const float* gT, const float* modg, int gate_idx, float gscale,
                        bool writeH, const float* g2, const float* modn, int shift_idx, int scale_idx, float* xdst, int gw, int W, int tidx) {
  const int lane = tidx & 63;
  constexpr bool first = RMODE == 0, hasT = RMODE != 0;
  constexpr int NR = 6;
  for (int t0 = gw; t0 < MTOK; t0 += NR * W) {
    float4 xf[NR][4];
    uint2 xq[NR][4], tq[NR][4];
#pragma unroll
    for (int r = 0; r < NR; ++r) {
      const int t = t0 + r * W;
      if (t < MTOK) {
        if (first) {
          const float* xs = t < MPR ? p.x_prompt + (size_t)t * DM : p.x_sample + (size_t)(t - MPR) * DM;
#pragma unroll
          for (int j = 0; j < 4; ++j) xf[r][j] = *(const float4*)(xs + lane * 4 + 256 * j);
        } else {
          const u16* xs = (const u16*)p.X + (size_t)t * DM;
          const u16* ts = (const u16*)p.T + (size_t)t * DM;
#pragma unroll
          for (int j = 0; j < 4; ++j) { xq[r][j] = *(const uint2*)(xs + lane * 4 + 256 * j); tq[r][j] = *(const uint2*)(ts + lane * 4 + 256 * j); }
        }
      }
    }
#pragma unroll
    for (int r = 0; r < NR; ++r) {
      const int t = t0 + r * W;
      if (t < MTOK) {
        const int ci = t < MPR ? 0 : 1 + ((t - MPR) >> 11);
        float4 x[4];
        if (first) {
#pragma unroll
          for (int j = 0; j < 4; ++j) x[j] = xf[r][j];
        } else {
#pragma unroll
          for (int j = 0; j < 4; ++j) x[j] = make_float4(bflo(xq[r][j].x), bfhi(xq[r][j].x), bflo(xq[r][j].y), bfhi(xq[r][j].y));
        }
        if (hasT) {
          float4 tv[4];
          float ss = 0.f;
#pragma unroll
          for (int j = 0; j < 4; ++j) {
            tv[j] = make_float4(bflo(tq[r][j].x), bfhi(tq[r][j].x), bflo(tq[r][j].y), bfhi(tq[r][j].y));
            ss += tv[j].x * tv[j].x + tv[j].y * tv[j].y + tv[j].z * tv[j].z + tv[j].w * tv[j].w;
          }
          ss = wave_sum(ss);
          const float rs = rsqrtf(ss * (1.f / 1024.f) + 1e-6f) * gscale;
          const float* mg = modg + ci * 9216 + gate_idx * 1024;
#pragma unroll
          for (int j = 0; j < 4; ++j) {
            int c = lane * 4 + 256 * j;
            float4 g4 = *(const float4*)(gT + c), m4 = *(const float4*)(mg + c);
            x[j].x += m4.x * (tv[j].x * rs * g4.x); x[j].y += m4.y * (tv[j].y * rs * g4.y);
            x[j].z += m4.z * (tv[j].z * rs * g4.z); x[j].w += m4.w * (tv[j].w * rs * g4.w);
          }
        }
        if (RMODE == 2) {
#pragma unroll
          for (int j = 0; j < 4; ++j) *(float4*)(xdst + (size_t)t * DM + lane * 4 + 256 * j) = x[j];
        } else {
#pragma unroll
          for (int j = 0; j < 4; ++j) {
            uint2 o; o.x = pack2(x[j].x, x[j].y); o.y = pack2(x[j].z, x[j].w);
            *(uint2*)((u16*)xdst + (size_t)t * DM + lane * 4 + 256 * j) = o;
          }
          float ss = 0.f;
#pragma unroll
          for (int j = 0; j < 4; ++j) ss += x[j].x * x[j].x + x[j].y * x[j].y + x[j].z * x[j].z + x[j].w * x[j].w;
          ss = wave_sum(ss);
          const float r2 = rsqrtf(ss * (1.f / 1024.f) + 1e-6f);
          const float* sh = modn + ci * 9216 + shift_idx * 1024;
          const float* sc = modn + ci * 9216 + scale_idx * 1024;
#pragma unroll
          for (int j = 0; j < 4; ++j) {
            int c = lane * 4 + 256 * j;
            float4 g4 = *(const float4*)(g2 + c), s4 = *(const float4*)(sc + c), h4 = *(const float4*)(sh + c);
            float h0 = x[j].x * r2 * g4.x * (1.f + s4.x) + h4.x;
            float h1 = x[j].y * r2 * g4.y * (1.f + s4.y) + h4.y;
            float h2 = x[j].z * r2 * g4.z * (1.f + s4.z) + h4.z;
            float h3 = x[j].w * r2 * g4.w * (1.f + s4.w) + h4.w;
            uint2 o; o.x = pack2(h0, h1); o.y = pack2(h2, h3);
            *(uint2*)(p.H + (size_t)t * DM + c) = o;
          }
        }
      }
    }
  }
}

enum { EPI_SWIGLU = 0, EPI_F32 = 1, EPI_EVIN = 2, EPI_ODIN = 3, EPI_POOL = 4, EPI_RES = 5 };
struct ResArgs { const float* gT; const float* modg; const float* g2; const float* modn; int gate; int shi; float gs; int kuse; int fin; };
using f32x4 = __attribute__((ext_vector_type(4))) float;

DI int lds_byte2(int r, int c) {
  int st = (r >> 4) * 2 + (c >> 5), ob = (r & 15) * 64 + (c & 31) * 2;
  return st * 1024 + (ob ^ (((ob >> 9) & 1) << 5));
}
DI void stage_rc2(int b, int& R, int& C) {
  int st = b >> 10, sb = b & 1023, swz = sb ^ (((sb >> 9) & 1) << 5);
  R = (st >> 1) * 16 + (swz >> 6);
  C = (st & 1) * 32 + ((swz & 63) >> 1);
}
#define WAIT_V0() asm volatile("s_waitcnt vmcnt(0)" ::: "memory")

#define LDS_RD4(a, b, c, d, addr, o0, o1, o2, o3) asm volatile( \
    "ds_read_b128 %0, %4 offset:%5\n\tds_read_b128 %1, %4 offset:%6\n\tds_read_b128 %2, %4 offset:%7\n\tds_read_b128 %3, %4 offset:%8\n\ts_waitcnt lgkmcnt(0)" \
    : "=&v"(a), "=&v"(b), "=&v"(c), "=&v"(d) : "v"(addr), "n"(o0), "n"(o1), "n"(o2), "n"(o3) : "memory")
template <int EPI, int MF, bool TAIL = false>
__device__ __forceinline__ void gemm_phase(const P& p, const u16* __restrict__ A, const u16* __restrict__ Bt, int K,
                                           int nMT, int nNT, void* outp, int ldc, char* smem, int vbid, int G, int tidx, int tlimit = 1 << 30, int tbase = 0, ResArgs ra = ResArgs{}) {
  constexpr int TILE_B = 32768, STAGE_B = 65536;
  const int wid = __builtin_amdgcn_readfirstlane(tidx >> 6), lane = tidx & 63, wr = wid >> 2, wc = wid & 3, fr = lane & 15, fq = lane >> 4;
  int sOff0;
  { int R, C; stage_rc2(wid * 1024 + lane * 16, R, C); sOff0 = R * K + C; }
  const unsigned sOffB = (unsigned)sOff0 * 2u;
  const int aOff0 = lds_byte2(wr * (16 * MF) + fr, fq * 8);
  const int bOff0 = lds_byte2(wc * 64 + fr, fq * 8);
  const int ntiles = TAIL ? tlimit : min(nMT * nNT, tlimit), nt = K >> 6;
#define GLDS_STAGE(AB, BB, buf, kt) do { _Pragma("unroll") for (int i = 0; i < 4; ++i) { \
      if (wid + 8 * i < 4 * MF) __builtin_amdgcn_global_load_lds((const unsigned*)((const char*)((AB) + (size_t)(i * 64) * K + (kt) * 64) + sOffB), (unsigned*)(smem + (buf) * STAGE_B + wid * 1024 + i * 8192), 16, 0, 0); \
      __builtin_amdgcn_global_load_lds((const unsigned*)((const char*)((BB) + (size_t)(i * 64) * K + (kt) * 64) + sOffB), (unsigned*)(smem + (buf) * STAGE_B + TILE_B + wid * 1024 + i * 8192), 16, 0, 0); } } while (0)
#define TILE_COORDS(T, BR, BC) do { const int ts_ = TAIL ? tbase + ((T) >> 1) : (T); \
      const int grp_ = ts_ / (8 * nNT), r2_ = ts_ - grp_ * 8 * nNT; \
      BR = (grp_ * 8 + (r2_ & 7)) * (TAIL ? 192 : 32 * MF) + (TAIL ? ((T) & 1) * 96 : 0); BC = (r2_ >> 3) * 256; } while (0)
  if (vbid < ntiles) {
    int br_, bc_; TILE_COORDS(vbid, br_, bc_);
    GLDS_STAGE(A + (size_t)br_ * K, Bt + (size_t)bc_ * K, 0, 0);
  }
  for (int tile = vbid; tile < ntiles; tile += G) {
    int brow, bcol; TILE_COORDS(tile, brow, bcol);
    const u16* Ab = A + (size_t)brow * K;
    const u16* Bb = Bt + (size_t)bcol * K;
    f32x4 acc[MF][4];
#pragma unroll
    for (int m = 0; m < MF; ++m)
#pragma unroll
      for (int n = 0; n < 4; ++n) { acc[m][n][0] = 0.f; acc[m][n][1] = 0.f; acc[m][n][2] = 0.f; acc[m][n][3] = 0.f; }
#define LDS_RD(dst, base, off) asm volatile("ds_read_b128 %0, %1 offset:%2" : "=v"(dst) : "v"(base), "n"(off))
    bf16x8 A0[MF], B0[4], A1[MF], B1[4];
    const unsigned lbase = (unsigned)(size_t)(smem);
    WAIT_V0(); __syncthreads();
    if (nt > 1) GLDS_STAGE(Ab, Bb, 1, 1);
    asm volatile("s_waitcnt lgkmcnt(0)" ::: "memory");
    {
      const unsigned la = lbase + aOff0, lb = lbase + TILE_B + bOff0;
#pragma unroll
      for (int n = 0; n < 4; ++n) LDS_RD(B0[n], lb, n * 2048);
#pragma unroll
      for (int m = 0; m < MF; ++m) LDS_RD(A0[m], la, m * 2048);
    }
    for (int t = 0; t < nt; ++t) {
      const int cur = t & 1;
      const unsigned la = lbase + cur * STAGE_B + aOff0, lb = lbase + cur * STAGE_B + TILE_B + bOff0;
      const unsigned lan = lbase + (cur ^ 1) * STAGE_B + aOff0, lbn = lbase + (cur ^ 1) * STAGE_B + TILE_B + bOff0;
#pragma unroll
      for (int n = 0; n < 4; ++n) LDS_RD(B1[n], lb, n * 2048 + 1024);
#pragma unroll
      for (int m = 0; m < MF; ++m) LDS_RD(A1[m], la, m * 2048 + 1024);
      __builtin_amdgcn_sched_barrier(0);
#pragma unroll
      for (int m = 0; m < MF; ++m) {
        if (m == 0) asm volatile("s_waitcnt lgkmcnt(%5)" : "+v"(A0[0]), "+v"(B0[0]), "+v"(B0[1]), "+v"(B0[2]), "+v"(B0[3]) : "n"(4 + MF + MF - 1));
        else asm volatile("s_waitcnt lgkmcnt(%1)" : "+v"(A0[m]) : "n"(4 + MF + MF - 1 - m));
#pragma unroll
        for (int n = 0; n < 4; ++n) acc[m][n] = __builtin_amdgcn_mfma_f32_16x16x32_bf16(A0[m], B0[n], acc[m][n], 0, 0, 0);
        __builtin_amdgcn_sched_barrier(0);
      }
      if (MF == 3) asm volatile("s_waitcnt lgkmcnt(0)" : "+v"(A1[0]), "+v"(A1[1]), "+v"(A1[MF - 1]), "+v"(B1[0]), "+v"(B1[1]), "+v"(B1[2]), "+v"(B1[3]));
      else if (MF == 6) asm volatile("s_waitcnt lgkmcnt(0)" : "+v"(A1[0]), "+v"(A1[1]), "+v"(A1[2]), "+v"(A1[3]), "+v"(A1[4]), "+v"(A1[MF - 1]), "+v"(B1[0]), "+v"(B1[1]), "+v"(B1[2]), "+v"(B1[3]));
      else asm volatile("s_waitcnt lgkmcnt(0)" : "+v"(A1[0]), "+v"(A1[1]), "+v"(A1[2]), "+v"(A1[3]), "+v"(A1[4]), "+v"(A1[5]), "+v"(A1[MF - 2]), "+v"(A1[MF - 1]), "+v"(B1[0]), "+v"(B1[1]), "+v"(B1[2]), "+v"(B1[3]));
      WAIT_V0(); __syncthreads();
      if (t + 2 < nt) { GLDS_STAGE(Ab, Bb, cur, t + 2); }
      else if (t + 1 == nt && tile + G < ntiles) {
        int br_, bc_; TILE_COORDS(tile + G, br_, bc_);
        GLDS_STAGE(A + (size_t)br_ * K, Bt + (size_t)bc_ * K, 0, 0);
      }
      if (t + 1 < nt) {
#pragma unroll
        for (int n = 0; n < 4; ++n) LDS_RD(B0[n], lbn, n * 2048);
#pragma unroll
        for (int m = 0; m < MF; ++m) LDS_RD(A0[m], lan, m * 2048);
      }
      __builtin_amdgcn_sched_barrier(0);
#pragma unroll
      for (int m = 0; m < MF; ++m) {
#pragma unroll
        for (int n = 0; n < 4; ++n) acc[m][n] = __builtin_amdgcn_mfma_f32_16x16x32_bf16(A1[m], B1[n], acc[m][n], 0, 0, 0);
      }
      __builtin_amdgcn_sched_barrier(0);
    }
#undef LDS_RD
    unsigned zl_ = 0u; asm volatile("" : "+v"(zl_));
    const int le = (int)__builtin_amdgcn_mbcnt_hi(~0u, __builtin_amdgcn_mbcnt_lo(~0u, zl_));
    const int fre = le & 15, fqe = le >> 4;
    float* Ew = (float*)(smem + STAGE_B + wid * 4352);
    const int r0 = brow + wr * (16 * MF), c0 = bcol + wc * 64;
    if (EPI == EPI_RES) {
      const int te = wid * 64 + le;
      float* rp = (float*)(smem + STAGE_B + 8 * 4352);
      float* rstat = rp + 192 * 4;
      const int mt = brow / 192, ntl = bcol >> 8;
      unsigned* flag = p.BAR + 3456 + mt * 32;
      const unsigned target = 4u * (unsigned)(ra.kuse + 1);
      float* xch0 = p.XCH + (size_t)brow * 4;
      float* xch1 = p.XCH + (size_t)(12288 + brow) * 4;
#define XCH_ST(ptr, v) __hip_atomic_store((ptr), (v), __ATOMIC_RELAXED, __HIP_MEMORY_SCOPE_AGENT)
#define XCH_LD(ptr) __hip_atomic_load((ptr), __ATOMIC_RELAXED, __HIP_MEMORY_SCOPE_AGENT)
#define ROW_EXCHANGE(FL) do { \
        asm volatile("s_waitcnt vmcnt(0)" ::: "memory"); \
        __syncthreads(); \
        if (te == 0) { \
          (void)__hip_atomic_fetch_add((FL), 1u, __ATOMIC_RELAXED, __HIP_MEMORY_SCOPE_AGENT); \
          unsigned sp_ = 0; \
          while (__hip_atomic_load((FL), __ATOMIC_RELAXED, __HIP_MEMORY_SCOPE_AGENT) < target) { __builtin_amdgcn_s_sleep(1); if (++sp_ > (1u << 22)) break; } \
        } \
        __syncthreads(); } while (0)
#pragma unroll
      for (int m = 0; m < MF; ++m)
#pragma unroll
        for (int j = 0; j < 4; ++j) {
          float s = acc[m][0][j] * acc[m][0][j] + acc[m][1][j] * acc[m][1][j] + acc[m][2][j] * acc[m][2][j] + acc[m][3][j] * acc[m][3][j];
          s += __shfl_xor(s, 1); s += __shfl_xor(s, 2); s += __shfl_xor(s, 4); s += __shfl_xor(s, 8);
          if (fre == 0) rp[(wr * 96 + m * 16 + fqe * 4 + j) * 4 + wc] = s;
        }
      __syncthreads();
      if (te < 192) XCH_ST(xch0 + te * 4 + ntl, rp[te * 4] + rp[te * 4 + 1] + rp[te * 4 + 2] + rp[te * 4 + 3]);
      ROW_EXCHANGE(flag);
      if (te < 192) { const float qs = XCH_LD(xch0 + te * 4) + XCH_LD(xch0 + te * 4 + 1) + XCH_LD(xch0 + te * 4 + 2) + XCH_LD(xch0 + te * 4 + 3); rstat[te] = rsqrtf(qs * (1.f / 1024.f) + 1e-6f) * ra.gs; }
      __syncthreads();
      const int c4 = (le & 15) * 4;
      const float4 gT4 = *(const float4*)(ra.gT + c0 + c4);
      u16* X16 = (u16*)p.X;
      float4 xn[MF][4];
#pragma unroll
      for (int m = 0; m < MF; ++m) {
        const int rm = r0 + m * 16;
        const int ci = rm < MPR ? 0 : 1 + ((rm - MPR) >> 11);
        const float4 mg4 = *(const float4*)(ra.modg + ci * 9216 + ra.gate * 1024 + c0 + c4);
#pragma unroll
        for (int n = 0; n < 4; ++n)
#pragma unroll
          for (int j = 0; j < 4; ++j) Ew[(fqe * 4 + j) * 68 + n * 16 + fre] = acc[m][n][j];
        f32x4 q0, q1, q2, q3;
        LDS_RD4(q0, q1, q2, q3, (unsigned)(size_t)(Ew + (le >> 4) * 68 + c4), 0, 1088, 2176, 3264);
#pragma unroll
        for (int ps = 0; ps < 4; ++ps) {
          const f32x4 qv = ps == 0 ? q0 : (ps == 1 ? q1 : (ps == 2 ? q2 : q3));
          const int rl = wr * 96 + m * 16 + (le >> 4) + 4 * ps;
          const size_t ro = (size_t)(brow + rl) * DM + c0 + c4;
          const float rs = rstat[rl];
          const uint2 xq = *(const uint2*)(X16 + ro);
          float4 y;
          y.x = bflo(xq.x) + mg4.x * (qv[0] * rs * gT4.x); y.y = bfhi(xq.x) + mg4.y * (qv[1] * rs * gT4.y);
          y.z = bflo(xq.y) + mg4.z * (qv[2] * rs * gT4.z); y.w = bfhi(xq.y) + mg4.w * (qv[3] * rs * gT4.w);
          xn[m][ps] = y;
          if (ra.fin) { *(float4*)(p.out + ro) = y; }
          else {
            uint2 o; o.x = pack2(y.x, y.y); o.y = pack2(y.z, y.w);
            *(uint2*)(X16 + ro) = o;
            float s = y.x * y.x + y.y * y.y + y.z * y.z + y.w * y.w;
            s += __shfl_xor(s, 1); s += __shfl_xor(s, 2); s += __shfl_xor(s, 4); s += __shfl_xor(s, 8);
            if ((le & 15) == 0) rp[rl * 4 + wc] = s;
          }
        }
      }
      if (!ra.fin) {
        __syncthreads();
        if (te < 192) XCH_ST(xch1 + te * 4 + ntl, rp[te * 4] + rp[te * 4 + 1] + rp[te * 4 + 2] + rp[te * 4 + 3]);
        ROW_EXCHANGE(flag + 16);
        if (te < 192) { const float qs = XCH_LD(xch1 + te * 4) + XCH_LD(xch1 + te * 4 + 1) + XCH_LD(xch1 + te * 4 + 2) + XCH_LD(xch1 + te * 4 + 3); rstat[te] = rsqrtf(qs * (1.f / 1024.f) + 1e-6f); }
        __syncthreads();
        const float4 g24 = *(const float4*)(ra.g2 + c0 + c4);
#pragma unroll
        for (int m = 0; m < MF; ++m) {
          const int rm = r0 + m * 16;
          const int ci = rm < MPR ? 0 : 1 + ((rm - MPR) >> 11);
          const float4 sh4 = *(const float4*)(ra.modn + ci * 9216 + ra.shi * 1024 + c0 + c4);
          const float4 sc4 = *(const float4*)(ra.modn + ci * 9216 + (ra.shi + 1) * 1024 + c0 + c4);
#pragma unroll
          for (int ps = 0; ps < 4; ++ps) {
            const int rl = wr * 96 + m * 16 + (le >> 4) + 4 * ps;
            const float r2 = rstat[rl];
            const float4 y = xn[m][ps];
            uint2 o;
            o.x = pack2(y.x * r2 * g24.x * (1.f + sc4.x) + sh4.x, y.y * r2 * g24.y * (1.f + sc4.y) + sh4.y);
            o.y = pack2(y.z * r2 * g24.z * (1.f + sc4.z) + sh4.z, y.w * r2 * g24.w * (1.f + sc4.w) + sh4.w);
            *(uint2*)(p.H + (size_t)(brow + rl) * DM + c0 + c4) = o;
          }
        }
      }
#undef ROW_EXCHANGE
#undef XCH_ST
#undef XCH_LD
      continue;
    }
    constexpr int vlo = (EPI == EPI_EVIN) ? 1024 : 1152, vhi = (EPI == EPI_EVIN) ? 1536 : 1280;
    const bool isV = (EPI == EPI_EVIN || EPI == EPI_ODIN) && c0 >= vlo && c0 < vhi;
    float* sbase = nullptr; int hd = 0, nh = 8;
    if (EPI == EPI_EVIN) {
      if (c0 >= 512 && c0 < 1024) { sbase = p.out + OFF_SAK; hd = (c0 - 512) >> 6; }
      else if (c0 >= 1024 && c0 < 1536) { sbase = p.out + OFF_SAV; hd = (c0 - 1024) >> 6; }
    } else if (EPI == EPI_ODIN) {
      nh = 2;
      if (c0 >= 1152 && c0 < 1280) { sbase = p.out + OFF_SDV; hd = (c0 - 1152) >> 6; }
    }
    const int c4 = (le & 15) * 4;
    float4 psc = make_float4(1.f, 1.f, 1.f, 1.f);
    if (EPI == EPI_POOL) psc = *(const float4*)(p.od_pool_scale + c0 + c4);
    constexpr int ESZ = 2;
    char* orow = (EPI == EPI_SWIGLU)
        ? (char*)outp + ((size_t)(r0 + (le >> 3)) * ldc + (c0 >> 1) + (le & 7) * 4) * 2
        : (char*)outp + ((size_t)(r0 + (le >> 4)) * ldc + c0 + c4) * ESZ;
    const size_t rstride = (size_t)ldc * ESZ;
#pragma unroll
    for (int m = 0; m < MF; ++m) {
      asm volatile("" : "+v"(orow));
      const int rm = r0 + m * 16;
      float* srow = (sbase && rm < MPR) ? sbase + ((size_t)((rm >> 8) * nh + hd) * 256 + (rm & 255) + (le >> 4)) * 64 + c4 : nullptr;
      if (EPI == EPI_EVIN || EPI == EPI_ODIN) {
        if (isV) {
          const int t0 = rm + fqe * 4, kk16 = t0 & 15;
          u16* vb = p.VT + ((size_t)(((c0 - vlo) >> 6) * 384 + (t0 >> 5)) * 4 + ((t0 >> 4) & 1)) * 512 + (((kk16 >> 2) & 1) * 32) * 8 + (kk16 >> 3) * 4;
#pragma unroll
          for (int n = 0; n < 4; ++n) {
            const int dim = n * 16 + fre;
            uint2 o; o.x = pack2(acc[m][n][0], acc[m][n][1]); o.y = pack2(acc[m][n][2], acc[m][n][3]);
            *(uint2*)(vb + (dim >> 5) * 1024 + (dim & 31) * 8) = o;
          }
        }
      }
      if (EPI != EPI_SWIGLU) {
#pragma unroll
      for (int n = 0; n < 4; ++n)
#pragma unroll
        for (int j = 0; j < 4; ++j) Ew[(fqe * 4 + j) * 68 + n * 16 + fre] = acc[m][n][j];
      }
      if (EPI == EPI_EVIN) {
        if (c0 >= 512 && c0 < 1024) {
#pragma unroll
          for (int ps = 0; ps < 2; ++ps) {
            const int slot = le + 64 * ps, row = slot >> 3, ch = slot & 7;
            const float4 a = *(const float4*)(Ew + row * 68 + ch * 8), b4 = *(const float4*)(Ew + row * 68 + ch * 8 + 4);
            uint4 o; o.x = pack2(a.x, a.y); o.y = pack2(a.z, a.w); o.z = pack2(b4.x, b4.y); o.w = pack2(b4.z, b4.w);
            const int t = rm + row;
            *(uint4*)(p.KF + ((size_t)(((c0 - 512) >> 6) * 384 + (t >> 5)) * 4 + (ch >> 1)) * 512 + ((ch & 1) * 32 + (t & 31)) * 8) = o;
          }
        }
      }
      if (EPI == EPI_SWIGLU) {
        u16* ab = (u16*)outp + (size_t)(rm + fqe * 4) * ldc + (c0 >> 1) + fre;
#pragma unroll
        for (int j = 0; j < 4; ++j)
#pragma unroll
          for (int n = 0; n < 2; ++n) {
            const float g = acc[m][n][j], u = acc[m][n + 2][j];
            ab[(size_t)j * ldc + n * 16] = (u16)pack2(g / (1.f + __expf(-g)) * u, 0.f);
          }
      } else {
        f32x4 q0, q1, q2, q3;
        LDS_RD4(q0, q1, q2, q3, (unsigned)(size_t)(Ew + (le >> 4) * 68 + c4), 0, 1088, 2176, 3264);
#pragma unroll
        for (int ps = 0; ps < 4; ++ps) {
          const f32x4 qv = ps == 0 ? q0 : (ps == 1 ? q1 : (ps == 2 ? q2 : q3));
          float4 v = make_float4(qv[0], qv[1], qv[2], qv[3]);
          if (EPI == EPI_F32) {
            uint2 o; o.x = pack2(v.x, v.y); o.y = pack2(v.z, v.w);
            *(uint2*)(orow + (size_t)(4 * ps) * rstride) = o;
          } else if (EPI == EPI_POOL) {
            uint2 o; o.x = pack2(v.x * psc.x, v.y * psc.y); o.y = pack2(v.z * psc.z, v.w * psc.w);
            *(uint2*)(orow + (size_t)(4 * ps) * rstride) = o;
          } else {
            uint2 o; o.x = pack2(v.x, v.y); o.y = pack2(v.z, v.w);
            *(uint2*)(orow + (size_t)(4 * ps) * rstride) = o;
            if (srow) *(float4*)(srow + (4 * ps) * 64) = v;
          }
        }
      }
      orow += 16 * rstride;
    }
  }
#undef GLDS_STAGE
#undef TILE_COORDS
  __syncthreads();
}

struct Seg { const u16* KF; const u16* VF; int n; };

template <bool BIAS>
__device__ __forceinline__ void attn_core(const u16* __restrict__ Q, int ldq, Seg s0, Seg s1, f32x16& o0, f32x16& o1, float& m, float& l,
                                          const float* __restrict__ rpb_h, int qr, int qc0, int rs, int tidx) {
  const int lane = tidx & 63, l31 = lane & 31, lh = lane >> 5;
  bf16x8 bq[4];
#pragma unroll
  for (int kk = 0; kk < 4; ++kk) bq[kk] = *(const bf16x8*)(Q + (size_t)l31 * ldq + kk * 16 + lh * 8);
  m = -1e30f; l = 0.f;
#pragma unroll
  for (int e = 0; e < 16; ++e) { o0[e] = 0.f; o1[e] = 0.f; }
  const int qc = qc0 + l31;
  const int cs = min(max(qc - 8, 0), 48);
  const int nt0 = s0.n >> 5, ntot = nt0 + (s1.n >> 5);
  const u16* k0p = s0.KF + lane * 8;
  const u16* k1p = s1.KF + lane * 8;
  const u16* v0p = s0.VF + lane * 8;
  const u16* v1p = s1.VF + lane * 8;
  bf16x8 kA[4], kB[4], vA[4], vB[4];
#define KLOAD(dst, i_) do { const int j_ = min((i_), ntot - 1); const bool n1_ = j_ >= nt0; \
    const u16* Kp_ = n1_ ? k1p + (size_t)(j_ - nt0) * 2048 : k0p + (size_t)j_ * 2048; \
    _Pragma("unroll") for (int kk = 0; kk < 4; ++kk) dst[kk] = *(const bf16x8*)(Kp_ + kk * 512); } while (0)
#define VLOAD(dst, i_) do { const int j_ = min((i_), ntot - 1); const bool n1_ = j_ >= nt0; \
    const u16* vp_ = n1_ ? v1p + (size_t)(j_ - nt0) * 2048 : v0p + (size_t)j_ * 2048; \
    _Pragma("unroll") for (int q = 0; q < 4; ++q) dst[q] = *(const bf16x8*)(vp_ + q * 512); } while (0)
#define ATT_STEP(kf, vf, i_, kd_, vd_) do { \
    const bool in1 = (i_) >= nt0; const int kt = in1 ? (i_) - nt0 : (i_); \
    f32x16 sc; _Pragma("unroll") for (int e = 0; e < 16; ++e) sc[e] = 0.f; \
    _Pragma("unroll") for (int kk = 0; kk < 4; ++kk) sc = MFMA(kf[kk], bq[kk], sc); \
    KLOAD(kf, (i_) + (kd_)); \
    float mx = -1e30f; \
    _Pragma("unroll") for (int e = 0; e < 16; ++e) { \
      float v = sc[e] * 0.125f; \
      if (BIAS) { if (in1) { \
          const float* brow_ = rpb_h + (rs + (kt >> 1) - qr + 7) * 31;     \
          int kc = (kt & 1) * 32 + 8 * (e >> 2) + 4 * lh + (e & 3); \
          bool valid = (kc >= cs) && (kc < cs + 16); \
          unsigned co = (unsigned)min(max(kc - qc + 15, 0), 30); \
          float bv = brow_[co]; \
          v = valid ? v + bv : -1e30f; } } \
      sc[e] = v; mx = fmaxf(mx, v); \
      if (BIAS && (e & 3) == 3) __builtin_amdgcn_sched_barrier(0); } \
    mx = fmaxf(mx, __shfl_xor(mx, 32)); \
    const float mnew = fmaxf(m, mx); \
    const float corr = __expf(m - mnew); \
    float rsum = 0.f; \
    _Pragma("unroll") for (int e = 0; e < 16; ++e) { float pv = __expf(sc[e] - mnew); sc[e] = pv; rsum += pv; } \
    rsum += __shfl_xor(rsum, 32); \
    l = l * corr + rsum; m = mnew; \
    _Pragma("unroll") for (int e = 0; e < 16; ++e) { o0[e] *= corr; o1[e] *= corr; } \
    uint4 t0, t1; \
    t0.x = pack2(sc[0], sc[1]); t0.y = pack2(sc[2], sc[3]); t0.z = pack2(sc[4], sc[5]); t0.w = pack2(sc[6], sc[7]); \
    t1.x = pack2(sc[8], sc[9]); t1.y = pack2(sc[10], sc[11]); t1.z = pack2(sc[12], sc[13]); t1.w = pack2(sc[14], sc[15]); \
    const bf16x8 pb0 = __builtin_bit_cast(bf16x8, t0), pb1 = __builtin_bit_cast(bf16x8, t1); \
    o0 = MFMA(vf[0], pb0, o0); o0 = MFMA(vf[1], pb1, o0); \
    o1 = MFMA(vf[2], pb0, o1); o1 = MFMA(vf[3], pb1, o1); \
    VLOAD(vf, (i_) + (vd_)); } while (0)
  KLOAD(kA, 0); VLOAD(vA, 0);
  if (!BIAS) { KLOAD(kB, 1); VLOAD(vB, 1); }
#pragma unroll 1
  for (int i = 0; i < ntot; i += 2) {
    if (BIAS) {
      ATT_STEP(kA, vA, i, 1, 1);
      ATT_STEP(kA, vA, i + 1, 1, 1);
    } else {
      ATT_STEP(kA, vA, i, 2, 2);
      ATT_STEP(kB, vB, i + 1, 2, 2);
    }
  }
#undef KLOAD
#undef VLOAD
#undef ATT_STEP
}

__device__ __forceinline__ void attn_store(const f32x16& o0, const f32x16& o1, float inv, u16* __restrict__ O, int ldo, int tidx) {
  const int lane = tidx & 63, l31 = lane & 31, lh = lane >> 5;
  u16* op = O + (size_t)l31 * ldo + 4 * lh;
#pragma unroll
  for (int q4 = 0; q4 < 4; ++q4) {
    uint2 a, b;
    a.x = pack2(o0[4 * q4] * inv, o0[4 * q4 + 1] * inv); a.y = pack2(o0[4 * q4 + 2] * inv, o0[4 * q4 + 3] * inv);
    b.x = pack2(o1[4 * q4] * inv, o1[4 * q4 + 1] * inv); b.y = pack2(o1[4 * q4 + 2] * inv, o1[4 * q4 + 3] * inv);
    *(uint2*)(op + 8 * q4) = a;
    *(uint2*)(op + 32 + 8 * q4) = b;
  }
}

template <bool BIAS>
__device__ __forceinline__ void attn_unit(const u16* __restrict__ Q, int ldq, Seg s0, Seg s1, u16* __restrict__ O, int ldo,
                                          const float* __restrict__ rpb_h, int qr, int qc0, int rs, int tidx) {
  f32x16 o0, o1; float m, l;
  attn_core<BIAS>(Q, ldq, s0, s1, o0, o1, m, l, rpb_h, qr, qc0, rs, tidx);
  attn_store(o0, o1, 1.f / l, O, ldo, tidx);
}

__device__ void mix_even(const P& p, int gw, int W, int tidx) {
  const int lane = tidx & 63;
  const u16* U = p.ACTU;
  u16* MO = p.H;
  for (int u0 = gw; u0 < 2048 + MTOK; u0 += W) {
   for (int sub = 0; sub < 2; ++sub) {
    int u;
    if (u0 < 1024) { if (sub) break; u = u0; }
    else if (u0 < 2048) { u = 1024 + 2 * (u0 - 1024) + sub; }
    else { if (sub) break; u = u0 + 1024; }
    if (u < 1024) {
      int b = u >> 9, h = (u >> 6) & 7, r = (u >> 1) & 31, hf = u & 1;
      int tb = MPR + b * 2048;
      int rs = min(max(r - 4, 0), 24);
      Seg s0 = { p.CAK + (size_t)((b * 8 + h) * 8) * 2048, p.CAVT + (size_t)((b * 8 + h) * 8) * 2048, 256 };
      const size_t lt = (size_t)(h * 384 + ((tb + rs * 64) >> 5)) * 2048;
      Seg s1 = { p.KF + lt, p.VT + lt, 512 };
      int q0 = tb + r * 64 + hf * 32;
      attn_unit<true>(U + (size_t)q0 * 3072 + h * 64, 3072, s0, s1, MO + (size_t)q0 * DM + h * 64, DM, p.ev_rpb + h * 465, r, hf * 32, rs, tidx);
    } else if (u < 3072) {
      int v = u - 1024; int b = v >> 6, h = (v >> 3) & 7, qb = v & 7;
      const size_t lt = (size_t)(h * 384 + b * 8) * 2048;
      Seg s0 = { p.KF + lt, p.VT + lt, 256 };
      Seg s1 = { s0.KF, s0.VF, 0 };
      int q0 = b * 256 + qb * 32;
      attn_unit<false>(U + (size_t)q0 * 3072 + h * 64, 3072, s0, s1, MO + (size_t)q0 * DM + h * 64, DM, nullptr, 0, 0, 0, tidx);
    } else {
      int t = u - 3072;
      int s, L;
      if (t < MPR) { s = t & 255; L = 256; } else { s = (t - MPR) & 2047; L = 2048; }
      const int c = lane * 8;
      float z[3][8];
#pragma unroll
      for (int d = 0; d < 3; ++d) {
        int sd = s + d - 1;
        if (sd >= 0 && sd < L) {
          const u16* row = U + (size_t)(t + d - 1) * 3072;
          uint4 cg4 = *(const uint4*)(row + 2048 + c), xb4 = *(const uint4*)(row + 2560 + c);
          z[d][0] = bflo(cg4.x) * bflo(xb4.x); z[d][1] = bfhi(cg4.x) * bfhi(xb4.x);
          z[d][2] = bflo(cg4.y) * bflo(xb4.y); z[d][3] = bfhi(cg4.y) * bfhi(xb4.y);
          z[d][4] = bflo(cg4.z) * bflo(xb4.z); z[d][5] = bfhi(cg4.z) * bfhi(xb4.z);
          z[d][6] = bflo(cg4.w) * bflo(xb4.w); z[d][7] = bfhi(cg4.w) * bfhi(xb4.w);
        } else {
#pragma unroll
          for (int j = 0; j < 8; ++j) z[d][j] = 0.f;
        }
      }
      uint4 bg4 = *(const uint4*)(U + (size_t)t * 3072 + 1536 + c);
      float bg[8] = { bflo(bg4.x), bfhi(bg4.x), bflo(bg4.y), bfhi(bg4.y), bflo(bg4.z), bfhi(bg4.z), bflo(bg4.w), bfhi(bg4.w) };
      float y[8];
#pragma unroll
      for (int j = 0; j < 8; ++j) {
        float w0 = p.ev_conv_w[c + j], w1 = p.ev_conv_w[512 + c + j], w2 = p.ev_conv_w[1024 + c + j];
        y[j] = bg[j] * (z[0][j] * w0 + z[1][j] * w1 + z[2][j] * w2 + p.ev_conv_b[c + j]);
      }
      uint4 o; o.x = pack2(y[0], y[1]); o.y = pack2(y[2], y[3]); o.z = pack2(y[4], y[5]); o.w = pack2(y[6], y[7]);
      *(uint4*)(MO + (size_t)t * DM + 512 + c) = o;
    }
   }
  }
}

__device__ void mix_odd_a(const P& p, int gw, int W, int tidx) {
  const int lane = tidx & 63;
  u16* U = p.ACTU;
  u16* POOLED = (u16*)p.T;
  const float invf = exp2f(-(float)((lane >> 1) & 15) * (13.287712379549449f / 16.f));
  for (int t = gw; t < MTOK; t += W) {
    const bool smp = t >= MPR;
    int s, L, base;
    if (!smp) { s = t & 255; L = 256; base = t - s; } else { s = (t - MPR) & 2047; L = 2048; base = t - s; }
    float cs_ = 1.f, sn_ = 0.f;
    if (smp) {
      float pos = (lane < 32) ? (float)(s >> 6) : (float)(s & 63);
      float ang = pos * invf;
      cs_ = cosf(ang); sn_ = sinf(ang);
    }
    u16* row = U + (size_t)t * 1280;
#pragma unroll 1
    for (int hd = 0; hd < 10; ++hd) {
      float v = bf2f(row[512 + hd * 64 + lane]);
      float ss = wave_sum(v * v);
      float w = hd < 8 ? p.od_q_norm[lane] : p.od_k_norm[lane];
      float nv = v * rsqrtf(ss * (1.f / 64.f) + 1e-6f) * w;
      float outv = nv;
      if (smp) {
        float pr = __shfl_xor(nv, 1);
        outv = (lane & 1) ? (pr * sn_ + nv * cs_) : (nv * cs_ - pr * sn_);
      } else if (hd >= 8) {
        int b = t >> 8;
        p.out[OFF_SDK + ((size_t)(b * 2 + (hd - 8)) * 256 + s) * 64 + lane] = nv;
      }
      if (hd < 8) row[512 + hd * 64 + lane] = f2bf(outv);
      else p.KF[((size_t)((hd - 8) * 384 + (t >> 5)) * 4 + (lane >> 4)) * 512 + (((lane >> 3) & 1) * 32 + (t & 31)) * 8 + (lane & 7)] = f2bf(outv);
    }
    {
      const int half = 1 << (lane >> 4);
      const int lo = max(s - half, 0), hi = min(s + half, L);
      const int c = lane * 8;
      float a[8];
#pragma unroll
      for (int j = 0; j < 8; ++j) a[j] = 0.f;
      for (int j = lo; j < hi; ++j) {
        uint4 v = *(const uint4*)(U + (size_t)(base + j) * 1280 + c);
        a[0] += bflo(v.x); a[1] += bfhi(v.x); a[2] += bflo(v.y); a[3] += bfhi(v.y);
        a[4] += bflo(v.z); a[5] += bfhi(v.z); a[6] += bflo(v.w); a[7] += bfhi(v.w);
      }
      const float rn = 1.f / (float)(hi - lo);
      uint4 sv = *(const uint4*)(U + (size_t)t * 1280 + c);
      uint4 o;
      o.x = pack2(a[0] * rn - bflo(sv.x), a[1] * rn - bfhi(sv.x));
      o.y = pack2(a[2] * rn - bflo(sv.y), a[3] * rn - bfhi(sv.y));
      o.z = pack2(a[4] * rn - bflo(sv.z), a[5] * rn - bfhi(sv.z));
      o.w = pack2(a[6] * rn - bflo(sv.w), a[7] * rn - bfhi(sv.w));
      *(uint4*)(POOLED + (size_t)t * 512 + c) = o;
    }
  }
}

__device__ void mix_odd_b(const P& p, int gw, int W, int tidx, char* smem) {
  const u16* U = p.ACTU;
  u16* MO = p.H;
  const int lane = tidx & 63, wave = tidx >> 6;
  for (int hu = gw; hu < 2048; hu += W) {
    const int v = hu >> 1, half = hu & 1;
    const int b = v >> 9, hq = (v >> 6) & 7, qb = v & 63, kvh = hq >> 2;
    const int tb = MPR + b * 2048;
    const size_t lt = (size_t)(kvh * 384 + (tb >> 5)) * 2048;
    Seg s0, s1;
    if (half == 0) {
      s0 = Seg{ p.CDK + (size_t)((b * 2 + kvh) * 8) * 2048, p.CDVT + (size_t)((b * 2 + kvh) * 8) * 2048, 256 };
      s1 = Seg{ p.KF + lt, p.VT + lt, 896 };
    } else {
      s0 = Seg{ p.KF + lt + (size_t)28 * 2048, p.VT + lt + (size_t)28 * 2048, 1152 };
      s1 = Seg{ p.KF + lt, p.VT + lt, 0 };
    }
    const int q0 = tb + qb * 32;
    f32x16 o0, o1; float m, l;
    attn_core<false>(U + (size_t)q0 * 1280 + 512 + hq * 64, 1280, s0, s1, o0, o1, m, l, nullptr, 0, 0, 0, tidx);
    float* cb = (float*)smem + (wave >> 1) * (34 * 64) + lane;
    if (half == 1) {
      cb[0] = m; cb[64] = l;
#pragma unroll
      for (int e = 0; e < 16; ++e) { cb[(2 + e) * 64] = o0[e]; cb[(18 + e) * 64] = o1[e]; }
    }
    __syncthreads();
    if (half == 0) {
      const float m2 = cb[0], l2 = cb[64];
      const float M = fmaxf(m, m2);
      const float a1 = __expf(m - M), a2 = __expf(m2 - M);
      const float inv = 1.f / (l * a1 + l2 * a2);
#pragma unroll
      for (int e = 0; e < 16; ++e) { o0[e] = o0[e] * a1 + cb[(2 + e) * 64] * a2; o1[e] = o1[e] * a1 + cb[(18 + e) * 64] * a2; }
      attn_store(o0, o1, inv, MO + (size_t)q0 * DM + 512 + hq * 64, DM, tidx);
    }
    __syncthreads();
  }
  for (int v = gw; v < 2048; v += W) {
    int b = v >> 6, hq = (v >> 3) & 7, qb = v & 7, kvh = hq >> 2;
    const size_t lt = (size_t)(kvh * 384 + b * 8) * 2048;
    Seg s0 = { p.KF + lt, p.VT + lt, 256 };
    Seg s1 = { s0.KF, s0.VF, 0 };
    int q0 = b * 256 + qb * 32;
    attn_unit<false>(U + (size_t)q0 * 1280 + 512 + hq * 64, 1280, s0, s1, MO + (size_t)q0 * DM + 512 + hq * 64, DM, nullptr, 0, 0, 0, tidx);
  }
}

#define XB_TMO      128
#define XB_XCNT(j)  (256  + 64 * (j))
#define XB_XSUB(j)  (1280 + 64 * (j))
#define XB_XGEN(j)  (2304 + 64 * (j))
#define XB_TOP      3328
#define XB_TOPGEN   3392
#define XCD_BAR_WORDS 3456
#define XB_SPIN_CAP (1u << 20)
#define LAS __attribute__((address_space(3)))
DI unsigned xb_ld(unsigned* p)              { return __hip_atomic_load(p, __ATOMIC_RELAXED, __HIP_MEMORY_SCOPE_AGENT); }
DI unsigned xb_add(unsigned* p, unsigned v) { return __hip_atomic_fetch_add(p, v, __ATOMIC_RELAXED, __HIP_MEMORY_SCOPE_AGENT); }
DI unsigned xb_xcc_id() { return (unsigned)__builtin_amdgcn_s_getreg((3 << 11) | 20) & 0xFu; }
#define XB_SPIN(cond, bar) do { unsigned _sp = 0; while (cond) { __builtin_amdgcn_s_sleep(1); \
    if ((++_sp & 255u) == 0u) { if (xb_ld(&(bar)[XB_TMO])) break; if (_sp > XB_SPIN_CAP) { atomicAdd(&(bar)[XB_TMO], 1u); break; } } } } while (0)
struct XcdBarrier { unsigned* bar; unsigned x; volatile LAS unsigned* st; };
DI XcdBarrier xcd_barrier_post(unsigned* bar, volatile LAS unsigned* st) {
  XcdBarrier b; b.bar = bar; b.x = xb_xcc_id(); b.st = st;
  if (threadIdx.x == 0) (void)xb_add(&bar[XB_XCNT(b.x)], 1u);
  return b;
}
DI void xcd_barrier_complete(unsigned* bar, unsigned x, unsigned& nloc, unsigned& nx) {
  const unsigned G = gridDim.x * gridDim.y * gridDim.z;
  unsigned sum, cnt, mine, sp = 0u;
  for (;;) {
    sum = 0u; cnt = 0u; mine = 0u;
#pragma unroll
    for (unsigned j = 0; j < 16; ++j) { const unsigned c = xb_ld(&bar[XB_XCNT(j)]); sum += c; cnt += (c > 0u) ? 1u : 0u; mine = (j == x) ? c : mine; }
    if (sum == G) break;
    __builtin_amdgcn_s_sleep(1);
    if ((++sp & 255u) == 0u) { if (xb_ld(&bar[XB_TMO])) break; if (sp > XB_SPIN_CAP) { atomicAdd(&bar[XB_TMO], 1u); break; } }
  }
  nloc = mine > 0u ? mine : 1u; nx = cnt > 0u ? cnt : 1u;
}
DI void xcd_barrier(const XcdBarrier& b, bool leader) {
  asm volatile("s_waitcnt vmcnt(0)" ::: "memory");
  __syncthreads();
  if (leader) {
    unsigned* bar = b.bar;
    __builtin_amdgcn_s_waitcnt(0);
    unsigned nloc = b.st[0], nx = b.st[1];
    if (nloc == 0u) { xcd_barrier_complete(bar, b.x, nloc, nx); b.st[0] = nloc; b.st[1] = nx; }
    const unsigned old = xb_add(&bar[XB_XSUB(b.x)], 1u);
    const unsigned gen = old / nloc;
    if (old + 1u == (gen + 1u) * nloc) {
      __builtin_amdgcn_fence(__ATOMIC_RELEASE, "agent");
      asm volatile("s_waitcnt vmcnt(0)" ::: "memory");
      const unsigned og = xb_add(&bar[XB_TOP], 1u);
      const unsigned tg = og / nx;
      if (og + 1u == (tg + 1u) * nx) xb_add(&bar[XB_TOPGEN], 1u);
      else XB_SPIN(xb_ld(&bar[XB_TOPGEN]) == tg, bar);
      __builtin_amdgcn_fence(__ATOMIC_ACQUIRE, "agent");
      xb_add(&bar[XB_XGEN(b.x)], 1u);
      asm volatile("s_waitcnt vmcnt(0)" ::: "memory");
    } else {
      XB_SPIN(xb_ld(&bar[XB_XGEN(b.x)]) == gen, bar);
      __builtin_amdgcn_fence(__ATOMIC_ACQUIRE, "agent");
      asm volatile("s_waitcnt vmcnt(0)" ::: "memory");
    }
  }
  __syncthreads();
}

constexpr int N_PHASES = 16;
#define GRID_SYNC() xcd_barrier(xb, wave_s == 0 && __builtin_amdgcn_mbcnt_hi(~0u, __builtin_amdgcn_mbcnt_lo(~0u, 0u)) == 0u)

#define LOADP() unsigned zop = 0u; asm volatile("" : "+v"(zop)); \
    const int tidx = wave_s * 64 + (int)__builtin_amdgcn_mbcnt_hi(~0u, __builtin_amdgcn_mbcnt_lo(~0u, zop)); \
    const int gw = vbid * (NTHR / 64) + wave_s; \
    PAK pa = pak0; asm volatile("" : "+s"(pa)); P p; \
    p.x_prompt = pa->in[0]; p.x_sample = pa->in[1]; p.cache_a_k = pa->in[2]; p.cache_a_v = pa->in[3]; p.cache_d_k = pa->in[4]; p.cache_d_v = pa->in[5]; \
    p.c = pa->in[6]; p.c_ctx = pa->in[7]; p.mod_w = pa->in[8]; p.mod_b = pa->in[9]; p.norm_w = pa->in[10]; p.ffn_w1 = pa->in[11]; p.ffn_w2 = pa->in[12]; \
    p.ev_w_in = pa->in[13]; p.ev_rpb = pa->in[14]; p.ev_conv_w = pa->in[15]; p.ev_conv_b = pa->in[16]; p.ev_w_out = pa->in[17]; \
    p.od_w_in = pa->in[18]; p.od_pool_w = pa->in[19]; p.od_pool_scale = pa->in[20]; p.od_q_norm = pa->in[21]; p.od_k_norm = pa->in[22]; p.od_w_out = pa->in[23]; \
    p.out = pa->out; \
    { char* ws = pa->ws; \
      p.W1T = (u16*)(ws + WO_W1T); p.W2T = (u16*)(ws + WO_W2T); p.EVIN = (u16*)(ws + WO_EVIN); p.EVOUT = (u16*)(ws + WO_EVOUT); \
      p.ODIN = (u16*)(ws + WO_ODIN); p.ODOUT = (u16*)(ws + WO_ODOUT); p.POOLW = (u16*)(ws + WO_POOLW); \
      p.CAK = (u16*)(ws + WO_CAK); p.CAVT = (u16*)(ws + WO_CAVT); p.CDK = (u16*)(ws + WO_CDK); p.CDVT = (u16*)(ws + WO_CDVT); \
      p.H = (u16*)(ws + WO_H); p.ACTU = (u16*)(ws + WO_ACTU); p.VT = (u16*)(ws + WO_VT); \
      p.MOD = (float*)(ws + WO_MOD); p.X = (float*)(ws + WO_X); p.T = (float*)(ws + WO_T); p.BAR = (unsigned*)(ws + WO_BAR); p.KF = (u16*)(ws + WO_KF); p.XCH = (float*)(ws + WO_XCH); }
typedef const __attribute__((address_space(4))) PA* PAK;
__global__ void __launch_bounds__(NTHR, 2) mega(PA pa_unused, int ph0, int ph1) {
  __shared__ __attribute__((aligned(1024))) char smem[LDS_BYTES];
  __shared__ uint4 xb_words;
  const int wave_s = __builtin_amdgcn_readfirstlane((int)(threadIdx.x >> 6));
  cg::grid_group grid = cg::this_grid();
  if (ph1 == 0x7fffffff) grid.sync();
  if (threadIdx.x == 0) xb_words = make_uint4(0u, 0u, 0u, 0u);
  __syncthreads();
  const PAK pak0 = (PAK)__builtin_amdgcn_kernarg_segment_ptr();
  const XcdBarrier xb = xcd_barrier_post((unsigned*)(pak0->ws + WO_BAR), (volatile LAS unsigned*)&xb_words);
  const int G = gridDim.x, bid = blockIdx.x;
  const int vbid = (G & 7) ? bid : ((bid & 7) * (G >> 3) + (bid >> 3));
  const int W = G * (NTHR / 64);
#ifndef REPMASK
#define REPMASK 0u
#endif
  for (int ph = ph0; ph < ph1; ++ph) {
   const int nrep = ((REPMASK >> ph) & 1u) ? 2 : 1;
   for (int rep = 0; rep < nrep; ++rep) {
    if (rep) { GRID_SYNC(); }
    if (ph == 0) {
      LOADP();
      prep_phase(p, smem, bid, G, tidx);
    } else if (ph == 1) {
      LOADP();
      r_phase<0>(p, true, false, nullptr, nullptr, 0, 0.f, true, p.norm_w, p.MOD, 0, 1, p.X, gw, W, tidx);
    } else {
      const int q = ph - 2;
      const int l = q / 7, s = q % 7;
#define NWMOD() const float* nw = p.norm_w + l * 6 * DM; const float* modl = p.MOD + l * 3 * 9216
      switch (s) {
        case 0: case 5: { LOADP();
          const int f = s == 0 ? 0 : 1;
          const u16* w1 = p.W1T + (size_t)(l * 2 + f) * 5632 * 1024;
          gemm_phase<EPI_SWIGLU, 6>(p, p.H, w1, 1024, 64, 22, p.ACTU, DFF, smem, vbid, G, tidx, 1280);
          gemm_phase<EPI_SWIGLU, 3, true>(p, p.H, w1, 1024, 64, 22, p.ACTU, DFF, smem, vbid, G, tidx, 256, 1280);
        } break;
        case 1: case 4: case 6: { LOADP(); NWMOD();
          const u16* A_ = s == 4 ? p.H : p.ACTU;
          const u16* B_ = s == 4 ? (l == 0 ? p.EVOUT : p.ODOUT) : p.W2T + (size_t)(l * 2 + (s == 1 ? 0 : 1)) * 1024 * 2816;
          ResArgs ra;
          ra.gT = nw + (s == 1 ? 1 : (s == 4 ? 3 : 5)) * DM;
          ra.modg = modl; ra.gate = s == 1 ? 2 : (s == 4 ? 5 : 8); ra.gs = s == 4 ? 1.0f : 0.5f;
          ra.fin = (s == 6 && l == 1) ? 1 : 0;
          ra.g2 = s == 1 ? nw + 2 * DM : (s == 4 ? nw + 4 * DM : p.norm_w + 6 * DM);
          ra.modn = s == 6 ? p.MOD + 3 * 9216 : modl;
          ra.shi = s == 1 ? 3 : (s == 4 ? 6 : 0);
          ra.kuse = 3 * l + (s == 1 ? 0 : (s == 4 ? 1 : 2));
          gemm_phase<EPI_RES, 6>(p, A_, B_, s == 4 ? 1024 : DFF, 64, 4, nullptr, DM, smem, vbid, G, tidx, 1 << 30, 0, ra);
        } break;
        case 2: { LOADP();
          if (l == 0) gemm_phase<EPI_EVIN, 6>(p, p.H, p.EVIN, 1024, 64, 12, p.ACTU, 3072, smem, vbid, G, tidx);
          else {
            gemm_phase<EPI_ODIN, 6>(p, p.H, p.ODIN, 1024, 64, 5, p.ACTU, 1280, smem, vbid, G, tidx, 256);
            gemm_phase<EPI_ODIN, 3, true>(p, p.H, p.ODIN, 1024, 64, 5, p.ACTU, 1280, smem, vbid, G, tidx, 128, 256);
            GRID_SYNC();
            mix_odd_a(p, gw, W, tidx);
          }
        } break;
        case 3: { LOADP();
          if (l == 0) mix_even(p, gw, W, tidx);
          else {
            gemm_phase<EPI_POOL, 3>(p, (const u16*)p.T, p.POOLW, 512, 128, 2, p.H, DM, smem, vbid, G, tidx);
            mix_odd_b(p, gw, W, tidx, smem);
          }
        } break;
      }
    }
   }
    if (ph + 1 < ph1) { GRID_SYNC(); }
#ifdef EXTRA_SYNCS
    if (ph == 1) { for (int es = 0; es < EXTRA_SYNCS; ++es) { GRID_SYNC(); } }
#endif
  }
}

extern "C" void kernel_launch(void* const* d_in, const int* in_sizes, int n_in, void* d_out, int out_size,
                              void* d_ws, size_t ws_size, hipStream_t stream) {
  static int grid_blocks = 0;
  if (!grid_blocks) {
    int dev = 0, cus = 0, per_cu = 0;
    hipGetDevice(&dev);
    hipDeviceGetAttribute(&cus, hipDeviceAttributeMultiprocessorCount, dev);
    hipOccupancyMaxActiveBlocksPerMultiprocessor(&per_cu, mega, NTHR, 0);
    if (per_cu > 1) per_cu = 1;
    if (per_cu < 1) per_cu = 1;
    grid_blocks = cus * per_cu;
  }
  PA p{};
  for (int i = 0; i < 24; ++i) p.in[i] = (const float*)d_in[i];
  p.out = (float*)d_out;
  p.ws = (char*)d_ws;
  if (WO_END > ws_size) { fprintf(stderr, "workspace too small: need %zu have %zu\n", (size_t)WO_END, ws_size); return; }
  (void)hipMemsetAsync(p.ws + WO_BAR, 0, (size_t)(XCD_BAR_WORDS + 2048) * 4, stream);
  int ph0 = 0, ph1 = N_PHASES;
  void* args[] = { &p, &ph0, &ph1 };
  hipError_t e = hipLaunchCooperativeKernel((void*)mega, dim3(grid_blocks), dim3(NTHR), args, 0, stream);
  if (e != hipSuccess) fprintf(stderr, "cooperative launch failed: %s (grid %d)\n", hipGetErrorString(e), grid_blocks);
}
```

```cpp
#include <hip/hip_runtime.h>
#include <hip/hip_cooperative_groups.h>
#include <cstdio>
namespace cg = cooperative_groups;

typedef unsigned short u16;
using bf16x8 = __attribute__((ext_vector_type(8))) short;
using s16x4  = __attribute__((ext_vector_type(4))) short;
using f32x16 = __attribute__((ext_vector_type(16))) float;
#define DI __device__ __forceinline__
#define MFMA(a, b, c) __builtin_amdgcn_mfma_f32_32x32x16_bf16((a), (b), (c), 0, 0, 0)

constexpr int MTOK = 12288;
constexpr int MPR  = 8192;
constexpr int DM   = 1024;
constexpr int DFF  = 2816;
constexpr int NTHR = 512;
constexpr int LDS_BYTES = 131072;
constexpr int SROW = 72;

constexpr size_t OFF_SAK = 12582912, OFF_SAV = 16777216, OFF_SDK = 20971520, OFF_SDV = 22020096;

struct P {
  const float *x_prompt, *x_sample, *cache_a_k, *cache_a_v, *cache_d_k, *cache_d_v, *c, *c_ctx;
  const float *mod_w, *mod_b, *norm_w, *ffn_w1, *ffn_w2, *ev_w_in, *ev_rpb, *ev_conv_w, *ev_conv_b, *ev_w_out;
  const float *od_w_in, *od_pool_w, *od_pool_scale, *od_q_norm, *od_k_norm, *od_w_out;
  float* out;
  u16 *W1T, *W2T, *EVIN, *EVOUT, *ODIN, *ODOUT, *POOLW, *CAK, *CAVT, *CDK, *CDVT, *H, *ACTU, *VT, *KF;
  float *MOD, *X, *T;
  unsigned* BAR;
  float* XCH;
};
struct PA {
  const float* in[24];
  float* out;
  char* ws;
};
constexpr size_t al256(size_t b) { return (b + 255) & ~(size_t)255; }
constexpr size_t WO_W1T = 0;
constexpr size_t WO_W2T = WO_W1T + al256((size_t)4 * 5632 * 1024 * 2);
constexpr size_t WO_EVIN = WO_W2T + al256((size_t)4 * 1024 * 2816 * 2);
constexpr size_t WO_EVOUT = WO_EVIN + al256((size_t)3072 * 1024 * 2);
constexpr size_t WO_ODIN = WO_EVOUT + al256((size_t)1024 * 1024 * 2);
constexpr size_t WO_ODOUT = WO_ODIN + al256((size_t)1280 * 1024 * 2);
constexpr size_t WO_POOLW = WO_ODOUT + al256((size_t)1024 * 1024 * 2);
constexpr size_t WO_CAK = WO_POOLW + al256((size_t)512 * 512 * 2);
constexpr size_t WO_CAVT = WO_CAK + al256((size_t)262144 * 2);
constexpr size_t WO_CDK = WO_CAVT + al256((size_t)262144 * 2);
constexpr size_t WO_CDVT = WO_CDK + al256((size_t)65536 * 2);
constexpr size_t WO_H = WO_CDVT + al256((size_t)65536 * 2);
constexpr size_t WO_ACTU = WO_H + al256((size_t)12288 * 1024 * 2);
constexpr size_t WO_VT = WO_ACTU + al256((size_t)12288 * 3072 * 2);
constexpr size_t WO_MOD = WO_VT + al256((size_t)512 * 12288 * 2);
constexpr size_t WO_X = WO_MOD + al256((size_t)2 * 3 * 9216 * 4);
constexpr size_t WO_T = WO_X + al256((size_t)12288 * 1024 * 4);
constexpr size_t WO_BAR = WO_T + al256((size_t)12288 * 1024 * 4);
constexpr size_t WO_KF = WO_BAR + al256((size_t)(3456 + 2048) * 4);
constexpr size_t WO_XCH = WO_KF + al256((size_t)512 * 12288 * 2);
constexpr size_t WO_END = WO_XCH + al256((size_t)2 * 12288 * 4 * 4);

DI u16 f2bf(float x) { unsigned u = __float_as_uint(x); u += 0x7fffu + ((u >> 16) & 1u); return (u16)(u >> 16); }
DI float bf2f(u16 v) { return __uint_as_float(((unsigned)v) << 16); }
DI unsigned pack2(float a, float b) { unsigned r; asm("v_cvt_pk_bf16_f32 %0, %1, %2" : "=v"(r) : "v"(a), "v"(b)); return r; }
DI float row16_sum(float v) {
  v += __builtin_bit_cast(float, __builtin_amdgcn_update_dpp(0, __builtin_bit_cast(int, v), 0xB1, 0xF, 0xF, true));
  v += __builtin_bit_cast(float, __builtin_amdgcn_update_dpp(0, __builtin_bit_cast(int, v), 0x4E, 0xF, 0xF, true));
  v += __builtin_bit_cast(float, __builtin_amdgcn_update_dpp(0, __builtin_bit_cast(int, v), 0x141, 0xF, 0xF, true));
  v += __builtin_bit_cast(float, __builtin_amdgcn_update_dpp(0, __builtin_bit_cast(int, v), 0x140, 0xF, 0xF, true));
  return v;
}
DI float xor32_max(float v) { float a = v, b = v; asm volatile("s_nop 1\n\tv_permlane32_swap_b32 %0, %1" : "+v"(a), "+v"(b)); return fmaxf(a, b); }
DI float xor32_sum(float v) { float a = v, b = v; asm volatile("s_nop 1\n\tv_permlane32_swap_b32 %0, %1" : "+v"(a), "+v"(b)); return a + b; }
DI float xor16_sum(float v) { float a = v, b = v; asm volatile("s_nop 1\n\tv_permlane16_swap_b32 %0, %1" : "+v"(a), "+v"(b)); return a + b; }
DI float wave_sum(float v) {
#pragma unroll
  for (int o = 32; o > 0; o >>= 1) v += __shfl_xor(v, o);
  return v;
}
DI float wave_sum_dpp(float v) {
  return xor32_sum(xor16_sum(row16_sum(v)));
}
DI float bflo(unsigned u) { return __uint_as_float(u << 16); }
DI float bfhi(unsigned u) { return __uint_as_float(u & 0xffff0000u); }

__device__ void mod_item(const P& p, int it, char* smem, int tidx) {
  float* sS = (float*)smem;
  float* red = sS + 3072;
  const int tid = tidx;
  const int l = it / 144, n0 = (it % 144) * 64;
  for (int i = tid; i < 3072; i += 256) {
    int r = i >> 10, k = i & 1023;
    float v = r == 0 ? p.c_ctx[k] : p.c[(r - 1) * 1024 + k];
    sS[i] = v / (1.f + expf(-v));
  }
  __syncthreads();
  const int kq = tid >> 4, cq = tid & 15;
  const float* w = p.mod_w + (size_t)l * 1024 * 9216 + (size_t)(kq * 64) * 9216 + n0 + cq * 4;
  float a00 = 0, a01 = 0, a02 = 0, a03 = 0, a10 = 0, a11 = 0, a12 = 0, a13 = 0, a20 = 0, a21 = 0, a22 = 0, a23 = 0;
#pragma unroll 1
  for (int k0 = 0; k0 < 64; k0 += 8) {
    float4 wv[8];
#pragma unroll
    for (int k = 0; k < 8; ++k) wv[k] = *(const float4*)(w + (size_t)(k0 + k) * 9216);
#pragma unroll
    for (int k = 0; k < 8; ++k) {
      float4 w4 = wv[k];
      float s0 = sS[kq * 64 + k0 + k], s1 = sS[1024 + kq * 64 + k0 + k], s2 = sS[2048 + kq * 64 + k0 + k];
      a00 += s0 * w4.x; a01 += s0 * w4.y; a02 += s0 * w4.z; a03 += s0 * w4.w;
      a10 += s1 * w4.x; a11 += s1 * w4.y; a12 += s1 * w4.z; a13 += s1 * w4.w;
      a20 += s2 * w4.x; a21 += s2 * w4.y; a22 += s2 * w4.z; a23 += s2 * w4.w;
    }
  }
  float* r0 = red + (kq * 3 + 0) * 64 + cq * 4;
  r0[0] = a00; r0[1] = a01; r0[2] = a02; r0[3] = a03;
  r0[64] = a10; r0[65] = a11; r0[66] = a12; r0[67] = a13;
  r0[128] = a20; r0[129] = a21; r0[130] = a22; r0[131] = a23;
  __syncthreads();
  if (tid < 192) {
    int r = tid >> 6, n = tid & 63;
    float s = p.mod_b[l * 9216 + n0 + n];
#pragma unroll
    for (int q = 0; q < 16; ++q) s += red[(q * 3 + r) * 64 + n];
    p.MOD[(l * 3 + r) * 9216 + n0 + n] = s;
  }
  __syncthreads();
}

struct TrItem { const float* src; u16* dst; int N, Kd, k0, n0, perm; };
DI TrItem tr_decode(const P& p, int idx) {
  TrItem t; t.perm = 0; int kt, nt;
  if (idx < 2816) { int mat = idx / 704, r = idx % 704; kt = r / 44; nt = r % 44; t.src = p.ffn_w1 + (size_t)mat * 1024 * 5632; t.N = 5632; t.Kd = 1024; t.dst = p.W1T + (size_t)mat * 5632 * 1024; t.perm = 1; }
  else if (idx < 4224) { int r0 = idx - 2816; int mat = r0 / 352, r = r0 % 352; kt = r / 8; nt = r % 8; t.src = p.ffn_w2 + (size_t)mat * 2816 * 1024; t.N = 1024; t.Kd = 2816; t.dst = p.W2T + (size_t)mat * 1024 * 2816; }
  else if (idx < 4608) { int r = idx - 4224; kt = r / 24; nt = r % 24; t.src = p.ev_w_in; t.N = 3072; t.Kd = 1024; t.dst = p.EVIN; }
  else if (idx < 4736) { int r = idx - 4608; kt = r / 8; nt = r % 8; t.src = p.ev_w_out; t.N = 1024; t.Kd = 1024; t.dst = p.EVOUT; }
  else if (idx < 4896) { int r = idx - 4736; kt = r / 10; nt = r % 10; t.src = p.od_w_in; t.N = 1280; t.Kd = 1024; t.dst = p.ODIN; }
  else if (idx < 5024) { int r = idx - 4896; kt = r / 8; nt = r % 8; t.src = p.od_w_out; t.N = 1024; t.Kd = 1024; t.dst = p.ODOUT; }
  else { int r = idx - 5024; int mat = r >> 1; kt = r & 1; nt = 0; t.src = p.od_pool_w + mat * 16384; t.N = 128; t.Kd = 512; t.dst = p.POOLW + (size_t)(mat * 128) * 512 + mat * 128; }
  t.k0 = kt * 64; t.n0 = nt * 128;
  return t;
}

__device__ void prep_phase(const P& p, char* smem_all, int bid, int G, int tid512) {
  constexpr int N_MOD = 288, N_TR = 5032, N_CC = 448;
  const int half = tid512 >> 8, tid = tid512 & 255;
  char* smem = smem_all + half * 36864;
  for (int pi = bid; pi < N_MOD / 2; pi += G) mod_item(p, 2 * pi + half, smem, tid);
  {
    float* tl = (float*)smem;
    const int r = tid >> 5, c4 = (tid & 31) * 4;
    float4 v[8];
    int tp = bid;
    TrItem cur{};
    if (tp < N_TR / 2) {
      cur = tr_decode(p, 2 * tp + half);
      const float* sp = cur.src + (size_t)(cur.k0 + r) * cur.N + cur.n0 + c4;
#pragma unroll
      for (int q = 0; q < 8; ++q) v[q] = *(const float4*)(sp + (size_t)(8 * q) * cur.N);
    }
    for (; tp < N_TR / 2; tp += G) {
      float* tpp = tl + r * 129 + c4;
#pragma unroll
      for (int q = 0; q < 8; ++q) { tpp[q * 8 * 129] = v[q].x; tpp[q * 8 * 129 + 1] = v[q].y; tpp[q * 8 * 129 + 2] = v[q].z; tpp[q * 8 * 129 + 3] = v[q].w; }
      __syncthreads();
      const TrItem me = cur;
      if (tp + G < N_TR / 2) {
        cur = tr_decode(p, 2 * (tp + G) + half);
        const float* sp = cur.src + (size_t)(cur.k0 + r) * cur.N + cur.n0 + c4;
#pragma unroll
        for (int q = 0; q < 8; ++q) v[q] = *(const float4*)(sp + (size_t)(8 * q) * cur.N);
      }
#pragma unroll
      for (int q = 0; q < 4; ++q) {
        int nn = (tid >> 3) + 32 * q, kc = tid & 7;
        int n = me.n0 + nn, nd = n;
        if (me.perm) nd = n < DFF ? ((n >> 5) * 64 + (n & 31)) : ((((n - DFF) >> 5) * 64) + 32 + ((n - DFF) & 31));
        const float* t = tl + (kc * 8) * 129 + nn;
        uint4 o;
        o.x = pack2(t[0], t[129]); o.y = pack2(t[258], t[387]); o.z = pack2(t[516], t[645]); o.w = pack2(t[774], t[903]);
        *(uint4*)(me.dst + (size_t)nd * me.Kd + me.k0 + kc * 8) = o;
      }
      __syncthreads();
    }
  }
  for (int pi = bid; pi < N_CC / 2; pi += G) {
    const int idx = 2 * pi + half;
    {
      int e0 = idx * 2048 + tid * 8;
#pragma unroll 1
      for (int j = 0; j < 8; ++j) {
        int e = e0 + j;
        if (e < 589824 && (e < 262144 || e >= 524288)) {
          const bool isA = e < 262144; const int q = isA ? e : e - 524288;
          const int x = q & 7, ln = (q >> 3) & 63, sub = (q >> 9) & 3, T = (q >> 11) & 7, bh = q >> 14;
          const int key = T * 32 + (ln & 31), d = sub * 16 + (ln >> 5) * 8 + x;
          const float v = (isA ? p.cache_a_k : p.cache_d_k)[(bh * 256 + key) * 64 + d];
          (isA ? p.CAK : p.CDK)[q] = f2bf(v);
        } else if (e < 655360) {
          const bool isA = e < 524288; const int q = isA ? e - 262144 : e - 589824;
          const int x = q & 7, ln = (q >> 3) & 63, sub = (q >> 9) & 3, T = (q >> 11) & 7, bh = q >> 14;
          const int dim = (sub >> 1) * 32 + (ln & 31), key = T * 32 + 16 * (sub & 1) + 8 * (x >> 2) + 4 * (ln >> 5) + (x & 3);
          const float v = (isA ? p.cache_a_v : p.cache_d_v)[(bh * 256 + key) * 64 + dim];
          (isA ? p.CAVT : p.CDVT)[q] = f2bf(v);
        }
        else { int q = e - 655360; int n = q >> 9, k = q & 511; if ((n >> 7) != (k >> 7)) p.POOLW[q] = 0; }
      }
    }
  }
}

template <int RMODE>
__device__ void r_phase(const P& p, bool first_unused, bool hasT_unused, const float* gT, const float* modg, int gate_idx, float gscale,
                        bool writeH, const float* g2, const float* modn, int shift_idx, int scale_idx, float* xdst, int gw, int W, int tidx) {
  const int lane = tidx & 63;
  constexpr bool first = RMODE == 0, hasT = RMODE != 0;
  constexpr int NR = 6;
  for (int t0 = gw; t0 < MTOK; t0 += NR * W) {
    float4 xf[NR][4];
    uint2 xq[NR][4], tq[NR][4];
#pragma unroll
    for (int r = 0; r < NR; ++r) {
      const int t = t0 + r * W;
      if (t < MTOK) {
        if (first) {
          const float* xs = t < MPR ? p.x_prompt + (size_t)t * DM : p.x_sample + (size_t)(t - MPR) * DM;
#pragma unroll
          for (int j = 0; j < 4; ++j) xf[r][j] = *(const float4*)(xs + lane * 4 + 256 * j);
        } else {
          const u16* xs = (const u16*)p.X + (size_t)t * DM;
          const u16* ts = (const u16*)p.T + (size_t)t * DM;
#pragma unroll
          for (int j = 0; j < 4; ++j) { xq[r][j] = *(const uint2*)(xs + lane * 4 + 256 * j); tq[r][j] = *(const uint2*)(ts + lane * 4 + 256 * j); }
        }
      }
    }
#pragma unroll
    for (int r = 0; r < NR; ++r) {
      const int t = t0 + r * W;
      if (t < MTOK) {
        const int ci = t < MPR ? 0 : 1 + ((t - MPR) >> 11);
        float4 x[4];
        if (first) {
#pragma unroll
          for (int j = 0; j < 4; ++j) x[j] = xf[r][j];
        } else {
#pragma unroll
          for (int j = 0; j < 4; ++j) x[j] = make_float4(bflo(xq[r][j].x), bfhi(xq[r][j].x), bflo(xq[r][j].y), bfhi(xq[r][j].y));
        }
        if (hasT) {
          float4 tv[4];
          float ss = 0.f;
#pragma unroll
          for (int j = 0; j < 4; ++j) {
            tv[j] = make_float4(bflo(tq[r][j].x), bfhi(tq[r][j].x), bflo(tq[r][j].y), bfhi(tq[r][j].y));
            ss += tv[j].x * tv[j].x + tv[j].y * tv[j].y + tv[j].z * tv[j].z + tv[j].w * tv[j].w;
          }
          ss = wave_sum(ss);
          const float rs = rsqrtf(ss * (1.f / 1024.f) + 1e-6f) * gscale;
          const float* mg = modg + ci * 9216 + gate_idx * 1024;
#pragma unroll
          for (int j = 0; j < 4; ++j) {
            int c = lane * 4 + 256 * j;
            float4 g4 = *(const float4*)(gT + c), m4 = *(const float4*)(mg + c);
            x[j].x += m4.x * (tv[j].x * rs * g4.x); x[j].y += m4.y * (tv[j].y * rs * g4.y);
            x[j].z += m4.z * (tv[j].z * rs * g4.z); x[j].w += m4.w * (tv[j].w * rs * g4.w);
          }
        }
        if (RMODE == 2) {
#pragma unroll
          for (int j = 0; j < 4; ++j) *(float4*)(xdst + (size_t)t * DM + lane * 4 + 256 * j) = x[j];
        } else {
#pragma unroll
          for (int j = 0; j < 4; ++j) {
            uint2 o; o.x = pack2(x[j].x, x[j].y); o.y = pack2(x[j].z, x[j].w);
            *(uint2*)((u16*)xdst + (size_t)t * DM + lane * 4 + 256 * j) = o;
          }
          float ss = 0.f;
#pragma unroll
          for (int j = 0; j < 4; ++j) ss += x[j].x * x[j].x + x[j].y * x[j].y + x[j].z * x[j].z + x[j].w * x[j].w;
          ss = wave_sum(ss);
          const float r2 = rsqrtf(ss * (1.f / 1024.f) + 1e-6f);
          const float* sh = modn + ci * 9216 + shift_idx * 1024;
          const float* sc = modn + ci * 9216 + scale_idx * 1024;
#pragma unroll
          for (int j = 0; j < 4; ++j) {
            int c = lane * 4 + 256 * j;
            float4 g4 = *(const float4*)(g2 + c), s4 = *(const float4*)(sc + c), h4 = *(const float4*)(sh + c);
            float h0 = x[j].x * r2 * g4.x * (1.f + s4.x) + h4.x;
            float h1 = x[j].y * r2 * g4.y * (1.f + s4.y) + h4.y;
            float h2 = x[j].z * r2 * g4.z * (1.f + s4.z) + h4.z;
            float h3 = x[j].w * r2 * g4.w * (1.f + s4.w) + h4.w;
            uint2 o; o.x = pack2(h0, h1); o.y = pack2(h2, h3);
            *(uint2*)(p.H + (size_t)t * DM + c) = o;
          }
        }
      }
    }
  }
}

enum { EPI_SWIGLU = 0, EPI_F32 = 1, EPI_EVIN = 2, EPI_ODIN = 3, EPI_POOL = 4, EPI_RES = 5 };
struct ResArgs { const float* gT; const float* modg; const float* g2; const float* modn; int gate; int shi; float gs; int kuse; int fin; };
using f32x4 = __attribute__((ext_vector_type(4))) float;

DI int lds_byte2(int r, int c) {
  int st = (r >> 4) * 2 + (c >> 5), ob = (r & 15) * 64 + (c & 31) * 2;
  return st * 1024 + (ob ^ (((ob >> 9) & 1) << 5));
}
DI void stage_rc2(int b, int& R, int& C) {
  int st = b >> 10, sb = b & 1023, swz = sb ^ (((sb >> 9) & 1) << 5);
  R = (st >> 1) * 16 + (swz >> 6);
  C = (st & 1) * 32 + ((swz & 63) >> 1);
}
#define WAIT_V0() asm volatile("s_waitcnt vmcnt(0)" ::: "memory")

#define LDS_RD4(a, b, c, d, addr, o0, o1, o2, o3) asm volatile( \
    "ds_read_b128 %0, %4 offset:%5\n\tds_read_b128 %1, %4 offset:%6\n\tds_read_b128 %2, %4 offset:%7\n\tds_read_b128 %3, %4 offset:%8\n\ts_waitcnt lgkmcnt(0)" \
    : "=&v"(a), "=&v"(b), "=&v"(c), "=&v"(d) : "v"(addr), "n"(o0), "n"(o1), "n"(o2), "n"(o3) : "memory")
template <int EPI, int MF, bool TAIL = false>
__device__ __forceinline__ void gemm_phase(const P& p, const u16* __restrict__ A, const u16* __restrict__ Bt, int K,
                                           int nMT, int nNT, void* outp, int ldc, char* smem, int vbid, int G, int tidx, int tlimit = 1 << 30, int tbase = 0, ResArgs ra = ResArgs{}) {
  constexpr int TILE_B = 32768, STAGE_B = 65536;
  const int wid = __builtin_amdgcn_readfirstlane(tidx >> 6), lane = tidx & 63, wr = wid >> 2, wc = wid & 3, fr = lane & 15, fq = lane >> 4;
  int sOff0;
  { int R, C; stage_rc2(wid * 1024 + lane * 16, R, C); sOff0 = R * K + C; }
  const unsigned sOffB = (unsigned)sOff0 * 2u;
  const int aOff0 = lds_byte2(wr * (16 * MF) + fr, fq * 8);
  const int bOff0 = lds_byte2(wc * 64 + fr, fq * 8);
  const int ntiles = TAIL ? tlimit : min(nMT * nNT, tlimit), nt = K >> 6;
#define GLDS_STAGE(AB, BB, buf, kt) do { _Pragma("unroll") for (int i = 0; i < 4; ++i) { \
      if (wid + 8 * i < 4 * MF) __builtin_amdgcn_global_load_lds((const unsigned*)((const char*)((AB) + (size_t)(i * 64) * K + (kt) * 64) + sOffCur), (unsigned*)(smem + (buf) * STAGE_B + wid * 1024 + i * 8192), 16, 0, 0); \
      __builtin_amdgcn_global_load_lds((const unsigned*)((const char*)((BB) + (size_t)(i * 64) * K + (kt) * 64) + sOffCur), (unsigned*)(smem + (buf) * STAGE_B + TILE_B + wid * 1024 + i * 8192), 16, 0, 0); } } while (0)
#define TILE_COORDS(T, BR, BC) do { const int ts_ = TAIL ? tbase + ((T) >> 1) : (T); \
      const int grp_ = ts_ / (8 * nNT), r2_ = ts_ - grp_ * 8 * nNT; \
      BR = (grp_ * 8 + (r2_ & 7)) * (TAIL ? 192 : 32 * MF) + (TAIL ? ((T) & 1) * 96 : 0); BC = (r2_ >> 3) * 256; } while (0)
  if (vbid < ntiles) {
    unsigned sOffCur = sOffB; asm volatile("" : "+v"(sOffCur));
    int br_, bc_; TILE_COORDS(vbid, br_, bc_);
    GLDS_STAGE(A + (size_t)br_ * K, Bt + (size_t)bc_ * K, 0, 0);
  }
  for (int tile = vbid; tile < ntiles; tile += G) {
    int brow, bcol; TILE_COORDS(tile, brow, bcol);
    unsigned sOffCur = sOffB; asm volatile("" : "+v"(sOffCur));
    const u16* Ab = A + (size_t)brow * K;
    const u16* Bb = Bt + (size_t)bcol * K;
    f32x4 acc[MF][4];
#pragma unroll
    for (int m = 0; m < MF; ++m)
#pragma unroll
      for (int n = 0; n < 4; ++n) { acc[m][n][0] = 0.f; acc[m][n][1] = 0.f; acc[m][n][2] = 0.f; acc[m][n][3] = 0.f; }
#define LDS_RD(dst, base, off) asm volatile("ds_read_b128 %0, %1 offset:%2" : "=v"(dst) : "v"(base), "n"(off))
    bf16x8 A0[MF], B0[4], A1[MF], B1[4];
    const unsigned lbase = (unsigned)(size_t)(smem);
    WAIT_V0(); __syncthreads();
    if (nt > 1) GLDS_STAGE(Ab, Bb, 1, 1);
    asm volatile("s_waitcnt lgkmcnt(0)" ::: "memory");
    {
      const unsigned la = lbase + aOff0, lb = lbase + TILE_B + bOff0;
#pragma unroll
      for (int n = 0; n < 4; ++n) LDS_RD(B0[n], lb, n * 2048);
#pragma unroll
      for (int m = 0; m < MF; ++m) LDS_RD(A0[m], la, m * 2048);
    }
    for (int t = 0; t < nt; ++t) {
      const int cur = t & 1;
      const unsigned la = lbase + cur * STAGE_B + aOff0, lb = lbase + cur * STAGE_B + TILE_B + bOff0;
      const unsigned lan = lbase + (cur ^ 1) * STAGE_B + aOff0, lbn = lbase + (cur ^ 1) * STAGE_B + TILE_B + bOff0;
#pragma unroll
      for (int n = 0; n < 4; ++n) LDS_RD(B1[n], lb, n * 2048 + 1024);
#pragma unroll
      for (int m = 0; m < MF; ++m) LDS_RD(A1[m], la, m * 2048 + 1024);
      __builtin_amdgcn_sched_barrier(0);
#pragma unroll
      for (int m = 0; m < MF; ++m) {
        if (m == 0) asm volatile("s_waitcnt lgkmcnt(%5)" : "+v"(A0[0]), "+v"(B0[0]), "+v"(B0[1]), "+v"(B0[2]), "+v"(B0[3]) : "n"(4 + MF + MF - 1));
        else asm volatile("s_waitcnt lgkmcnt(%1)" : "+v"(A0[m]) : "n"(4 + MF + MF - 1 - m));
#pragma unroll
        for (int n = 0; n < 4; ++n) acc[m][n] = __builtin_amdgcn_mfma_f32_16x16x32_bf16(A0[m], B0[n], acc[m][n], 0, 0, 0);
        __builtin_amdgcn_sched_barrier(0);
      }
      if (MF == 3) asm volatile("s_waitcnt lgkmcnt(0)" : "+v"(A1[0]), "+v"(A1[1]), "+v"(A1[MF - 1]), "+v"(B1[0]), "+v"(B1[1]), "+v"(B1[2]), "+v"(B1[3]));
      else if (MF == 6) asm volatile("s_waitcnt lgkmcnt(0)" : "+v"(A1[0]), "+v"(A1[1]), "+v"(A1[2]), "+v"(A1[3]), "+v"(A1[4]), "+v"(A1[MF - 1]), "+v"(B1[0]), "+v"(B1[1]), "+v"(B1[2]), "+v"(B1[3]));
      else asm volatile("s_waitcnt lgkmcnt(0)" : "+v"(A1[0]), "+v"(A1[1]), "+v"(A1[2]), "+v"(A1[3]), "+v"(A1[4]), "+v"(A1[5]), "+v"(A1[MF - 2]), "+v"(A1[MF - 1]), "+v"(B1[0]), "+v"(B1[1]), "+v"(B1[2]), "+v"(B1[3]));
      WAIT_V0(); __syncthreads();
      if (t + 2 < nt) { GLDS_STAGE(Ab, Bb, cur, t + 2); }
      else if (t + 1 == nt && tile + G < ntiles) {
        int br_, bc_; TILE_COORDS(tile + G, br_, bc_);
        GLDS_STAGE(A + (size_t)br_ * K, Bt + (size_t)bc_ * K, 0, 0);
      }
      if (t + 1 < nt) {
#pragma unroll
        for (int n = 0; n < 4; ++n) LDS_RD(B0[n], lbn, n * 2048);
#pragma unroll
        for (int m = 0; m < MF; ++m) LDS_RD(A0[m], lan, m * 2048);
      }
      __builtin_amdgcn_sched_barrier(0);
#pragma unroll
      for (int m = 0; m < MF; ++m) {
#pragma unroll
        for (int n = 0; n < 4; ++n) acc[m][n] = __builtin_amdgcn_mfma_f32_16x16x32_bf16(A1[m], B1[n], acc[m][n], 0, 0, 0);
      }
      __builtin_amdgcn_sched_barrier(0);
    }
#undef LDS_RD
    unsigned zl_ = 0u; asm volatile("" : "+v"(zl_));
    const int le = (int)__builtin_amdgcn_mbcnt_hi(~0u, __builtin_amdgcn_mbcnt_lo(~0u, zl_));
    const int fre = le & 15, fqe = le >> 4;
    float* Ew = (float*)(smem + STAGE_B + wid * 4352);
    const int r0 = brow + wr * (16 * MF), c0 = bcol + wc * 64;
    if (EPI == EPI_RES) {
      const int te = wid * 64 + le;
      float* rp = (float*)(smem + STAGE_B + 8 * 4352);
      float* rstat = rp + 192 * 4;
      const int mt = brow / 192, ntl = bcol >> 8;
      unsigned* flag = p.BAR + 3456 + mt * 32;
      const unsigned target = 4u * (unsigned)(ra.kuse + 1);
      float* xch0 = p.XCH + (size_t)brow * 4;
      float* xch1 = p.XCH + (size_t)(12288 + brow) * 4;
#define XCH_ST(ptr, v) __hip_atomic_store((ptr), (v), __ATOMIC_RELAXED, __HIP_MEMORY_SCOPE_AGENT)
#define XCH_LD(ptr) __hip_atomic_load((ptr), __ATOMIC_RELAXED, __HIP_MEMORY_SCOPE_AGENT)
#define ROW_EXCHANGE(FL) do { \
        asm volatile("s_waitcnt vmcnt(0)" ::: "memory"); \
        __syncthreads(); \
        if (te == 0) { \
          (void)__hip_atomic_fetch_add((FL), 1u, __ATOMIC_RELAXED, __HIP_MEMORY_SCOPE_AGENT); \
          unsigned sp_ = 0; \
          while (__hip_atomic_load((FL), __ATOMIC_RELAXED, __HIP_MEMORY_SCOPE_AGENT) < target) { __builtin_amdgcn_s_sleep(1); if (++sp_ > (1u << 22)) break; } \
        } \
        __syncthreads(); } while (0)
      const int c4 = (le & 15) * 4;
      u16* X16 = (u16*)p.X;
      uint2 xpre[MF][4];
      float4 mgpre[MF];
#pragma unroll
      for (int m = 0; m < MF; ++m) {
        const int rm = r0 + m * 16;
        const int ci = rm < MPR ? 0 : 1 + ((rm - MPR) >> 11);
        mgpre[m] = *(const float4*)(ra.modg + ci * 9216 + ra.gate * 1024 + c0 + c4);
#pragma unroll
        for (int ps = 0; ps < 4; ++ps)
          xpre[m][ps] = *(const uint2*)(X16 + (size_t)(brow + wr * 96 + m * 16 + (le >> 4) + 4 * ps) * DM + c0 + c4);
      }
#pragma unroll
      for (int m = 0; m < MF; ++m)
#pragma unroll
        for (int j = 0; j < 4; ++j) {
          float s = acc[m][0][j] * acc[m][0][j] + acc[m][1][j] * acc[m][1][j] + acc[m][2][j] * acc[m][2][j] + acc[m][3][j] * acc[m][3][j];
          s = row16_sum(s);
          if (fre == 0) rp[(wr * 96 + m * 16 + fqe * 4 + j) * 4 + wc] = s;
        }
      __syncthreads();
      if (te < 192) XCH_ST(xch0 + te * 4 + ntl, rp[te * 4] + rp[te * 4 + 1] + rp[te * 4 + 2] + rp[te * 4 + 3]);
      ROW_EXCHANGE(flag);
      if (te < 192) { const float qs = XCH_LD(xch0 + te * 4) + XCH_LD(xch0 + te * 4 + 1) + XCH_LD(xch0 + te * 4 + 2) + XCH_LD(xch0 + te * 4 + 3); rstat[te] = rsqrtf(qs * (1.f / 1024.f) + 1e-6f) * ra.gs; }
      __syncthreads();
      const float4 gT4 = *(const float4*)(ra.gT + c0 + c4);
      float4 xn[MF][4];
#pragma unroll
      for (int m = 0; m < MF; ++m) {
        const int rm = r0 + m * 16;
        const int ci = rm < MPR ? 0 : 1 + ((rm - MPR) >> 11);
        const float4 mg4 = mgpre[m];
#pragma unroll
        for (int n = 0; n < 4; ++n)
#pragma unroll
          for (int j = 0; j < 4; ++j) Ew[(fqe * 4 + j) * 68 + n * 16 + fre] = acc[m][n][j];
        f32x4 q0, q1, q2, q3;
        LDS_RD4(q0, q1, q2, q3, (unsigned)(size_t)(Ew + (le >> 4) * 68 + c4), 0, 1088, 2176, 3264);
#pragma unroll
        for (int ps = 0; ps < 4; ++ps) {
          const f32x4 qv = ps == 0 ? q0 : (ps == 1 ? q1 : (ps == 2 ? q2 : q3));
          const int rl = wr * 96 + m * 16 + (le >> 4) + 4 * ps;
          const size_t ro = (size_t)(brow + rl) * DM + c0 + c4;
          const float rs = rstat[rl];
          const uint2 xq = xpre[m][ps];
          float4 y;
          y.x = bflo(xq.x) + mg4.x * (qv[0] * rs * gT4.x); y.y = bfhi(xq.x) + mg4.y * (qv[1] * rs * gT4.y);
          y.z = bflo(xq.y) + mg4.z * (qv[2] * rs * gT4.z); y.w = bfhi(xq.y) + mg4.w * (qv[3] * rs * gT4.w);
          xn[m][ps] = y;
          if (ra.fin) { *(float4*)(p.out + ro) = y; }
          else {
            uint2 o; o.x = pack2(y.x, y.y); o.y = pack2(y.z, y.w);
            *(uint2*)(X16 + ro) = o;
            float s = y.x * y.x + y.y * y.y + y.z * y.z + y.w * y.w;
            s = row16_sum(s);
            if ((le & 15) == 0) rp[rl * 4 + wc] = s;
          }
        }
      }
      if (!ra.fin) {
        __syncthreads();
        if (te < 192) XCH_ST(xch1 + te * 4 + ntl, rp[te * 4] + rp[te * 4 + 1] + rp[te * 4 + 2] + rp[te * 4 + 3]);
        ROW_EXCHANGE(flag + 16);
        if (te < 192) { const float qs = XCH_LD(xch1 + te * 4) + XCH_LD(xch1 + te * 4 + 1) + XCH_LD(xch1 + te * 4 + 2) + XCH_LD(xch1 + te * 4 + 3); rstat[te] = rsqrtf(qs * (1.f / 1024.f) + 1e-6f); }
        __syncthreads();
        const float4 g24 = *(const float4*)(ra.g2 + c0 + c4);
#pragma unroll
        for (int m = 0; m < MF; ++m) {
          const int rm = r0 + m * 16;
          const int ci = rm < MPR ? 0 : 1 + ((rm - MPR) >> 11);
          const float4 sh4 = *(const float4*)(ra.modn + ci * 9216 + ra.shi * 1024 + c0 + c4);
          const float4 sc4 = *(const float4*)(ra.modn + ci * 9216 + (ra.shi + 1) * 1024 + c0 + c4);
#pragma unroll
          for (int ps = 0; ps < 4; ++ps) {
            const int rl = wr * 96 + m * 16 + (le >> 4) + 4 * ps;
            const float r2 = rstat[rl];
            const float4 y = xn[m][ps];
            uint2 o;
            o.x = pack2(y.x * r2 * g24.x * (1.f + sc4.x) + sh4.x, y.y * r2 * g24.y * (1.f + sc4.y) + sh4.y);
            o.y = pack2(y.z * r2 * g24.z * (1.f + sc4.z) + sh4.z, y.w * r2 * g24.w * (1.f + sc4.w) + sh4.w);
            *(uint2*)(p.H + (size_t)(brow + rl) * DM + c0 + c4) = o;
          }
        }
      }
#undef ROW_EXCHANGE
#undef XCH_ST
#undef XCH_LD
      continue;
    }
    constexpr int vlo = (EPI == EPI_EVIN) ? 1024 : 1152, vhi = (EPI == EPI_EVIN) ? 1536 : 1280;
    const bool isV = (EPI == EPI_EVIN || EPI == EPI_ODIN) && c0 >= vlo && c0 < vhi;
    float* sbase = nullptr; int hd = 0, nh = 8;
    if (EPI == EPI_EVIN) {
      if (c0 >= 512 && c0 < 1024) { sbase = p.out + OFF_SAK; hd = (c0 - 512) >> 6; }
      else if (c0 >= 1024 && c0 < 1536) { sbase = p.out + OFF_SAV; hd = (c0 - 1024) >> 6; }
    } else if (EPI == EPI_ODIN) {
      nh = 2;
      if (c0 >= 1152 && c0 < 1280) { sbase = p.out + OFF_SDV; hd = (c0 - 1152) >> 6; }
    }
    const int c4 = (le & 15) * 4;
    float4 psc = make_float4(1.f, 1.f, 1.f, 1.f);
    if (EPI == EPI_POOL) psc = *(const float4*)(p.od_pool_scale + c0 + c4);
    constexpr int ESZ = 2;
    char* orow = (EPI == EPI_SWIGLU)
        ? (char*)outp + ((size_t)(r0 + (le >> 3)) * ldc + (c0 >> 1) + (le & 7) * 4) * 2
        : (char*)outp + ((size_t)(r0 + (le >> 4)) * ldc + c0 + c4) * ESZ;
    const size_t rstride = (size_t)ldc * ESZ;
#pragma unroll
    for (int m = 0; m < MF; ++m) {
      asm volatile("" : "+v"(orow));
      const int rm = r0 + m * 16;
      float* srow = (sbase && rm < MPR) ? sbase + ((size_t)((rm >> 8) * nh + hd) * 256 + (rm & 255) + (le >> 4)) * 64 + c4 : nullptr;
      if (EPI == EPI_EVIN || EPI == EPI_ODIN) {
        if (isV) {
          const int t0 = rm + fqe * 4, kk16 = t0 & 15;
          u16* vb = p.VT + ((size_t)(((c0 - vlo) >> 6) * 384 + (t0 >> 5)) * 4 + ((t0 >> 4) & 1)) * 512 + (((kk16 >> 2) & 1) * 32) * 8 + (kk16 >> 3) * 4;
#pragma unroll
          for (int n = 0; n < 4; ++n) {
            const int dim = n * 16 + fre;
            uint2 o; o.x = pack2(acc[m][n][0], acc[m][n][1]); o.y = pack2(acc[m][n][2], acc[m][n][3]);
            *(uint2*)(vb + (dim >> 5) * 1024 + (dim & 31) * 8) = o;
          }
        }
      }
      if (EPI != EPI_SWIGLU) {
#pragma unroll
      for (int n = 0; n < 4; ++n)
#pragma unroll
        for (int j = 0; j < 4; ++j) Ew[(fqe * 4 + j) * 68 + n * 16 + fre] = acc[m][n][j];
      }
      if (EPI == EPI_EVIN) {
        if (c0 >= 512 && c0 < 1024) {
#pragma unroll
          for (int ps = 0; ps < 2; ++ps) {
            const int slot = le + 64 * ps, row = slot >> 3, ch = slot & 7;
            const float4 a = *(const float4*)(Ew + row * 68 + ch * 8), b4 = *(const float4*)(Ew + row * 68 + ch * 8 + 4);
            uint4 o; o.x = pack2(a.x, a.y); o.y = pack2(a.z, a.w); o.z = pack2(b4.x, b4.y); o.w = pack2(b4.z, b4.w);
            const int t = rm + row;
            *(uint4*)(p.KF + ((size_t)(((c0 - 512) >> 6) * 384 + (t >> 5)) * 4 + (ch >> 1)) * 512 + ((ch & 1) * 32 + (t & 31)) * 8) = o;
          }
        }
      }
      if (EPI == EPI_SWIGLU) {
        u16* ab = (u16*)outp + (size_t)(rm + fqe * 4) * ldc + (c0 >> 1) + fre;
#pragma unroll
        for (int j = 0; j < 4; ++j)
#pragma unroll
          for (int n = 0; n < 2; ++n) {
            const float g = acc[m][n][j], u = acc[m][n + 2][j];
            ab[(size_t)j * ldc + n * 16] = (u16)pack2(g / (1.f + __expf(-g)) * u, 0.f);
          }
      } else {
        f32x4 q0, q1, q2, q3;
        LDS_RD4(q0, q1, q2, q3, (unsigned)(size_t)(Ew + (le >> 4) * 68 + c4), 0, 1088, 2176, 3264);
#pragma unroll
        for (int ps = 0; ps < 4; ++ps) {
          const f32x4 qv = ps == 0 ? q0 : (ps == 1 ? q1 : (ps == 2 ? q2 : q3));
          float4 v = make_float4(qv[0], qv[1], qv[2], qv[3]);
          if (EPI == EPI_F32) {
            uint2 o; o.x = pack2(v.x, v.y); o.y = pack2(v.z, v.w);
            *(uint2*)(orow + (size_t)(4 * ps) * rstride) = o;
          } else if (EPI == EPI_POOL) {
            uint2 o; o.x = pack2(v.x * psc.x, v.y * psc.y); o.y = pack2(v.z * psc.z, v.w * psc.w);
            *(uint2*)(orow + (size_t)(4 * ps) * rstride) = o;
          } else {
            uint2 o; o.x = pack2(v.x, v.y); o.y = pack2(v.z, v.w);
            *(uint2*)(orow + (size_t)(4 * ps) * rstride) = o;
            if (srow) *(float4*)(srow + (4 * ps) * 64) = v;
          }
        }
      }
      orow += 16 * rstride;
    }
  }
#undef GLDS_STAGE
#undef TILE_COORDS
  __syncthreads();
}

struct Seg { const u16* KF; const u16* VF; int n; };

template <bool BIAS>
__device__ __forceinline__ void attn_core(const u16* __restrict__ Q, int ldq, Seg s0, Seg s1, f32x16& o0, f32x16& o1, float& m, float& l,
                                          const float* __restrict__ rpb_h, int qr, int qc0, int rs, int tidx) {
  const int lane = tidx & 63, l31 = lane & 31, lh = lane >> 5;
  bf16x8 bq[4];
#pragma unroll
  for (int kk = 0; kk < 4; ++kk) bq[kk] = *(const bf16x8*)(Q + (size_t)l31 * ldq + kk * 16 + lh * 8);
  m = -1e30f; l = 0.f;
#pragma unroll
  for (int e = 0; e < 16; ++e) { o0[e] = 0.f; o1[e] = 0.f; }
  const int qc = qc0 + l31;
  const int cs = min(max(qc - 8, 0), 48);
  const int nt0 = s0.n >> 5, ntot = nt0 + (s1.n >> 5);
  const u16* k0p = s0.KF + lane * 8;
  const u16* k1p = s1.KF + lane * 8;
  const u16* v0p = s0.VF + lane * 8;
  const u16* v1p = s1.VF + lane * 8;
  bf16x8 kA[4], kB[4], vA[4], vB[4];
#define KLOAD(dst, i_) do { const int j_ = min((i_), ntot - 1); const bool n1_ = j_ >= nt0; \
    const u16* Kp_ = n1_ ? k1p + (size_t)(j_ - nt0) * 2048 : k0p + (size_t)j_ * 2048; \
    _Pragma("unroll") for (int kk = 0; kk < 4; ++kk) dst[kk] = *(const bf16x8*)(Kp_ + kk * 512); } while (0)
#define VLOAD(dst, i_) do { const int j_ = min((i_), ntot - 1); const bool n1_ = j_ >= nt0; \
    const u16* vp_ = n1_ ? v1p + (size_t)(j_ - nt0) * 2048 : v0p + (size_t)j_ * 2048; \
    _Pragma("unroll") for (int q = 0; q < 4; ++q) dst[q] = *(const bf16x8*)(vp_ + q * 512); } while (0)
#define ATT_STEP(kf, vf, i_, kd_, vd_) do { \
    const bool in1 = (i_) >= nt0; const int kt = in1 ? (i_) - nt0 : (i_); \
    f32x16 sc; _Pragma("unroll") for (int e = 0; e < 16; ++e) sc[e] = 0.f; \
    _Pragma("unroll") for (int kk = 0; kk < 4; ++kk) sc = MFMA(kf[kk], bq[kk], sc); \
    KLOAD(kf, (i_) + (kd_)); \
    float mx = -1e30f; \
    _Pragma("unroll") for (int e = 0; e < 16; ++e) { \
      float v = sc[e] * 0.125f; \
      if (BIAS) { if (in1) { \
          const float* brow_ = rpb_h + (rs + (kt >> 1) - qr + 7) * 31;     \
          int kc = (kt & 1) * 32 + 8 * (e >> 2) + 4 * lh + (e & 3); \
          bool valid = (kc >= cs) && (kc < cs + 16); \
          unsigned co = (unsigned)min(max(kc - qc + 15, 0), 30); \
          float bv = brow_[co]; \
          v = valid ? v + bv : -1e30f; } } \
      sc[e] = v; mx = fmaxf(mx, v); \
      if (BIAS && (e & 3) == 3) __builtin_amdgcn_sched_barrier(0); } \
    mx = xor32_max(mx); \
    const float mnew = fmaxf(m, mx); \
    const float corr = __expf(m - mnew); \
    float rsum = 0.f; \
    _Pragma("unroll") for (int e = 0; e < 16; ++e) { float pv = __expf(sc[e] - mnew); sc[e] = pv; rsum += pv; } \
    rsum = xor32_sum(rsum); \
    l = l * corr + rsum; m = mnew; \
    _Pragma("unroll") for (int e = 0; e < 16; ++e) { o0[e] *= corr; o1[e] *= corr; } \
    uint4 t0, t1; \
    t0.x = pack2(sc[0], sc[1]); t0.y = pack2(sc[2], sc[3]); t0.z = pack2(sc[4], sc[5]); t0.w = pack2(sc[6], sc[7]); \
    t1.x = pack2(sc[8], sc[9]); t1.y = pack2(sc[10], sc[11]); t1.z = pack2(sc[12], sc[13]); t1.w = pack2(sc[14], sc[15]); \
    const bf16x8 pb0 = __builtin_bit_cast(bf16x8, t0), pb1 = __builtin_bit_cast(bf16x8, t1); \
    o0 = MFMA(vf[0], pb0, o0); o0 = MFMA(vf[1], pb1, o0); \
    o1 = MFMA(vf[2], pb0, o1); o1 = MFMA(vf[3], pb1, o1); \
    VLOAD(vf, (i_) + (vd_)); } while (0)
  KLOAD(kA, 0); VLOAD(vA, 0);
  if (!BIAS) { KLOAD(kB, 1); VLOAD(vB, 1); }
#pragma unroll 1
  for (int i = 0; i < ntot; i += 2) {
    if (BIAS) {
      ATT_STEP(kA, vA, i, 1, 1);
      ATT_STEP(kA, vA, i + 1, 1, 1);
    } else {
      ATT_STEP(kA, vA, i, 2, 2);
      ATT_STEP(kB, vB, i + 1, 2, 2);
    }
  }
#undef KLOAD
#undef VLOAD
#undef ATT_STEP
}

__device__ __forceinline__ void attn_store(const f32x16& o0, const f32x16& o1, float inv, u16* __restrict__ O, int ldo, int tidx) {
  const int lane = tidx & 63, l31 = lane & 31, lh = lane >> 5;
  u16* op = O + (size_t)l31 * ldo + 4 * lh;
#pragma unroll
  for (int q4 = 0; q4 < 4; ++q4) {
    uint2 a, b;
    a.x = pack2(o0[4 * q4] * inv, o0[4 * q4 + 1] * inv); a.y = pack2(o0[4 * q4 + 2] * inv, o0[4 * q4 + 3] * inv);
    b.x = pack2(o1[4 * q4] * inv, o1[4 * q4 + 1] * inv); b.y = pack2(o1[4 * q4 + 2] * inv, o1[4 * q4 + 3] * inv);
    *(uint2*)(op + 8 * q4) = a;
    *(uint2*)(op + 32 + 8 * q4) = b;
  }
}

template <bool BIAS>
__device__ __forceinline__ void attn_unit(const u16* __restrict__ Q, int ldq, Seg s0, Seg s1, u16* __restrict__ O, int ldo,
                                          const float* __restrict__ rpb_h, int qr, int qc0, int rs, int tidx) {
  f32x16 o0, o1; float m, l;
  attn_core<BIAS>(Q, ldq, s0, s1, o0, o1, m, l, rpb_h, qr, qc0, rs, tidx);
  attn_store(o0, o1, 1.f / l, O, ldo, tidx);
}

__device__ void mix_even(const P& p, int gw, int W, int tidx) {
  const int lane = tidx & 63;
  const u16* U = p.ACTU;
  u16* MO = p.H;
  for (int u0 = gw; u0 < 2048 + MTOK; u0 += W) {
   for (int sub = 0; sub < 2; ++sub) {
    int u;
    if (u0 < 1024) { if (sub) break; u = u0; }
    else if (u0 < 2048) { u = 1024 + 2 * (u0 - 1024) + sub; }
    else { if (sub) break; u = u0 + 1024; }
    if (u < 1024) {
      int b = u >> 9, h = (u >> 6) & 7, r = (u >> 1) & 31, hf = u & 1;
      int tb = MPR + b * 2048;
      int rs = min(max(r - 4, 0), 24);
      Seg s0 = { p.CAK + (size_t)((b * 8 + h) * 8) * 2048, p.CAVT + (size_t)((b * 8 + h) * 8) * 2048, 256 };
      const size_t lt = (size_t)(h * 384 + ((tb + rs * 64) >> 5)) * 2048;
      Seg s1 = { p.KF + lt, p.VT + lt, 512 };
      int q0 = tb + r * 64 + hf * 32;
      attn_unit<true>(U + (size_t)q0 * 3072 + h * 64, 3072, s0, s1, MO + (size_t)q0 * DM + h * 64, DM, p.ev_rpb + h * 465, r, hf * 32, rs, tidx);
    } else if (u < 3072) {
      int v = u - 1024; int b = v >> 6, h = (v >> 3) & 7, qb = v & 7;
      const size_t lt = (size_t)(h * 384 + b * 8) * 2048;
      Seg s0 = { p.KF + lt, p.VT + lt, 256 };
      Seg s1 = { s0.KF, s0.VF, 0 };
      int q0 = b * 256 + qb * 32;
      attn_unit<false>(U + (size_t)q0 * 3072 + h * 64, 3072, s0, s1, MO + (size_t)q0 * DM + h * 64, DM, nullptr, 0, 0, 0, tidx);
    } else {
      int t = u - 3072;
      int s, L;
      if (t < MPR) { s = t & 255; L = 256; } else { s = (t - MPR) & 2047; L = 2048; }
      const int c = lane * 8;
      float z[3][8];
#pragma unroll
      for (int d = 0; d < 3; ++d) {
        int sd = s + d - 1;
        if (sd >= 0 && sd < L) {
          const u16* row = U + (size_t)(t + d - 1) * 3072;
          uint4 cg4 = *(const uint4*)(row + 2048 + c), xb4 = *(const uint4*)(row + 2560 + c);
          z[d][0] = bflo(cg4.x) * bflo(xb4.x); z[d][1] = bfhi(cg4.x) * bfhi(xb4.x);
          z[d][2] = bflo(cg4.y) * bflo(xb4.y); z[d][3] = bfhi(cg4.y) * bfhi(xb4.y);
          z[d][4] = bflo(cg4.z) * bflo(xb4.z); z[d][5] = bfhi(cg4.z) * bfhi(xb4.z);
          z[d][6] = bflo(cg4.w) * bflo(xb4.w); z[d][7] = bfhi(cg4.w) * bfhi(xb4.w);
        } else {
#pragma unroll
          for (int j = 0; j < 8; ++j) z[d][j] = 0.f;
        }
      }
      uint4 bg4 = *(const uint4*)(U + (size_t)t * 3072 + 1536 + c);
      float bg[8] = { bflo(bg4.x), bfhi(bg4.x), bflo(bg4.y), bfhi(bg4.y), bflo(bg4.z), bfhi(bg4.z), bflo(bg4.w), bfhi(bg4.w) };
      float y[8];
#pragma unroll
      for (int j = 0; j < 8; ++j) {
        float w0 = p.ev_conv_w[c + j], w1 = p.ev_conv_w[512 + c + j], w2 = p.ev_conv_w[1024 + c + j];
        y[j] = bg[j] * (z[0][j] * w0 + z[1][j] * w1 + z[2][j] * w2 + p.ev_conv_b[c + j]);
      }
      uint4 o; o.x = pack2(y[0], y[1]); o.y = pack2(y[2], y[3]); o.z = pack2(y[4], y[5]); o.w = pack2(y[6], y[7]);
      *(uint4*)(MO + (size_t)t * DM + 512 + c) = o;
    }
   }
  }
}

__device__ void mix_odd_a(const P& p, int gw, int W, int tidx) {
  const int lane = tidx & 63;
  u16* U = p.ACTU;
  u16* POOLED = (u16*)p.T;
  const float invf = exp2f(-(float)((lane >> 1) & 15) * (13.287712379549449f / 16.f));
  for (int t = gw; t < MTOK; t += W) {
    const bool smp = t >= MPR;
    int s, L, base;
    if (!smp) { s = t & 255; L = 256; base = t - s; } else { s = (t - MPR) & 2047; L = 2048; base = t - s; }
    float cs_ = 1.f, sn_ = 0.f;
    if (smp) {
      float pos = (lane < 32) ? (float)(s >> 6) : (float)(s & 63);
      float ang = pos * invf;
      cs_ = cosf(ang); sn_ = sinf(ang);
    }
    u16* row = U + (size_t)t * 1280;
#pragma unroll 1
    for (int hd = 0; hd < 10; ++hd) {
      float v = bf2f(row[512 + hd * 64 + lane]);
      float ss = wave_sum_dpp(v * v);
      float w = hd < 8 ? p.od_q_norm[lane] : p.od_k_norm[lane];
      float nv = v * rsqrtf(ss * (1.f / 64.f) + 1e-6f) * w;
      float outv = nv;
      if (smp) {
        float pr = __builtin_bit_cast(float, __builtin_amdgcn_update_dpp(0, __builtin_bit_cast(int, nv), 0xB1, 0xF, 0xF, true));
        outv = (lane & 1) ? (pr * sn_ + nv * cs_) : (nv * cs_ - pr * sn_);
      } else if (hd >= 8) {
        int b = t >> 8;
        p.out[OFF_SDK + ((size_t)(b * 2 + (hd - 8)) * 256 + s) * 64 + lane] = nv;
      }
      if (hd < 8) row[512 + hd * 64 + lane] = f2bf(outv);
      else p.KF[((size_t)((hd - 8) * 384 + (t >> 5)) * 4 + (lane >> 4)) * 512 + (((lane >> 3) & 1) * 32 + (t & 31)) * 8 + (lane & 7)] = f2bf(outv);
    }
    {
      const int half = 1 << (lane >> 4);
      const int lo = max(s - half, 0), hi = min(s + half, L);
      const int c = lane * 8;
      float a[8];
#pragma unroll
      for (int j = 0; j < 8; ++j) a[j] = 0.f;
      for (int j = lo; j < hi; ++j) {
        uint4 v = *(const uint4*)(U + (size_t)(base + j) * 1280 + c);
        a[0] += bflo(v.x); a[1] += bfhi(v.x); a[2] += bflo(v.y); a[3] += bfhi(v.y);
        a[4] += bflo(v.z); a[5] += bfhi(v.z); a[6] += bflo(v.w); a[7] += bfhi(v.w);
      }
      const float rn = 1.f / (float)(hi - lo);
      uint4 sv = *(const uint4*)(U + (size_t)t * 1280 + c);
      uint4 o;
      o.x = pack2(a[0] * rn - bflo(sv.x), a[1] * rn - bfhi(sv.x));
      o.y = pack2(a[2] * rn - bflo(sv.y), a[3] * rn - bfhi(sv.y));
      o.z = pack2(a[4] * rn - bflo(sv.z), a[5] * rn - bfhi(sv.z));
      o.w = pack2(a[6] * rn - bflo(sv.w), a[7] * rn - bfhi(sv.w));
      *(uint4*)(POOLED + (size_t)t * 512 + c) = o;
    }
  }
}

__device__ void mix_odd_b(const P& p, int gw, int W, int tidx, char* smem) {
  const u16* U = p.ACTU;
  u16* MO = p.H;
  const int lane = tidx & 63, wave = tidx >> 6;
  for (int hu = gw; hu < 2048; hu += W) {
    const int v = hu >> 1, half = hu & 1;
    const int b = v >> 9, hq = (v >> 6) & 7, qb = v & 63, kvh = hq >> 2;
    const int tb = MPR + b * 2048;
    const size_t lt = (size_t)(kvh * 384 + (tb >> 5)) * 2048;
    Seg s0, s1;
    if (half == 0) {
      s0 = Seg{ p.CDK + (size_t)((b * 2 + kvh) * 8) * 2048, p.CDVT + (size_t)((b * 2 + kvh) * 8) * 2048, 256 };
      s1 = Seg{ p.KF + lt, p.VT + lt, 896 };
    } else {
      s0 = Seg{ p.KF + lt + (size_t)28 * 2048, p.VT + lt + (size_t)28 * 2048, 1152 };
      s1 = Seg{ p.KF + lt, p.VT + lt, 0 };
    }
    const int q0 = tb + qb * 32;
    f32x16 o0, o1; float m, l;
    attn_core<false>(U + (size_t)q0 * 1280 + 512 + hq * 64, 1280, s0, s1, o0, o1, m, l, nullptr, 0, 0, 0, tidx);
    float* cb = (float*)smem + (wave >> 1) * (34 * 64) + lane;
    if (half == 1) {
      cb[0] = m; cb[64] = l;
#pragma unroll
      for (int e = 0; e < 16; ++e) { cb[(2 + e) * 64] = o0[e]; cb[(18 + e) * 64] = o1[e]; }
    }
    __syncthreads();
    if (half == 0) {
      const float m2 = cb[0], l2 = cb[64];
      const float M = fmaxf(m, m2);
      const float a1 = __expf(m - M), a2 = __expf(m2 - M);
      const float inv = 1.f / (l * a1 + l2 * a2);
#pragma unroll
      for (int e = 0; e < 16; ++e) { o0[e] = o0[e] * a1 + cb[(2 + e) * 64] * a2; o1[e] = o1[e] * a1 + cb[(18 + e) * 64] * a2; }
      attn_store(o0, o1, inv, MO + (size_t)q0 * DM + 512 + hq * 64, DM, tidx);
    }
    __syncthreads();
  }
  for (int v = gw; v < 2048; v += W) {
    int b = v >> 6, hq = (v >> 3) & 7, qb = v & 7, kvh = hq >> 2;
    const size_t lt = (size_t)(kvh * 384 + b * 8) * 2048;
    Seg s0 = { p.KF + lt, p.VT + lt, 256 };
    Seg s1 = { s0.KF, s0.VF, 0 };
    int q0 = b * 256 + qb * 32;
    attn_unit<false>(U + (size_t)q0 * 1280 + 512 + hq * 64, 1280, s0, s1, MO + (size_t)q0 * DM + 512 + hq * 64, DM, nullptr, 0, 0, 0, tidx);
  }
}

#define XB_TMO      128
#define XB_XCNT(j)  (256  + 64 * (j))
#define XB_XSUB(j)  (1280 + 64 * (j))
#define XB_XGEN(j)  (2304 + 64 * (j))
#define XB_TOP      3328
#define XB_TOPGEN   3392
#define XCD_BAR_WORDS 3456
#define XB_SPIN_CAP (1u << 20)
#define LAS __attribute__((address_space(3)))
DI unsigned xb_ld(unsigned* p)              { return __hip_atomic_load(p, __ATOMIC_RELAXED, __HIP_MEMORY_SCOPE_AGENT); }
DI unsigned xb_add(unsigned* p, unsigned v) { return __hip_atomic_fetch_add(p, v, __ATOMIC_RELAXED, __HIP_MEMORY_SCOPE_AGENT); }
DI unsigned xb_xcc_id() { return (unsigned)__builtin_amdgcn_s_getreg((3 << 11) | 20) & 0xFu; }
#define XB_SPIN(cond, bar) do { unsigned _sp = 0; while (cond) { __builtin_amdgcn_s_sleep(1); \
    if ((++_sp & 255u) == 0u) { if (xb_ld(&(bar)[XB_TMO])) break; if (_sp > XB_SPIN_CAP) { atomicAdd(&(bar)[XB_TMO], 1u); break; } } } } while (0)
struct XcdBarrier { unsigned* bar; unsigned x; volatile LAS unsigned* st; };
DI XcdBarrier xcd_barrier_post(unsigned* bar, volatile LAS unsigned* st) {
  XcdBarrier b; b.bar = bar; b.x = xb_xcc_id(); b.st = st;
  if (threadIdx.x == 0) (void)xb_add(&bar[XB_XCNT(b.x)], 1u);
  return b;
}
DI void xcd_barrier_complete(unsigned* bar, unsigned x, unsigned& nloc, unsigned& nx) {
  const unsigned G = gridDim.x * gridDim.y * gridDim.z;
  unsigned sum, cnt, mine, sp = 0u;
  for (;;) {
    sum = 0u; cnt = 0u; mine = 0u;
#pragma unroll
    for (unsigned j = 0; j < 16; ++j) { const unsigned c = xb_ld(&bar[XB_XCNT(j)]); sum += c; cnt += (c > 0u) ? 1u : 0u; mine = (j == x) ? c : mine; }
    if (sum == G) break;
    __builtin_amdgcn_s_sleep(1);
    if ((++sp & 255u) == 0u) { if (xb_ld(&bar[XB_TMO])) break; if (sp > XB_SPIN_CAP) { atomicAdd(&bar[XB_TMO], 1u); break; } }
  }
  nloc = mine > 0u ? mine : 1u; nx = cnt > 0u ? cnt : 1u;
}
DI void xcd_barrier(const XcdBarrier& b, bool leader) {
  asm volatile("s_waitcnt vmcnt(0)" ::: "memory");
  __syncthreads();
  if (leader) {
    unsigned* bar = b.bar;
    __builtin_amdgcn_s_waitcnt(0);
    unsigned nloc = b.st[0], nx = b.st[1];
    if (nloc == 0u) { xcd_barrier_complete(bar, b.x, nloc, nx); b.st[0] = nloc; b.st[1] = nx; }
    const unsigned old = xb_add(&bar[XB_XSUB(b.x)], 1u);
    const unsigned gen = old / nloc;
    if (old + 1u == (gen + 1u) * nloc) {
      __builtin_amdgcn_fence(__ATOMIC_RELEASE, "agent");
      asm volatile("s_waitcnt vmcnt(0)" ::: "memory");
      const unsigned og = xb_add(&bar[XB_TOP], 1u);
      const unsigned tg = og / nx;
      if (og + 1u == (tg + 1u) * nx) xb_add(&bar[XB_TOPGEN], 1u);
      else XB_SPIN(xb_ld(&bar[XB_TOPGEN]) == tg, bar);
      __builtin_amdgcn_fence(__ATOMIC_ACQUIRE, "agent");
      xb_add(&bar[XB_XGEN(b.x)], 1u);
      asm volatile("s_waitcnt vmcnt(0)" ::: "memory");
    } else {
      XB_SPIN(xb_ld(&bar[XB_XGEN(b.x)]) == gen, bar);
      __builtin_amdgcn_fence(__ATOMIC_ACQUIRE, "agent");
      asm volatile("s_waitcnt vmcnt(0)" ::: "memory");
    }
  }
  __syncthreads();
}

constexpr int N_PHASES = 16;
#define GRID_SYNC() xcd_barrier(xb, wave_s == 0 && __builtin_amdgcn_mbcnt_hi(~0u, __builtin_amdgcn_mbcnt_lo(~0u, 0u)) == 0u)

#define LOADP() unsigned zop = 0u; asm volatile("" : "+v"(zop)); \
    const int tidx = wave_s * 64 + (int)__builtin_amdgcn_mbcnt_hi(~0u, __builtin_amdgcn_mbcnt_lo(~0u, zop)); \
    const int gw = vbid * (NTHR / 64) + wave_s; \
    PAK pa = pak0; asm volatile("" : "+s"(pa)); P p; \
    p.x_prompt = pa->in[0]; p.x_sample = pa->in[1]; p.cache_a_k = pa->in[2]; p.cache_a_v = pa->in[3]; p.cache_d_k = pa->in[4]; p.cache_d_v = pa->in[5]; \
    p.c = pa->in[6]; p.c_ctx = pa->in[7]; p.mod_w = pa->in[8]; p.mod_b = pa->in[9]; p.norm_w = pa->in[10]; p.ffn_w1 = pa->in[11]; p.ffn_w2 = pa->in[12]; \
    p.ev_w_in = pa->in[13]; p.ev_rpb = pa->in[14]; p.ev_conv_w = pa->in[15]; p.ev_conv_b = pa->in[16]; p.ev_w_out = pa->in[17]; \
    p.od_w_in = pa->in[18]; p.od_pool_w = pa->in[19]; p.od_pool_scale = pa->in[20]; p.od_q_norm = pa->in[21]; p.od_k_norm = pa->in[22]; p.od_w_out = pa->in[23]; \
    p.out = pa->out; \
    { char* ws = pa->ws; \
      p.W1T = (u16*)(ws + WO_W1T); p.W2T = (u16*)(ws + WO_W2T); p.EVIN = (u16*)(ws + WO_EVIN); p.EVOUT = (u16*)(ws + WO_EVOUT); \
      p.ODIN = (u16*)(ws + WO_ODIN); p.ODOUT = (u16*)(ws + WO_ODOUT); p.POOLW = (u16*)(ws + WO_POOLW); \
      p.CAK = (u16*)(ws + WO_CAK); p.CAVT = (u16*)(ws + WO_CAVT); p.CDK = (u16*)(ws + WO_CDK); p.CDVT = (u16*)(ws + WO_CDVT); \
      p.H = (u16*)(ws + WO_H); p.ACTU = (u16*)(ws + WO_ACTU); p.VT = (u16*)(ws + WO_VT); \
      p.MOD = (float*)(ws + WO_MOD); p.X = (float*)(ws + WO_X); p.T = (float*)(ws + WO_T); p.BAR = (unsigned*)(ws + WO_BAR); p.KF = (u16*)(ws + WO_KF); p.XCH = (float*)(ws + WO_XCH); }
typedef const __attribute__((address_space(4))) PA* PAK;
__global__ void __launch_bounds__(NTHR, 2) mega(PA pa_unused, int ph0, int ph1) {
  __shared__ __attribute__((aligned(1024))) char smem[LDS_BYTES];
  __shared__ uint4 xb_words;
  const int wave_s = __builtin_amdgcn_readfirstlane((int)(threadIdx.x >> 6));
  cg::grid_group grid = cg::this_grid();
  if (ph1 == 0x7fffffff) grid.sync();
  if (threadIdx.x == 0) xb_words = make_uint4(0u, 0u, 0u, 0u);
  __syncthreads();
  const PAK pak0 = (PAK)__builtin_amdgcn_kernarg_segment_ptr();
  const XcdBarrier xb = xcd_barrier_post((unsigned*)(pak0->ws + WO_BAR), (volatile LAS unsigned*)&xb_words);
  const int G = gridDim.x, bid = blockIdx.x;
  const int vbid = (G & 7) ? bid : ((bid & 7) * (G >> 3) + (bid >> 3));
  const int W = G * (NTHR / 64);
#ifndef REPMASK
#define REPMASK 0u
#endif
  for (int ph = ph0; ph < ph1; ++ph) {
   const int nrep = ((REPMASK >> ph) & 1u) ? 2 : 1;
   for (int rep = 0; rep < nrep; ++rep) {
    if (rep) { GRID_SYNC(); }
    if (ph == 0) {
      LOADP();
      prep_phase(p, smem, bid, G, tidx);
    } else if (ph == 1) {
      LOADP();
      r_phase<0>(p, true, false, nullptr, nullptr, 0, 0.f, true, p.norm_w, p.MOD, 0, 1, p.X, gw, W, tidx);
    } else {
      const int q = ph - 2;
      const int l = q / 7, s = q % 7;
#define NWMOD() const float* nw = p.norm_w + l * 6 * DM; const float* modl = p.MOD + l * 3 * 9216
      switch (s) {
        case 0: case 5: { LOADP();
          const int f = s == 0 ? 0 : 1;
          const u16* w1 = p.W1T + (size_t)(l * 2 + f) * 5632 * 1024;
          gemm_phase<EPI_SWIGLU, 6>(p, p.H, w1, 1024, 64, 22, p.ACTU, DFF, smem, vbid, G, tidx, 1280);
          gemm_phase<EPI_SWIGLU, 3, true>(p, p.H, w1, 1024, 64, 22, p.ACTU, DFF, smem, vbid, G, tidx, 256, 1280);
        } break;
        case 1: case 4: case 6: { LOADP(); NWMOD();
          const u16* A_ = s == 4 ? p.H : p.ACTU;
          const u16* B_ = s == 4 ? (l == 0 ? p.EVOUT : p.ODOUT) : p.W2T + (size_t)(l * 2 + (s == 1 ? 0 : 1)) * 1024 * 2816;
          ResArgs ra;
          ra.gT = nw + (s == 1 ? 1 : (s == 4 ? 3 : 5)) * DM;
          ra.modg = modl; ra.gate = s == 1 ? 2 : (s == 4 ? 5 : 8); ra.gs = s == 4 ? 1.0f : 0.5f;
          ra.fin = (s == 6 && l == 1) ? 1 : 0;
          ra.g2 = s == 1 ? nw + 2 * DM : (s == 4 ? nw + 4 * DM : p.norm_w + 6 * DM);
          ra.modn = s == 6 ? p.MOD + 3 * 9216 : modl;
          ra.shi = s == 1 ? 3 : (s == 4 ? 6 : 0);
          ra.kuse = 3 * l + (s == 1 ? 0 : (s == 4 ? 1 : 2));
          gemm_phase<EPI_RES, 6>(p, A_, B_, s == 4 ? 1024 : DFF, 64, 4, nullptr, DM, smem, vbid, G, tidx, 1 << 30, 0, ra);
        } break;
        case 2: { LOADP();
          if (l == 0) gemm_phase<EPI_EVIN, 6>(p, p.H, p.EVIN, 1024, 64, 12, p.ACTU, 3072, smem, vbid, G, tidx);
          else {
            gemm_phase<EPI_ODIN, 6>(p, p.H, p.ODIN, 1024, 64, 5, p.ACTU, 1280, smem, vbid, G, tidx, 256);
            gemm_phase<EPI_ODIN, 3, true>(p, p.H, p.ODIN, 1024, 64, 5, p.ACTU, 1280, smem, vbid, G, tidx, 128, 256);
            GRID_SYNC();
            mix_odd_a(p, gw, W, tidx);
          }
        } break;
        case 3: { LOADP();
          if (l == 0) mix_even(p, gw, W, tidx);
          else {
            gemm_phase<EPI_POOL, 3>(p, (const u16*)p.T, p.POOLW, 512, 128, 2, p.H, DM, smem, vbid, G, tidx);
            mix_odd_b(p, gw, W, tidx, smem);
          }
        } break;
      }
    }
   }
    if (ph + 1 < ph1) { GRID_SYNC(); }
#ifdef EXTRA_SYNCS
    if (ph == 1) { for (int es = 0; es < EXTRA_SYNCS; ++es) { GRID_SYNC(); } }
#endif
  }
}

extern "C" void kernel_launch(void* const* d_in, const int* in_sizes, int n_in, void* d_out, int out_size,
                              void* d_ws, size_t ws_size, hipStream_t stream) {
  static int grid_blocks = 0;
  if (!grid_blocks) {
    int dev = 0, cus = 0, per_cu = 0;
    hipGetDevice(&dev);
    hipDeviceGetAttribute(&cus, hipDeviceAttributeMultiprocessorCount, dev);
    hipOccupancyMaxActiveBlocksPerMultiprocessor(&per_cu, mega, NTHR, 0);
    if (per_cu > 1) per_cu = 1;
    if (per_cu < 1) per_cu = 1;
    grid_blocks = cus * per_cu;
  }
  PA p{};
  for (int i = 0; i < 24; ++i) p.in[i] = (const float*)d_in[i];
  p.out = (float*)d_out;
  p.ws = (char*)d_ws;
  if (WO_END > ws_size) { fprintf(stderr, "workspace too small: need %zu have %zu\n", (size_t)WO_END, ws_size); return; }
  (void)hipMemsetAsync(p.ws + WO_BAR, 0, (size_t)(XCD_BAR_WORDS + 2048) * 4, stream);
  int ph0 = 0, ph1 = N_PHASES;
  void* args[] = { &p, &ph0, &ph1 };
  hipError_t e = hipLaunchCooperativeKernel((void*)mega, dim3(grid_blocks), dim3(NTHR), args, 0, stream);
  if (e != hipSuccess) fprintf(stderr, "cooperative launch failed: %s (grid %d)\n", hipGetErrorString(e), grid_blocks);
}
```

```cpp
#include <hip/hip_runtime.h>
#include <hip/hip_cooperative_groups.h>
#include <cstdio>
namespace cg = cooperative_groups;

typedef unsigned short u16;
using bf16x8 = __attribute__((ext_vector_type(8))) short;
using s16x4  = __attribute__((ext_vector_type(4))) short;
using f32x16 = __attribute__((ext_vector_type(16))) float;
#define DI __device__ __forceinline__
#define MFMA(a, b, c) __builtin_amdgcn_mfma_f32_32x32x16_bf16((a), (b), (c), 0, 0, 0)

constexpr int MTOK = 12288;
constexpr int MPR  = 8192;
constexpr int DM   = 1024;
constexpr int DFF  = 2816;
constexpr int NTHR = 512;
constexpr int LDS_BYTES = 131072;
constexpr int SROW = 72;

constexpr size_t OFF_SAK = 12582912, OFF_SAV = 16777216, OFF_SDK = 20971520, OFF_SDV = 22020096;

struct P {
  const float *x_prompt, *x_sample, *cache_a_k, *cache_a_v, *cache_d_k, *cache_d_v, *c, *c_ctx;
  const float *mod_w, *mod_b, *norm_w, *ffn_w1, *ffn_w2, *ev_w_in, *ev_rpb, *ev_conv_w, *ev_conv_b, *ev_w_out;
  const float *od_w_in, *od_pool_w, *od_pool_scale, *od_q_norm, *od_k_norm, *od_w_out;
  float* out;
  u16 *W1T, *W2T, *EVIN, *EVOUT, *ODIN, *ODOUT, *POOLW, *CAK, *CAVT, *CDK, *CDVT, *H, *ACTU, *VT, *KF;
  float *MOD, *X, *T;
  unsigned* BAR;
  float* XCH;
};
struct PA {
  const float* in[24];
  float* out;
  char* ws;
};
constexpr size_t al256(size_t b) { return (b + 255) & ~(size_t)255; }
constexpr size_t WO_W1T = 0;
constexpr size_t WO_W2T = WO_W1T + al256((size_t)4 * 5632 * 1024 * 2);
constexpr size_t WO_EVIN = WO_W2T + al256((size_t)4 * 1024 * 2816 * 2);
constexpr size_t WO_EVOUT = WO_EVIN + al256((size_t)3072 * 1024 * 2);
constexpr size_t WO_ODIN = WO_EVOUT + al256((size_t)1024 * 1024 * 2);
constexpr size_t WO_ODOUT = WO_ODIN + al256((size_t)1280 * 1024 * 2);
constexpr size_t WO_POOLW = WO_ODOUT + al256((size_t)1024 * 1024 * 2);
constexpr size_t WO_CAK = WO_POOLW + al256((size_t)512 * 512 * 2);
constexpr size_t WO_CAVT = WO_CAK + al256((size_t)262144 * 2);
constexpr size_t WO_CDK = WO_CAVT + al256((size_t)262144 * 2);
constexpr size_t WO_CDVT = WO_CDK + al256((size_t)65536 * 2);
constexpr size_t WO_H = WO_CDVT + al256((size_t)65536 * 2);
constexpr size_t WO_ACTU = WO_H + al256((size_t)12288 * 1024 * 2);
constexpr size_t WO_VT = WO_ACTU + al256((size_t)12288 * 3072 * 2);
constexpr size_t WO_MOD = WO_VT + al256((size_t)512 * 12288 * 2);
constexpr size_t WO_X = WO_MOD + al256((size_t)2 * 3 * 9216 * 4);
constexpr size_t WO_T = WO_X + al256((size_t)12288 * 1024 * 4);
constexpr size_t WO_BAR = WO_T + al256((size_t)12288 * 1024 * 4);
constexpr size_t WO_KF = WO_BAR + al256((size_t)(3456 + 2048) * 4);
constexpr size_t WO_XCH = WO_KF + al256((size_t)512 * 12288 * 2);
constexpr size_t WO_END = WO_XCH + al256((size_t)2 * 12288 * 4 * 4);

DI u16 f2bf(float x) { unsigned u = __float_as_uint(x); u += 0x7fffu + ((u >> 16) & 1u); return (u16)(u >> 16); }
DI float bf2f(u16 v) { return __uint_as_float(((unsigned)v) << 16); }
DI unsigned pack2(float a, float b) { unsigned r; asm("v_cvt_pk_bf16_f32 %0, %1, %2" : "=v"(r) : "v"(a), "v"(b)); return r; }
DI float row16_sum(float v) {
  v += __builtin_bit_cast(float, __builtin_amdgcn_update_dpp(0, __builtin_bit_cast(int, v), 0xB1, 0xF, 0xF, true));
  v += __builtin_bit_cast(float, __builtin_amdgcn_update_dpp(0, __builtin_bit_cast(int, v), 0x4E, 0xF, 0xF, true));
  v += __builtin_bit_cast(float, __builtin_amdgcn_update_dpp(0, __builtin_bit_cast(int, v), 0x141, 0xF, 0xF, true));
  v += __builtin_bit_cast(float, __builtin_amdgcn_update_dpp(0, __builtin_bit_cast(int, v), 0x140, 0xF, 0xF, true));
  return v;
}
DI float xor32_max(float v) { float a = v, b = v; asm volatile("s_nop 1\n\tv_permlane32_swap_b32 %0, %1" : "+v"(a), "+v"(b)); return fmaxf(a, b); }
DI float xor32_sum(float v) { float a = v, b = v; asm volatile("s_nop 1\n\tv_permlane32_swap_b32 %0, %1" : "+v"(a), "+v"(b)); return a + b; }
DI float xor16_sum(float v) { float a = v, b = v; asm volatile("s_nop 1\n\tv_permlane16_swap_b32 %0, %1" : "+v"(a), "+v"(b)); return a + b; }
DI float wave_sum(float v) {
#pragma unroll
  for (int o = 32; o > 0; o >>= 1) v += __shfl_xor(v, o);
  return v;
}
DI float wave_sum_dpp(float v) {
  return xor32_sum(xor16_sum(row16_sum(v)));
}
DI float bflo(unsigned u) { return __uint_as_float(u << 16); }
DI float bfhi(unsigned u) { return __uint_as_float(u & 0xffff0000u); }

__device__ void mod_item(const P& p, int it, char* smem, int tidx) {
  float* sS = (float*)smem;
  float* red = sS + 3072;
  const int tid = tidx;
  const int l = it / 144, n0 = (it % 144) * 64;
  for (int i = tid; i < 3072; i += 256) {
    int r = i >> 10, k = i & 1023;
    float v = r == 0 ? p.c_ctx[k] : p.c[(r - 1) * 1024 + k];
    sS[i] = v / (1.f + expf(-v));
  }
  __syncthreads();
  const int kq = tid >> 4, cq = tid & 15;
  const float* w = p.mod_w + (size_t)l * 1024 * 9216 + (size_t)(kq * 64) * 9216 + n0 + cq * 4;
  float a00 = 0, a01 = 0, a02 = 0, a03 = 0, a10 = 0, a11 = 0, a12 = 0, a13 = 0, a20 = 0, a21 = 0, a22 = 0, a23 = 0;
#pragma unroll 1
  for (int k0 = 0; k0 < 64; k0 += 8) {
    float4 wv[8];
#pragma unroll
    for (int k = 0; k < 8; ++k) wv[k] = *(const float4*)(w + (size_t)(k0 + k) * 9216);
#pragma unroll
    for (int k = 0; k < 8; ++k) {
      float4 w4 = wv[k];
      float s0 = sS[kq * 64 + k0 + k], s1 = sS[1024 + kq * 64 + k0 + k], s2 = sS[2048 + kq * 64 + k0 + k];
      a00 += s0 * w4.x; a01 += s0 * w4.y; a02 += s0 * w4.z; a03 += s0 * w4.w;
      a10 += s1 * w4.x; a11 += s1 * w4.y; a12 += s1 * w4.z; a13 += s1 * w4.w;
      a20 += s2 * w4.x; a21 += s2 * w4.y; a22 += s2 * w4.z; a23 += s2 * w4.w;
    }
  }
  float* r0 = red + (kq * 3 + 0) * 64 + cq * 4;
  r0[0] = a00; r0[1] = a01; r0[2] = a02; r0[3] = a03;
  r0[64] = a10; r0[65] = a11; r0[66] = a12; r0[67] = a13;
  r0[128] = a20; r0[129] = a21; r0[130] = a22; r0[131] = a23;
  __syncthreads();
  if (tid < 192) {
    int r = tid >> 6, n = tid & 63;
    float s = p.mod_b[l * 9216 + n0 + n];
#pragma unroll
    for (int q = 0; q < 16; ++q) s += red[(q * 3 + r) * 64 + n];
    p.MOD[(l * 3 + r) * 9216 + n0 + n] = s;
  }
  __syncthreads();
}

struct TrItem { const float* src; u16* dst; int N, Kd, k0, n0, perm; };
DI TrItem tr_decode(const P& p, int idx) {
  TrItem t; t.perm = 0; int kt, nt;
  if (idx < 2816) { int mat = idx / 704, r = idx % 704; kt = r / 44; nt = r % 44; t.src = p.ffn_w1 + (size_t)mat * 1024 * 5632; t.N = 5632; t.Kd = 1024; t.dst = p.W1T + (size_t)mat * 5632 * 1024; t.perm = 1; }
  else if (idx < 4224) { int r0 = idx - 2816; int mat = r0 / 352, r = r0 % 352; kt = r / 8; nt = r % 8; t.src = p.ffn_w2 + (size_t)mat * 2816 * 1024; t.N = 1024; t.Kd = 2816; t.dst = p.W2T + (size_t)mat * 1024 * 2816; }
  else if (idx < 4608) { int r = idx - 4224; kt = r / 24; nt = r % 24; t.src = p.ev_w_in; t.N = 3072; t.Kd = 1024; t.dst = p.EVIN; }
  else if (idx < 4736) { int r = idx - 4608; kt = r / 8; nt = r % 8; t.src = p.ev_w_out; t.N = 1024; t.Kd = 1024; t.dst = p.EVOUT; }
  else if (idx < 4896) { int r = idx - 4736; kt = r / 10; nt = r % 10; t.src = p.od_w_in; t.N = 1280; t.Kd = 1024; t.dst = p.ODIN; }
  else if (idx < 5024) { int r = idx - 4896; kt = r / 8; nt = r % 8; t.src = p.od_w_out; t.N = 1024; t.Kd = 1024; t.dst = p.ODOUT; }
  else { int r = idx - 5024; int mat = r >> 1; kt = r & 1; nt = 0; t.src = p.od_pool_w + mat * 16384; t.N = 128; t.Kd = 512; t.dst = p.POOLW + (size_t)(mat * 128) * 512 + mat * 128; }
  t.k0 = kt * 64; t.n0 = nt * 128;
  return t;
}

__device__ void prep_phase(const P& p, char* smem_all, int bid, int G, int tid512) {
  constexpr int N_MOD = 288, N_TR = 5032, N_CC = 448;
  const int half = tid512 >> 8, tid = tid512 & 255;
  char* smem = smem_all + half * 36864;
  for (int pi = bid; pi < N_MOD / 2; pi += G) mod_item(p, 2 * pi + half, smem, tid);
  {
    float* tl = (float*)smem;
    const int r = tid >> 5, c4 = (tid & 31) * 4;
    float4 v[8];
    int tp = bid;
    TrItem cur{};
    if (tp < N_TR / 2) {
      cur = tr_decode(p, 2 * tp + half);
      const float* sp = cur.src + (size_t)(cur.k0 + r) * cur.N + cur.n0 + c4;
#pragma unroll
      for (int q = 0; q < 8; ++q) v[q] = *(const float4*)(sp + (size_t)(8 * q) * cur.N);
    }
    for (; tp < N_TR / 2; tp += G) {
      float* tpp = tl + r * 129 + c4;
#pragma unroll
      for (int q = 0; q < 8; ++q) { tpp[q * 8 * 129] = v[q].x; tpp[q * 8 * 129 + 1] = v[q].y; tpp[q * 8 * 129 + 2] = v[q].z; tpp[q * 8 * 129 + 3] = v[q].w; }
      __syncthreads();
      const TrItem me = cur;
      if (tp + G < N_TR / 2) {
        cur = tr_decode(p, 2 * (tp + G) + half);
        const float* sp = cur.src + (size_t)(cur.k0 + r) * cur.N + cur.n0 + c4;
#pragma unroll
        for (int q = 0; q < 8; ++q) v[q] = *(const float4*)(sp + (size_t)(8 * q) * cur.N);
      }
#pragma unroll
      for (int q = 0; q < 4; ++q) {
        int nn = (tid >> 3) + 32 * q, kc = tid & 7;
        int n = me.n0 + nn, nd = n;
        if (me.perm) nd = n < DFF ? ((n >> 5) * 64 + (n & 31)) : ((((n - DFF) >> 5) * 64) + 32 + ((n - DFF) & 31));
        const float* t = tl + (kc * 8) * 129 + nn;
        uint4 o;
        o.x = pack2(t[0], t[129]); o.y = pack2(t[258], t[387]); o.z = pack2(t[516], t[645]); o.w = pack2(t[774], t[903]);
        *(uint4*)(me.dst + (size_t)nd * me.Kd + me.k0 + kc * 8) = o;
      }
      __syncthreads();
    }
  }
  for (int pi = bid; pi < N_CC / 2; pi += G) {
    const int idx = 2 * pi + half;
    {
      int e0 = idx * 2048 + tid * 8;
#pragma unroll 1
      for (int j = 0; j < 8; ++j) {
        int e = e0 + j;
        if (e < 589824 && (e < 262144 || e >= 524288)) {
          const bool isA = e < 262144; const int q = isA ? e : e - 524288;
          const int x = q & 7, ln = (q >> 3) & 63, sub = (q >> 9) & 3, T = (q >> 11) & 7, bh = q >> 14;
          const int key = T * 32 + (ln & 31), d = sub * 16 + (ln >> 5) * 8 + x;
          const float v = (isA ? p.cache_a_k : p.cache_d_k)[(bh * 256 + key) * 64 + d];
          (isA ? p.CAK : p.CDK)[q] = f2bf(v);
        } else if (e < 655360) {
          const bool isA = e < 524288; const int q = isA ? e - 262144 : e - 589824;
          const int x = q & 7, ln = (q >> 3) & 63, sub = (q >> 9) & 3, T = (q >> 11) & 7, bh = q >> 14;
          const int dim = (sub >> 1) * 32 + (ln & 31), key = T * 32 + 16 * (sub & 1) + 8 * (x >> 2) + 4 * (ln >> 5) + (x & 3);
          const float v = (isA ? p.cache_a_v : p.cache_d_v)[(bh * 256 + key) * 64 + dim];
          (isA ? p.CAVT : p.CDVT)[q] = f2bf(v);
        }
        else { int q = e - 655360; int n = q >> 9, k = q & 511; if ((n >> 7) != (k >> 7)) p.POOLW[q] = 0; }
      }
    }
  }
}

template <int RMODE>
__device__ void r_phase(const P& p, bool first_unused, bool hasT_unused, const float* gT, const float* modg, int gate_idx, float gscale,
                        bool writeH, const float* g2, const float* modn, int shift_idx, int scale_idx, float* xdst, int gw, int W, int tidx) {
  const int lane = tidx & 63;
  constexpr bool first = RMODE == 0, hasT = RMODE != 0;
  constexpr int NR = 6;
  for (int t0 = gw; t0 < MTOK; t0 += NR * W) {
    float4 xf[NR][4];
    uint2 xq[NR][4], tq[NR][4];
#pragma unroll
    for (int r = 0; r < NR; ++r) {
      const int t = t0 + r * W;
      if (t < MTOK) {
        if (first) {
          const float* xs = t < MPR ? p.x_prompt + (size_t)t * DM : p.x_sample + (size_t)(t - MPR) * DM;
#pragma unroll
          for (int j = 0; j < 4; ++j) xf[r][j] = *(const float4*)(xs + lane * 4 + 256 * j);
        } else {
          const u16* xs = (const u16*)p.X + (size_t)t * DM;
          const u16* ts = (const u16*)p.T + (size_t)t * DM;
#pragma unroll
          for (int j = 0; j < 4; ++j) { xq[r][j] = *(const uint2*)(xs + lane * 4 + 256 * j); tq[r][j] = *(const uint2*)(ts + lane * 4 + 256 * j); }
        }
      }
    }
#pragma unroll
    for (int r = 0; r < NR; ++r) {
      const int t = t0 + r * W;
      if (t < MTOK) {
        const int ci = t < MPR ? 0 : 1 + ((t - MPR) >> 11);
        float4 x[4];
        if (first) {
#pragma unroll
          for (int j = 0; j < 4; ++j) x[j] = xf[r][j];
        } else {
#pragma unroll
          for (int j = 0; j < 4; ++j) x[j] = make_float4(bflo(xq[r][j].x), bfhi(xq[r][j].x), bflo(xq[r][j].y), bfhi(xq[r][j].y));
        }
        if (hasT) {
          float4 tv[4];
          float ss = 0.f;
#pragma unroll
          for (int j = 0; j < 4; ++j) {
            tv[j] = make_float4(bflo(tq[r][j].x), bfhi(tq[r][j].x), bflo(tq[r][j].y), bfhi(tq[r][j].y));
            ss += tv[j].x * tv[j].x + tv[j].y * tv[j].y + tv[j].z * tv[j].z + tv[j].w * tv[j].w;
          }
          ss = wave_sum(ss);
          const float rs = rsqrtf(ss * (1.f / 1024.f) + 1e-6f) * gscale;
          const float* mg = modg + ci * 9216 + gate_idx * 1024;
#pragma unroll
          for (int j = 0; j < 4; ++j) {
            int c = lane * 4 + 256 * j;
            float4 g4 = *(const float4*)(gT + c), m4 = *(const float4*)(mg + c);
            x[j].x += m4.x * (tv[j].x * rs * g4.x); x[j].y += m4.y * (tv[j].y * rs * g4.y);
            x[j].z += m4.z * (tv[j].z * rs * g4.z); x[j].w += m4.w * (tv[j].w * rs * g4.w);
          }
        }
        if (RMODE == 2) {
#pragma unroll
          for (int j = 0; j < 4; ++j) *(float4*)(xdst + (size_t)t * DM + lane * 4 + 256 * j) = x[j];
        } else {
#pragma unroll
          for (int j = 0; j < 4; ++j) {
            uint2 o; o.x = pack2(x[j].x, x[j].y); o.y = pack2(x[j].z, x[j].w);
            *(uint2*)((u16*)xdst + (size_t)t * DM + lane * 4 + 256 * j) = o;
          }
          float ss = 0.f;
#pragma unroll
          for (int j = 0; j < 4; ++j) ss += x[j].x * x[j].x + x[j].y * x[j].y + x[j].z * x[j].z + x[j].w * x[j].w;
          ss = wave_sum(ss);
          const float r2 = rsqrtf(ss * (1.f / 1024.f) + 1e-6f);
          const float* sh = modn + ci * 9216 + shift_idx * 1024;
          const float* sc = modn + ci * 9216 + scale_idx * 1024;
#pragma unroll
          for (int j = 0; j < 4; ++j) {
            int c = lane * 4 + 256 * j;
            float4 g4 = *(const float4*)(g2 + c), s4 = *(const float4*)(sc + c), h4 = *(const float4*)(sh + c);
            float h0 = x[j].x * r2 * g4.x * (1.f + s4.x) + h4.x;
            float h1 = x[j].y * r2 * g4.y * (1.f + s4.y) + h4.y;
            float h2 = x[j].z * r2 * g4.z * (1.f + s4.z) + h4.z;
            float h3 = x[j].w * r2 * g4.w * (1.f + s4.w) + h4.w;
            uint2 o; o.x = pack2(h0, h1); o.y = pack2(h2, h3);
            *(uint2*)(p.H + (size_t)t * DM + c) = o;
          }
        }
      }
    }
  }
}

enum { EPI_SWIGLU = 0, EPI_F32 = 1, EPI_EVIN = 2, EPI_ODIN = 3, EPI_POOL = 4, EPI_RES = 5 };
struct ResArgs { const float* gT; const float* modg; const float* g2; const float* modn; int gate; int shi; float gs; int kuse; int fin; };
using f32x4 = __attribute__((ext_vector_type(4))) float;

DI int lds_byte2(int r, int c) {
  int st = (r >> 4) * 2 + (c >> 5), ob = (r & 15) * 64 + (c & 31) * 2;
  return st * 1024 + (ob ^ (((ob >> 9) & 1) << 5));
}
DI void stage_rc2(int b, int& R, int& C) {
  int st = b >> 10, sb = b & 1023, swz = sb ^ (((sb >> 9) & 1) << 5);
  R = (st >> 1) * 16 + (swz >> 6);
  C = (st & 1) * 32 + ((swz & 63) >> 1);
}
#define WAIT_V0() asm volatile("s_waitcnt vmcnt(0)" ::: "memory")

#define LDS_RD4(a, b, c, d, addr, o0, o1, o2, o3) asm volatile( \
    "ds_read_b128 %0, %4 offset:%5\n\tds_read_b128 %1, %4 offset:%6\n\tds_read_b128 %2, %4 offset:%7\n\tds_read_b128 %3, %4 offset:%8\n\ts_waitcnt lgkmcnt(0)" \
    : "=&v"(a), "=&v"(b), "=&v"(c), "=&v"(d) : "v"(addr), "n"(o0), "n"(o1), "n"(o2), "n"(o3) : "memory")
template <int EPI, int MF, bool TAIL = false>
__device__ __forceinline__ void gemm_phase(const P& p, const u16* __restrict__ A, const u16* __restrict__ Bt, int K,
                                           int nMT, int nNT, void* outp, int ldc, char* smem, int vbid, int G, int tidx, int tlimit = 1 << 30, int tbase = 0, ResArgs ra = ResArgs{}) {
  constexpr int TILE_B = 32768, STAGE_B = 65536;
  const int wid = __builtin_amdgcn_readfirstlane(tidx >> 6), lane = tidx & 63, wr = wid >> 2, wc = wid & 3, fr = lane & 15, fq = lane >> 4;
  int sOff0;
  { int R, C; stage_rc2(wid * 1024 + lane * 16, R, C); sOff0 = R * K + C; }
  const unsigned sOffB = (unsigned)sOff0 * 2u;
  const int aOff0 = lds_byte2(wr * (16 * MF) + fr, fq * 8);
  const int bOff0 = lds_byte2(wc * 64 + fr, fq * 8);
  const int ntiles = TAIL ? tlimit : min(nMT * nNT, tlimit), nt = K >> 6;
#define GLDS_STAGE(AB, BB, buf, kt) do { _Pragma("unroll") for (int i = 0; i < 4; ++i) { \
      if (wid + 8 * i < 4 * MF) __builtin_amdgcn_global_load_lds((const unsigned*)((const char*)((AB) + (size_t)(i * 64) * K + (kt) * 64) + sOffCur), (unsigned*)(smem + (buf) * STAGE_B + wid * 1024 + i * 8192), 16, 0, 0); \
      __builtin_amdgcn_global_load_lds((const unsigned*)((const char*)((BB) + (size_t)(i * 64) * K + (kt) * 64) + sOffCur), (unsigned*)(smem + (buf) * STAGE_B + TILE_B + wid * 1024 + i * 8192), 16, 0, 0); } } while (0)
#define TILE_COORDS(T, BR, BC) do { const int ts_ = TAIL ? tbase + ((T) >> 1) : (T); \
      const int grp_ = ts_ / (8 * nNT), r2_ = ts_ - grp_ * 8 * nNT; \
      BR = (grp_ * 8 + (r2_ & 7)) * (TAIL ? 192 : 32 * MF) + (TAIL ? ((T) & 1) * 96 : 0); BC = (r2_ >> 3) * 256; } while (0)
  if (vbid < ntiles) {
    unsigned sOffCur = sOffB; asm volatile("" : "+v"(sOffCur));
    int br_, bc_; TILE_COORDS(vbid, br_, bc_);
    GLDS_STAGE(A + (size_t)br_ * K, Bt + (size_t)bc_ * K, 0, 0);
  }
  for (int tile = vbid; tile < ntiles; tile += G) {
    int brow, bcol; TILE_COORDS(tile, brow, bcol);
    unsigned sOffCur = sOffB; asm volatile("" : "+v"(sOffCur));
    const u16* Ab = A + (size_t)brow * K;
    const u16* Bb = Bt + (size_t)bcol * K;
    f32x4 acc[MF][4];
#pragma unroll
    for (int m = 0; m < MF; ++m)
#pragma unroll
      for (int n = 0; n < 4; ++n) { acc[m][n][0] = 0.f; acc[m][n][1] = 0.f; acc[m][n][2] = 0.f; acc[m][n][3] = 0.f; }
#define LDS_RD(dst, base, off) asm volatile("ds_read_b128 %0, %1 offset:%2" : "=v"(dst) : "v"(base), "n"(off))
    bf16x8 A0[MF], B0[4], A1[MF], B1[4];
    const unsigned lbase = (unsigned)(size_t)(smem);
    WAIT_V0(); __syncthreads();
    if (nt > 1) GLDS_STAGE(Ab, Bb, 1, 1);
    asm volatile("s_waitcnt lgkmcnt(0)" ::: "memory");
    {
      const unsigned la = lbase + aOff0, lb = lbase + TILE_B + bOff0;
#pragma unroll
      for (int n = 0; n < 4; ++n) LDS_RD(B0[n], lb, n * 2048);
#pragma unroll
      for (int m = 0; m < MF; ++m) LDS_RD(A0[m], la, m * 2048);
    }
    for (int t = 0; t < nt; ++t) {
      const int cur = t & 1;
      const unsigned la = lbase + cur * STAGE_B + aOff0, lb = lbase + cur * STAGE_B + TILE_B + bOff0;
      const unsigned lan = lbase + (cur ^ 1) * STAGE_B + aOff0, lbn = lbase + (cur ^ 1) * STAGE_B + TILE_B + bOff0;
#pragma unroll
      for (int n = 0; n < 4; ++n) LDS_RD(B1[n], lb, n * 2048 + 1024);
#pragma unroll
      for (int m = 0; m < MF; ++m) LDS_RD(A1[m], la, m * 2048 + 1024);
      __builtin_amdgcn_sched_barrier(0);
#pragma unroll
      for (int m = 0; m < MF; ++m) {
        if (m == 0) asm volatile("s_waitcnt lgkmcnt(%5)" : "+v"(A0[0]), "+v"(B0[0]), "+v"(B0[1]), "+v"(B0[2]), "+v"(B0[3]) : "n"(4 + MF + MF - 1));
        else asm volatile("s_waitcnt lgkmcnt(%1)" : "+v"(A0[m]) : "n"(4 + MF + MF - 1 - m));
#pragma unroll
        for (int n = 0; n < 4; ++n) acc[m][n] = __builtin_amdgcn_mfma_f32_16x16x32_bf16(A0[m], B0[n], acc[m][n], 0, 0, 0);
        __builtin_amdgcn_sched_barrier(0);
      }
      if (MF == 3) asm volatile("s_waitcnt lgkmcnt(0)" : "+v"(A1[0]), "+v"(A1[1]), "+v"(A1[MF - 1]), "+v"(B1[0]), "+v"(B1[1]), "+v"(B1[2]), "+v"(B1[3]));
      else if (MF == 6) asm volatile("s_waitcnt lgkmcnt(0)" : "+v"(A1[0]), "+v"(A1[1]), "+v"(A1[2]), "+v"(A1[3]), "+v"(A1[4]), "+v"(A1[MF - 1]), "+v"(B1[0]), "+v"(B1[1]), "+v"(B1[2]), "+v"(B1[3]));
      else asm volatile("s_waitcnt lgkmcnt(0)" : "+v"(A1[0]), "+v"(A1[1]), "+v"(A1[2]), "+v"(A1[3]), "+v"(A1[4]), "+v"(A1[5]), "+v"(A1[MF - 2]), "+v"(A1[MF - 1]), "+v"(B1[0]), "+v"(B1[1]), "+v"(B1[2]), "+v"(B1[3]));
      WAIT_V0(); __syncthreads();
      if (t + 2 < nt) { GLDS_STAGE(Ab, Bb, cur, t + 2); }
      else if (t + 1 == nt && tile + G < ntiles) {
        int br_, bc_; TILE_COORDS(tile + G, br_, bc_);
        GLDS_STAGE(A + (size_t)br_ * K, Bt + (size_t)bc_ * K, 0, 0);
      }
      if (t + 1 < nt) {
#pragma unroll
        for (int n = 0; n < 4; ++n) LDS_RD(B0[n], lbn, n * 2048);
#pragma unroll
        for (int m = 0; m < MF; ++m) LDS_RD(A0[m], lan, m * 2048);
      }
      __builtin_amdgcn_sched_barrier(0);
#pragma unroll
      for (int m = 0; m < MF; ++m) {
#pragma unroll
        for (int n = 0; n < 4; ++n) acc[m][n] = __builtin_amdgcn_mfma_f32_16x16x32_bf16(A1[m], B1[n], acc[m][n], 0, 0, 0);
      }
      __builtin_amdgcn_sched_barrier(0);
    }
#undef LDS_RD
    unsigned zl_ = 0u; asm volatile("" : "+v"(zl_));
    const int le = (int)__builtin_amdgcn_mbcnt_hi(~0u, __builtin_amdgcn_mbcnt_lo(~0u, zl_));
    const int fre = le & 15, fqe = le >> 4;
    float* Ew = (float*)(smem + STAGE_B + wid * 4352);
    const int r0 = brow + wr * (16 * MF), c0 = bcol + wc * 64;
    if (EPI == EPI_RES) {
      const int te = wid * 64 + le;
      float* rp = (float*)(smem + STAGE_B + 8 * 4352);
      float* rstat = rp + 192 * 4;
      const int mt = brow / 192, ntl = bcol >> 8;
      unsigned* flag = p.BAR + 3456 + mt * 32;
      const unsigned target = 4u * (unsigned)(ra.kuse + 1);
      float* xch0 = p.XCH + (size_t)brow * 4;
      float* xch1 = p.XCH + (size_t)(12288 + brow) * 4;
#define XCH_ST(ptr, v) __hip_atomic_store((ptr), (v), __ATOMIC_RELAXED, __HIP_MEMORY_SCOPE_AGENT)
#define XCH_LD(ptr) __hip_atomic_load((ptr), __ATOMIC_RELAXED, __HIP_MEMORY_SCOPE_AGENT)
#define ROW_EXCHANGE(FL) do { \
        asm volatile("s_waitcnt vmcnt(0)" ::: "memory"); \
        __syncthreads(); \
        if (te == 0) { \
          (void)__hip_atomic_fetch_add((FL), 1u, __ATOMIC_RELAXED, __HIP_MEMORY_SCOPE_AGENT); \
          unsigned sp_ = 0; \
          while (__hip_atomic_load((FL), __ATOMIC_RELAXED, __HIP_MEMORY_SCOPE_AGENT) < target) { __builtin_amdgcn_s_sleep(1); if (++sp_ > (1u << 22)) break; } \
        } \
        __syncthreads(); } while (0)
      const int c4 = (le & 15) * 4;
      u16* X16 = (u16*)p.X;
      uint2 xpre[MF][4];
      float4 mgpre[MF];
#pragma unroll
      for (int m = 0; m < MF; ++m) {
        const int rm = r0 + m * 16;
        const int ci = rm < MPR ? 0 : 1 + ((rm - MPR) >> 11);
        mgpre[m] = *(const float4*)(ra.modg + ci * 9216 + ra.gate * 1024 + c0 + c4);
#pragma unroll
        for (int ps = 0; ps < 4; ++ps)
          xpre[m][ps] = *(const uint2*)(X16 + (size_t)(brow + wr * 96 + m * 16 + (le >> 4) + 4 * ps) * DM + c0 + c4);
      }
#pragma unroll
      for (int m = 0; m < MF; ++m)
#pragma unroll
        for (int j = 0; j < 4; ++j) {
          float s = acc[m][0][j] * acc[m][0][j] + acc[m][1][j] * acc[m][1][j] + acc[m][2][j] * acc[m][2][j] + acc[m][3][j] * acc[m][3][j];
          s = row16_sum(s);
          if (fre == 0) rp[(wr * 96 + m * 16 + fqe * 4 + j) * 4 + wc] = s;
        }
      __syncthreads();
      if (te < 192) XCH_ST(xch0 + te * 4 + ntl, rp[te * 4] + rp[te * 4 + 1] + rp[te * 4 + 2] + rp[te * 4 + 3]);
      ROW_EXCHANGE(flag);
      if (te < 192) { const float qs = XCH_LD(xch0 + te * 4) + XCH_LD(xch0 + te * 4 + 1) + XCH_LD(xch0 + te * 4 + 2) + XCH_LD(xch0 + te * 4 + 3); rstat[te] = rsqrtf(qs * (1.f / 1024.f) + 1e-6f) * ra.gs; }
      __syncthreads();
      const float4 gT4 = *(const float4*)(ra.gT + c0 + c4);
      float4 xn[MF][4];
#pragma unroll
      for (int m = 0; m < MF; ++m) {
        const int rm = r0 + m * 16;
        const int ci = rm < MPR ? 0 : 1 + ((rm - MPR) >> 11);
        const float4 mg4 = mgpre[m];
#pragma unroll
        for (int n = 0; n < 4; ++n)
#pragma unroll
          for (int j = 0; j < 4; ++j) Ew[(fqe * 4 + j) * 68 + n * 16 + fre] = acc[m][n][j];
        f32x4 q0, q1, q2, q3;
        LDS_RD4(q0, q1, q2, q3, (unsigned)(size_t)(Ew + (le >> 4) * 68 + c4), 0, 1088, 2176, 3264);
#pragma unroll
        for (int ps = 0; ps < 4; ++ps) {
          const f32x4 qv = ps == 0 ? q0 : (ps == 1 ? q1 : (ps == 2 ? q2 : q3));
          const int rl = wr * 96 + m * 16 + (le >> 4) + 4 * ps;
          const size_t ro = (size_t)(brow + rl) * DM + c0 + c4;
          const float rs = rstat[rl];
          const uint2 xq = xpre[m][ps];
          float4 y;
          y.x = bflo(xq.x) + mg4.x * (qv[0] * rs * gT4.x); y.y = bfhi(xq.x) + mg4.y * (qv[1] * rs * gT4.y);
          y.z = bflo(xq.y) + mg4.z * (qv[2] * rs * gT4.z); y.w = bfhi(xq.y) + mg4.w * (qv[3] * rs * gT4.w);
          xn[m][ps] = y;
          if (ra.fin) { *(float4*)(p.out + ro) = y; }
          else {
            uint2 o; o.x = pack2(y.x, y.y); o.y = pack2(y.z, y.w);
            *(uint2*)(X16 + ro) = o;
            float s = y.x * y.x + y.y * y.y + y.z * y.z + y.w * y.w;
            s = row16_sum(s);
            if ((le & 15) == 0) rp[rl * 4 + wc] = s;
          }
        }
      }
      float4 shpre[MF], scpre[MF];
      float4 g24 = make_float4(0.f, 0.f, 0.f, 0.f);
      if (!ra.fin) {
        g24 = *(const float4*)(ra.g2 + c0 + c4);
#pragma unroll
        for (int m = 0; m < MF; ++m) {
          const int rm = r0 + m * 16;
          const int ci = rm < MPR ? 0 : 1 + ((rm - MPR) >> 11);
          shpre[m] = *(const float4*)(ra.modn + ci * 9216 + ra.shi * 1024 + c0 + c4);
          scpre[m] = *(const float4*)(ra.modn + ci * 9216 + (ra.shi + 1) * 1024 + c0 + c4);
        }
      }
      if (!ra.fin) {
        __syncthreads();
        if (te < 192) XCH_ST(xch1 + te * 4 + ntl, rp[te * 4] + rp[te * 4 + 1] + rp[te * 4 + 2] + rp[te * 4 + 3]);
        ROW_EXCHANGE(flag + 16);
        if (te < 192) { const float qs = XCH_LD(xch1 + te * 4) + XCH_LD(xch1 + te * 4 + 1) + XCH_LD(xch1 + te * 4 + 2) + XCH_LD(xch1 + te * 4 + 3); rstat[te] = rsqrtf(qs * (1.f / 1024.f) + 1e-6f); }
        __syncthreads();
#pragma unroll
        for (int m = 0; m < MF; ++m) {
          const float4 sh4 = shpre[m], sc4 = scpre[m];
#pragma unroll
          for (int ps = 0; ps < 4; ++ps) {
            const int rl = wr * 96 + m * 16 + (le >> 4) + 4 * ps;
            const float r2 = rstat[rl];
            const float4 y = xn[m][ps];
            uint2 o;
            o.x = pack2(y.x * r2 * g24.x * (1.f + sc4.x) + sh4.x, y.y * r2 * g24.y * (1.f + sc4.y) + sh4.y);
            o.y = pack2(y.z * r2 * g24.z * (1.f + sc4.z) + sh4.z, y.w * r2 * g24.w * (1.f + sc4.w) + sh4.w);
            *(uint2*)(p.H + (size_t)(brow + rl) * DM + c0 + c4) = o;
          }
        }
      }
#undef ROW_EXCHANGE
#undef XCH_ST
#undef XCH_LD
      continue;
    }
    constexpr int vlo = (EPI == EPI_EVIN) ? 1024 : 1152, vhi = (EPI == EPI_EVIN) ? 1536 : 1280;
    const bool isV = (EPI == EPI_EVIN || EPI == EPI_ODIN) && c0 >= vlo && c0 < vhi;
    float* sbase = nullptr; int hd = 0, nh = 8;
    if (EPI == EPI_EVIN) {
      if (c0 >= 512 && c0 < 1024) { sbase = p.out + OFF_SAK; hd = (c0 - 512) >> 6; }
      else if (c0 >= 1024 && c0 < 1536) { sbase = p.out + OFF_SAV; hd = (c0 - 1024) >> 6; }
    } else if (EPI == EPI_ODIN) {
      nh = 2;
      if (c0 >= 1152 && c0 < 1280) { sbase = p.out + OFF_SDV; hd = (c0 - 1152) >> 6; }
    }
    const int c4 = (le & 15) * 4;
    float4 psc = make_float4(1.f, 1.f, 1.f, 1.f);
    if (EPI == EPI_POOL) psc = *(const float4*)(p.od_pool_scale + c0 + c4);
    constexpr int ESZ = 2;
    char* orow = (EPI == EPI_SWIGLU)
        ? (char*)outp + ((size_t)(r0 + (le >> 3)) * ldc + (c0 >> 1) + (le & 7) * 4) * 2
        : (char*)outp + ((size_t)(r0 + (le >> 4)) * ldc + c0 + c4) * ESZ;
    const size_t rstride = (size_t)ldc * ESZ;
#pragma unroll
    for (int m = 0; m < MF; ++m) {
      asm volatile("" : "+v"(orow));
      const int rm = r0 + m * 16;
      float* srow = (sbase && rm < MPR) ? sbase + ((size_t)((rm >> 8) * nh + hd) * 256 + (rm & 255) + (le >> 4)) * 64 + c4 : nullptr;
      if (EPI == EPI_EVIN || EPI == EPI_ODIN) {
        if (isV) {
          const int t0 = rm + fqe * 4, kk16 = t0 & 15;
          u16* vb = p.VT + ((size_t)(((c0 - vlo) >> 6) * 384 + (t0 >> 5)) * 4 + ((t0 >> 4) & 1)) * 512 + (((kk16 >> 2) & 1) * 32) * 8 + (kk16 >> 3) * 4;
#pragma unroll
          for (int n = 0; n < 4; ++n) {
            const int dim = n * 16 + fre;
            uint2 o; o.x = pack2(acc[m][n][0], acc[m][n][1]); o.y = pack2(acc[m][n][2], acc[m][n][3]);
            *(uint2*)(vb + (dim >> 5) * 1024 + (dim & 31) * 8) = o;
          }
        }
      }
      if (EPI != EPI_SWIGLU) {
#pragma unroll
      for (int n = 0; n < 4; ++n)
#pragma unroll
        for (int j = 0; j < 4; ++j) Ew[(fqe * 4 + j) * 68 + n * 16 + fre] = acc[m][n][j];
      }
      if (EPI == EPI_EVIN) {
        if (c0 >= 512 && c0 < 1024) {
#pragma unroll
          for (int ps = 0; ps < 2; ++ps) {
            const int slot = le + 64 * ps, row = slot >> 3, ch = slot & 7;
            const float4 a = *(const float4*)(Ew + row * 68 + ch * 8), b4 = *(const float4*)(Ew + row * 68 + ch * 8 + 4);
            uint4 o; o.x = pack2(a.x, a.y); o.y = pack2(a.z, a.w); o.z = pack2(b4.x, b4.y); o.w = pack2(b4.z, b4.w);
            const int t = rm + row;
            *(uint4*)(p.KF + ((size_t)(((c0 - 512) >> 6) * 384 + (t >> 5)) * 4 + (ch >> 1)) * 512 + ((ch & 1) * 32 + (t & 31)) * 8) = o;
          }
        }
      }
      if (EPI == EPI_SWIGLU) {
        u16* ab = (u16*)outp + (size_t)(rm + fqe * 4) * ldc + (c0 >> 1) + fre;
#pragma unroll
        for (int j = 0; j < 4; ++j)
#pragma unroll
          for (int n = 0; n < 2; ++n) {
            const float g = acc[m][n][j], u = acc[m][n + 2][j];
            ab[(size_t)j * ldc + n * 16] = (u16)pack2(g * u * __builtin_amdgcn_rcpf(1.f + __expf(-g)), 0.f);
          }
      } else {
        f32x4 q0, q1, q2, q3;
        LDS_RD4(q0, q1, q2, q3, (unsigned)(size_t)(Ew + (le >> 4) * 68 + c4), 0, 1088, 2176, 3264);
#pragma unroll
        for (int ps = 0; ps < 4; ++ps) {
          const f32x4 qv = ps == 0 ? q0 : (ps == 1 ? q1 : (ps == 2 ? q2 : q3));
          float4 v = make_float4(qv[0], qv[1], qv[2], qv[3]);
          if (EPI == EPI_F32) {
            uint2 o; o.x = pack2(v.x, v.y); o.y = pack2(v.z, v.w);
            *(uint2*)(orow + (size_t)(4 * ps) * rstride) = o;
          } else if (EPI == EPI_POOL) {
            uint2 o; o.x = pack2(v.x * psc.x, v.y * psc.y); o.y = pack2(v.z * psc.z, v.w * psc.w);
            *(uint2*)(orow + (size_t)(4 * ps) * rstride) = o;
          } else {
            uint2 o; o.x = pack2(v.x, v.y); o.y = pack2(v.z, v.w);
            *(uint2*)(orow + (size_t)(4 * ps) * rstride) = o;
            if (srow) *(float4*)(srow + (4 * ps) * 64) = v;
          }
        }
      }
      orow += 16 * rstride;
    }
  }
#undef GLDS_STAGE
#undef TILE_COORDS
  __syncthreads();
}

struct Seg { const u16* KF; const u16* VF; int n; };

template <bool BIAS>
__device__ __forceinline__ void attn_core(const u16* __restrict__ Q, int ldq, Seg s0, Seg s1, f32x16& o0, f32x16& o1, float& m, float& l,
                                          const float* __restrict__ rpb_h, int qr, int qc0, int rs, int tidx) {
  const int lane = tidx & 63, l31 = lane & 31, lh = lane >> 5;
  bf16x8 bq[4];
#pragma unroll
  for (int kk = 0; kk < 4; ++kk) bq[kk] = *(const bf16x8*)(Q + (size_t)l31 * ldq + kk * 16 + lh * 8);
  m = -1e30f; l = 0.f;
#pragma unroll
  for (int e = 0; e < 16; ++e) { o0[e] = 0.f; o1[e] = 0.f; }
  const int qc = qc0 + l31;
  const int cs = min(max(qc - 8, 0), 48);
  const int nt0 = s0.n >> 5, ntot = nt0 + (s1.n >> 5);
  const u16* k0p = s0.KF + lane * 8;
  const u16* k1p = s1.KF + lane * 8;
  const u16* v0p = s0.VF + lane * 8;
  const u16* v1p = s1.VF + lane * 8;
  bf16x8 kA[4], kB[4], vA[4], vB[4];
#define KLOAD(dst, i_) do { const int j_ = min((i_), ntot - 1); const bool n1_ = j_ >= nt0; \
    const u16* Kp_ = n1_ ? k1p + (size_t)(j_ - nt0) * 2048 : k0p + (size_t)j_ * 2048; \
    _Pragma("unroll") for (int kk = 0; kk < 4; ++kk) dst[kk] = *(const bf16x8*)(Kp_ + kk * 512); } while (0)
#define VLOAD(dst, i_) do { const int j_ = min((i_), ntot - 1); const bool n1_ = j_ >= nt0; \
    const u16* vp_ = n1_ ? v1p + (size_t)(j_ - nt0) * 2048 : v0p + (size_t)j_ * 2048; \
    _Pragma("unroll") for (int q = 0; q < 4; ++q) dst[q] = *(const bf16x8*)(vp_ + q * 512); } while (0)
#define ATT_STEP(kf, vf, i_, kd_, vd_) do { \
    const bool in1 = (i_) >= nt0; const int kt = in1 ? (i_) - nt0 : (i_); \
    f32x16 sc; _Pragma("unroll") for (int e = 0; e < 16; ++e) sc[e] = 0.f; \
    _Pragma("unroll") for (int kk = 0; kk < 4; ++kk) sc = MFMA(kf[kk], bq[kk], sc); \
    KLOAD(kf, (i_) + (kd_)); \
    float mx = -1e30f; \
    _Pragma("unroll") for (int e = 0; e < 16; ++e) { \
      float v = sc[e] * 0.125f; \
      if (BIAS) { if (in1) { \
          const float* brow_ = rpb_h + (rs + (kt >> 1) - qr + 7) * 31;     \
          int kc = (kt & 1) * 32 + 8 * (e >> 2) + 4 * lh + (e & 3); \
          bool valid = (kc >= cs) && (kc < cs + 16); \
          unsigned co = (unsigned)min(max(kc - qc + 15, 0), 30); \
          float bv = brow_[co]; \
          v = valid ? v + bv : -1e30f; } } \
      sc[e] = v; mx = fmaxf(mx, v); \
      if (BIAS && (e & 3) == 3) __builtin_amdgcn_sched_barrier(0); } \
    mx = xor32_max(mx); \
    const float mnew = fmaxf(m, mx); \
    const float corr = __expf(m - mnew); \
    float rsum = 0.f; \
    _Pragma("unroll") for (int e = 0; e < 16; ++e) { float pv = __expf(sc[e] - mnew); sc[e] = pv; rsum += pv; } \
    rsum = xor32_sum(rsum); \
    l = l * corr + rsum; m = mnew; \
    _Pragma("unroll") for (int e = 0; e < 16; ++e) { o0[e] *= corr; o1[e] *= corr; } \
    uint4 t0, t1; \
    t0.x = pack2(sc[0], sc[1]); t0.y = pack2(sc[2], sc[3]); t0.z = pack2(sc[4], sc[5]); t0.w = pack2(sc[6], sc[7]); \
    t1.x = pack2(sc[8], sc[9]); t1.y = pack2(sc[10], sc[11]); t1.z = pack2(sc[12], sc[13]); t1.w = pack2(sc[14], sc[15]); \
    const bf16x8 pb0 = __builtin_bit_cast(bf16x8, t0), pb1 = __builtin_bit_cast(bf16x8, t1); \
    o0 = MFMA(vf[0], pb0, o0); o0 = MFMA(vf[1], pb1, o0); \
    o1 = MFMA(vf[2], pb0, o1); o1 = MFMA(vf[3], pb1, o1); \
    VLOAD(vf, (i_) + (vd_)); } while (0)
  KLOAD(kA, 0); VLOAD(vA, 0);
  if (!BIAS) { KLOAD(kB, 1); VLOAD(vB, 1); }
#pragma unroll 1
  for (int i = 0; i < ntot; i += 2) {
    if (BIAS) {
      ATT_STEP(kA, vA, i, 1, 1);
      ATT_STEP(kA, vA, i + 1, 1, 1);
    } else {
      ATT_STEP(kA, vA, i, 2, 2);
      ATT_STEP(kB, vB, i + 1, 2, 2);
    }
  }
#undef KLOAD
#undef VLOAD
#undef ATT_STEP
}

__device__ __forceinline__ void attn_store(const f32x16& o0, const f32x16& o1, float inv, u16* __restrict__ O, int ldo, int tidx) {
  const int lane = tidx & 63, l31 = lane & 31, lh = lane >> 5;
  u16* op = O + (size_t)l31 * ldo + 4 * lh;
#pragma unroll
  for (int q4 = 0; q4 < 4; ++q4) {
    uint2 a, b;
    a.x = pack2(o0[4 * q4] * inv, o0[4 * q4 + 1] * inv); a.y = pack2(o0[4 * q4 + 2] * inv, o0[4 * q4 + 3] * inv);
    b.x = pack2(o1[4 * q4] * inv, o1[4 * q4 + 1] * inv); b.y = pack2(o1[4 * q4 + 2] * inv, o1[4 * q4 + 3] * inv);
    *(uint2*)(op + 8 * q4) = a;
    *(uint2*)(op + 32 + 8 * q4) = b;
  }
}

template <bool BIAS>
__device__ __forceinline__ void attn_unit(const u16* __restrict__ Q, int ldq, Seg s0, Seg s1, u16* __restrict__ O, int ldo,
                                          const float* __restrict__ rpb_h, int qr, int qc0, int rs, int tidx) {
  f32x16 o0, o1; float m, l;
  attn_core<BIAS>(Q, ldq, s0, s1, o0, o1, m, l, rpb_h, qr, qc0, rs, tidx);
  attn_store(o0, o1, 1.f / l, O, ldo, tidx);
}

__device__ void mix_even(const P& p, int gw, int W, int tidx) {
  const int lane = tidx & 63;
  const u16* U = p.ACTU;
  u16* MO = p.H;
  for (int u0 = gw; u0 < 2048 + MTOK; u0 += W) {
   for (int sub = 0; sub < 2; ++sub) {
    int u;
    if (u0 < 1024) { if (sub) break; u = u0; }
    else if (u0 < 2048) { u = 1024 + 2 * (u0 - 1024) + sub; }
    else { if (sub) break; u = u0 + 1024; }
    if (u < 1024) {
      int b = u >> 9, h = (u >> 6) & 7, r = (u >> 1) & 31, hf = u & 1;
      int tb = MPR + b * 2048;
      int rs = min(max(r - 4, 0), 24);
      Seg s0 = { p.CAK + (size_t)((b * 8 + h) * 8) * 2048, p.CAVT + (size_t)((b * 8 + h) * 8) * 2048, 256 };
      const size_t lt = (size_t)(h * 384 + ((tb + rs * 64) >> 5)) * 2048;
      Seg s1 = { p.KF + lt, p.VT + lt, 512 };
      int q0 = tb + r * 64 + hf * 32;
      attn_unit<true>(U + (size_t)q0 * 3072 + h * 64, 3072, s0, s1, MO + (size_t)q0 * DM + h * 64, DM, p.ev_rpb + h * 465, r, hf * 32, rs, tidx);
    } else if (u < 3072) {
      int v = u - 1024; int b = v >> 6, h = (v >> 3) & 7, qb = v & 7;
      const size_t lt = (size_t)(h * 384 + b * 8) * 2048;
      Seg s0 = { p.KF + lt, p.VT + lt, 256 };
      Seg s1 = { s0.KF, s0.VF, 0 };
      int q0 = b * 256 + qb * 32;
      attn_unit<false>(U + (size_t)q0 * 3072 + h * 64, 3072, s0, s1, MO + (size_t)q0 * DM + h * 64, DM, nullptr, 0, 0, 0, tidx);
    } else {
      int t = u - 3072;
      int s, L;
      if (t < MPR) { s = t & 255; L = 256; } else { s = (t - MPR) & 2047; L = 2048; }
      const int c = lane * 8;
      float z[3][8];
#pragma unroll
      for (int d = 0; d < 3; ++d) {
        int sd = s + d - 1;
        if (sd >= 0 && sd < L) {
          const u16* row = U + (size_t)(t + d - 1) * 3072;
          uint4 cg4 = *(const uint4*)(row + 2048 + c), xb4 = *(const uint4*)(row + 2560 + c);
          z[d][0] = bflo(cg4.x) * bflo(xb4.x); z[d][1] = bfhi(cg4.x) * bfhi(xb4.x);
          z[d][2] = bflo(cg4.y) * bflo(xb4.y); z[d][3] = bfhi(cg4.y) * bfhi(xb4.y);
          z[d][4] = bflo(cg4.z) * bflo(xb4.z); z[d][5] = bfhi(cg4.z) * bfhi(xb4.z);
          z[d][6] = bflo(cg4.w) * bflo(xb4.w); z[d][7] = bfhi(cg4.w) * bfhi(xb4.w);
        } else {
#pragma unroll
          for (int j = 0; j < 8; ++j) z[d][j] = 0.f;
        }
      }
      uint4 bg4 = *(const uint4*)(U + (size_t)t * 3072 + 1536 + c);
      float bg[8] = { bflo(bg4.x), bfhi(bg4.x), bflo(bg4.y), bfhi(bg4.y), bflo(bg4.z), bfhi(bg4.z), bflo(bg4.w), bfhi(bg4.w) };
      float y[8];
#pragma unroll
      for (int j = 0; j < 8; ++j) {
        float w0 = p.ev_conv_w[c + j], w1 = p.ev_conv_w[512 + c + j], w2 = p.ev_conv_w[1024 + c + j];
        y[j] = bg[j] * (z[0][j] * w0 + z[1][j] * w1 + z[2][j] * w2 + p.ev_conv_b[c + j]);
      }
      uint4 o; o.x = pack2(y[0], y[1]); o.y = pack2(y[2], y[3]); o.z = pack2(y[4], y[5]); o.w = pack2(y[6], y[7]);
      *(uint4*)(MO + (size_t)t * DM + 512 + c) = o;
    }
   }
  }
}

__device__ void mix_odd_a(const P& p, int gw, int W, int tidx) {
  const int lane = tidx & 63;
  u16* U = p.ACTU;
  u16* POOLED = (u16*)p.T;
  const float invf = exp2f(-(float)((lane >> 1) & 15) * (13.287712379549449f / 16.f));
  for (int t = gw; t < MTOK; t += W) {
    const bool smp = t >= MPR;
    int s, L, base;
    if (!smp) { s = t & 255; L = 256; base = t - s; } else { s = (t - MPR) & 2047; L = 2048; base = t - s; }
    float cs_ = 1.f, sn_ = 0.f;
    if (smp) {
      float pos = (lane < 32) ? (float)(s >> 6) : (float)(s & 63);
      float ang = pos * invf;
      cs_ = cosf(ang); sn_ = sinf(ang);
    }
    u16* row = U + (size_t)t * 1280;
#pragma unroll 1
    for (int hd = 0; hd < 10; ++hd) {
      float v = bf2f(row[512 + hd * 64 + lane]);
      float ss = wave_sum_dpp(v * v);
      float w = hd < 8 ? p.od_q_norm[lane] : p.od_k_norm[lane];
      float nv = v * rsqrtf(ss * (1.f / 64.f) + 1e-6f) * w;
      float outv = nv;
      if (smp) {
        float pr = __builtin_bit_cast(float, __builtin_amdgcn_update_dpp(0, __builtin_bit_cast(int, nv), 0xB1, 0xF, 0xF, true));
        outv = (lane & 1) ? (pr * sn_ + nv * cs_) : (nv * cs_ - pr * sn_);
      } else if (hd >= 8) {
        int b = t >> 8;
        p.out[OFF_SDK + ((size_t)(b * 2 + (hd - 8)) * 256 + s) * 64 + lane] = nv;
      }
      if (hd < 8) row[512 + hd * 64 + lane] = f2bf(outv);
      else p.KF[((size_t)((hd - 8) * 384 + (t >> 5)) * 4 + (lane >> 4)) * 512 + (((lane >> 3) & 1) * 32 + (t & 31)) * 8 + (lane & 7)] = f2bf(outv);
    }
    {
      const int half = 1 << (lane >> 4);
      const int lo = max(s - half, 0), hi = min(s + half, L);
      const int c = lane * 8;
      float a[8];
#pragma unroll
      for (int j = 0; j < 8; ++j) a[j] = 0.f;
      for (int j = lo; j < hi; ++j) {
        uint4 v = *(const uint4*)(U + (size_t)(base + j) * 1280 + c);
        a[0] += bflo(v.x); a[1] += bfhi(v.x); a[2] += bflo(v.y); a[3] += bfhi(v.y);
        a[4] += bflo(v.z); a[5] += bfhi(v.z); a[6] += bflo(v.w); a[7] += bfhi(v.w);
      }
      const float rn = 1.f / (float)(hi - lo);
      uint4 sv = *(const uint4*)(U + (size_t)t * 1280 + c);
      uint4 o;
      o.x = pack2(a[0] * rn - bflo(sv.x), a[1] * rn - bfhi(sv.x));
      o.y = pack2(a[2] * rn - bflo(sv.y), a[3] * rn - bfhi(sv.y));
      o.z = pack2(a[4] * rn - bflo(sv.z), a[5] * rn - bfhi(sv.z));
      o.w = pack2(a[6] * rn - bflo(sv.w), a[7] * rn - bfhi(sv.w));
      *(uint4*)(POOLED + (size_t)t * 512 + c) = o;
    }
  }
}

__device__ void mix_odd_b(const P& p, int gw, int W, int tidx, char* smem) {
  const u16* U = p.ACTU;
  u16* MO = p.H;
  const int lane = tidx & 63, wave = tidx >> 6;
  for (int hu = gw; hu < 2048; hu += W) {
    const int v = hu >> 1, half = hu & 1;
    const int b = v >> 9, hq = (v >> 6) & 7, qb = v & 63, kvh = hq >> 2;
    const int tb = MPR + b * 2048;
    const size_t lt = (size_t)(kvh * 384 + (tb >> 5)) * 2048;
    Seg s0, s1;
    if (half == 0) {
      s0 = Seg{ p.CDK + (size_t)((b * 2 + kvh) * 8) * 2048, p.CDVT + (size_t)((b * 2 + kvh) * 8) * 2048, 256 };
      s1 = Seg{ p.KF + lt, p.VT + lt, 896 };
    } else {
      s0 = Seg{ p.KF + lt + (size_t)28 * 2048, p.VT + lt + (size_t)28 * 2048, 1152 };
      s1 = Seg{ p.KF + lt, p.VT + lt, 0 };
    }
    const int q0 = tb + qb * 32;
    f32x16 o0, o1; float m, l;
    attn_core<false>(U + (size_t)q0 * 1280 + 512 + hq * 64, 1280, s0, s1, o0, o1, m, l, nullptr, 0, 0, 0, tidx);
    float* cb = (float*)smem + (wave >> 1) * (34 * 64) + lane;
    if (half == 1) {
      cb[0] = m; cb[64] = l;
#pragma unroll
      for (int e = 0; e < 16; ++e) { cb[(2 + e) * 64] = o0[e]; cb[(18 + e) * 64] = o1[e]; }
    }
    __syncthreads();
    if (half == 0) {
      const float m2 = cb[0], l2 = cb[64];
      const float M = fmaxf(m, m2);
      const float a1 = __expf(m - M), a2 = __expf(m2 - M);
      const float inv = 1.f / (l * a1 + l2 * a2);
#pragma unroll
      for (int e = 0; e < 16; ++e) { o0[e] = o0[e] * a1 + cb[(2 + e) * 64] * a2; o1[e] = o1[e] * a1 + cb[(18 + e) * 64] * a2; }
      attn_store(o0, o1, inv, MO + (size_t)q0 * DM + 512 + hq * 64, DM, tidx);
    }
    __syncthreads();
  }
  for (int v = gw; v < 2048; v += W) {
    int b = v >> 6, hq = (v >> 3) & 7, qb = v & 7, kvh = hq >> 2;
    const size_t lt = (size_t)(kvh * 384 + b * 8) * 2048;
    Seg s0 = { p.KF + lt, p.VT + lt, 256 };
    Seg s1 = { s0.KF, s0.VF, 0 };
    int q0 = b * 256 + qb * 32;
    attn_unit<false>(U + (size_t)q0 * 1280 + 512 + hq * 64, 1280, s0, s1, MO + (size_t)q0 * DM + 512 + hq * 64, DM, nullptr, 0, 0, 0, tidx);
  }
}

#define XB_TMO      128
#define XB_XCNT(j)  (256  + 64 * (j))
#define XB_XSUB(j)  (1280 + 64 * (j))
#define XB_XGEN(j)  (2304 + 64 * (j))
#define XB_TOP      3328
#define XB_TOPGEN   3392
#define XCD_BAR_WORDS 3456
#define XB_SPIN_CAP (1u << 20)
#define LAS __attribute__((address_space(3)))
DI unsigned xb_ld(unsigned* p)              { return __hip_atomic_load(p, __ATOMIC_RELAXED, __HIP_MEMORY_SCOPE_AGENT); }
DI unsigned xb_add(unsigned* p, unsigned v) { return __hip_atomic_fetch_add(p, v, __ATOMIC_RELAXED, __HIP_MEMORY_SCOPE_AGENT); }
DI unsigned xb_xcc_id() { return (unsigned)__builtin_amdgcn_s_getreg((3 << 11) | 20) & 0xFu; }
#define XB_SPIN(cond, bar) do { unsigned _sp = 0; while (cond) { __builtin_amdgcn_s_sleep(1); \
    if ((++_sp & 255u) == 0u) { if (xb_ld(&(bar)[XB_TMO])) break; if (_sp > XB_SPIN_CAP) { atomicAdd(&(bar)[XB_TMO], 1u); break; } } } } while (0)
struct XcdBarrier { unsigned* bar; unsigned x; volatile LAS unsigned* st; };
DI XcdBarrier xcd_barrier_post(unsigned* bar, volatile LAS unsigned* st) {
  XcdBarrier b; b.bar = bar; b.x = xb_xcc_id(); b.st = st;
  if (threadIdx.x == 0) (void)xb_add(&bar[XB_XCNT(b.x)], 1u);
  return b;
}
DI void xcd_barrier_complete(unsigned* bar, unsigned x, unsigned& nloc, unsigned& nx) {
  const unsigned G = gridDim.x * gridDim.y * gridDim.z;
  unsigned sum, cnt, mine, sp = 0u;
  for (;;) {
    sum = 0u; cnt = 0u; mine = 0u;
#pragma unroll
    for (unsigned j = 0; j < 16; ++j) { const unsigned c = xb_ld(&bar[XB_XCNT(j)]); sum += c; cnt += (c > 0u) ? 1u : 0u; mine = (j == x) ? c : mine; }
    if (sum == G) break;
    __builtin_amdgcn_s_sleep(1);
    if ((++sp & 255u) == 0u) { if (xb_ld(&bar[XB_TMO])) break; if (sp > XB_SPIN_CAP) { atomicAdd(&bar[XB_TMO], 1u); break; } }
  }
  nloc = mine > 0u ? mine : 1u; nx = cnt > 0u ? cnt : 1u;
}
DI void xcd_barrier(const XcdBarrier& b, bool leader) {
  asm volatile("s_waitcnt vmcnt(0)" ::: "memory");
  __syncthreads();
  if (leader) {
    unsigned* bar = b.bar;
    __builtin_amdgcn_s_waitcnt(0);
    unsigned nloc = b.st[0], nx = b.st[1];
    if (nloc == 0u) { xcd_barrier_complete(bar, b.x, nloc, nx); b.st[0] = nloc; b.st[1] = nx; }
    const unsigned old = xb_add(&bar[XB_XSUB(b.x)], 1u);
    const unsigned gen = old / nloc;
    if (old + 1u == (gen + 1u) * nloc) {
      __builtin_amdgcn_fence(__ATOMIC_RELEASE, "agent");
      asm volatile("s_waitcnt vmcnt(0)" ::: "memory");
      const unsigned og = xb_add(&bar[XB_TOP], 1u);
      const unsigned tg = og / nx;
      if (og + 1u == (tg + 1u) * nx) xb_add(&bar[XB_TOPGEN], 1u);
      else XB_SPIN(xb_ld(&bar[XB_TOPGEN]) == tg, bar);
      __builtin_amdgcn_fence(__ATOMIC_ACQUIRE, "agent");
      xb_add(&bar[XB_XGEN(b.x)], 1u);
      asm volatile("s_waitcnt vmcnt(0)" ::: "memory");
    } else {
      XB_SPIN(xb_ld(&bar[XB_XGEN(b.x)]) == gen, bar);
      __builtin_amdgcn_fence(__ATOMIC_ACQUIRE, "agent");
      asm volatile("s_waitcnt vmcnt(0)" ::: "memory");
    }
  }
  __syncthreads();
}

constexpr int N_PHASES = 16;
#define GRID_SYNC() xcd_barrier(xb, wave_s == 0 && __builtin_amdgcn_mbcnt_hi(~0u, __builtin_amdgcn_mbcnt_lo(~0u, 0u)) == 0u)

#define LOADP() unsigned zop = 0u; asm volatile("" : "+v"(zop)); \
    const int tidx = wave_s * 64 + (int)__builtin_amdgcn_mbcnt_hi(~0u, __builtin_amdgcn_mbcnt_lo(~0u, zop)); \
    const int gw = vbid * (NTHR / 64) + wave_s; \
    PAK pa = pak0; asm volatile("" : "+s"(pa)); P p; \
    p.x_prompt = pa->in[0]; p.x_sample = pa->in[1]; p.cache_a_k = pa->in[2]; p.cache_a_v = pa->in[3]; p.cache_d_k = pa->in[4]; p.cache_d_v = pa->in[5]; \
    p.c = pa->in[6]; p.c_ctx = pa->in[7]; p.mod_w = pa->in[8]; p.mod_b = pa->in[9]; p.norm_w = pa->in[10]; p.ffn_w1 = pa->in[11]; p.ffn_w2 = pa->in[12]; \
    p.ev_w_in = pa->in[13]; p.ev_rpb = pa->in[14]; p.ev_conv_w = pa->in[15]; p.ev_conv_b = pa->in[16]; p.ev_w_out = pa->in[17]; \
    p.od_w_in = pa->in[18]; p.od_pool_w = pa->in[19]; p.od_pool_scale = pa->in[20]; p.od_q_norm = pa->in[21]; p.od_k_norm = pa->in[22]; p.od_w_out = pa->in[23]; \
    p.out = pa->out; \
    { char* ws = pa->ws; \
      p.W1T = (u16*)(ws + WO_W1T); p.W2T = (u16*)(ws + WO_W2T); p.EVIN = (u16*)(ws + WO_EVIN); p.EVOUT = (u16*)(ws + WO_EVOUT); \
      p.ODIN = (u16*)(ws + WO_ODIN); p.ODOUT = (u16*)(ws + WO_ODOUT); p.POOLW = (u16*)(ws + WO_POOLW); \
      p.CAK = (u16*)(ws + WO_CAK); p.CAVT = (u16*)(ws + WO_CAVT); p.CDK = (u16*)(ws + WO_CDK); p.CDVT = (u16*)(ws + WO_CDVT); \
      p.H = (u16*)(ws + WO_H); p.ACTU = (u16*)(ws + WO_ACTU); p.VT = (u16*)(ws + WO_VT); \
      p.MOD = (float*)(ws + WO_MOD); p.X = (float*)(ws + WO_X); p.T = (float*)(ws + WO_T); p.BAR = (unsigned*)(ws + WO_BAR); p.KF = (u16*)(ws + WO_KF); p.XCH = (float*)(ws + WO_XCH); }
typedef const __attribute__((address_space(4))) PA* PAK;
__global__ void __launch_bounds__(NTHR, 2) mega(PA pa_unused, int ph0, int ph1) {
  __shared__ __attribute__((aligned(1024))) char smem[LDS_BYTES];
  __shared__ uint4 xb_words;
  const int wave_s = __builtin_amdgcn_readfirstlane((int)(threadIdx.x >> 6));
  cg::grid_group grid = cg::this_grid();
  if (ph1 == 0x7fffffff) grid.sync();
  if (threadIdx.x == 0) xb_words = make_uint4(0u, 0u, 0u, 0u);
  __syncthreads();
  const PAK pak0 = (PAK)__builtin_amdgcn_kernarg_segment_ptr();
  const XcdBarrier xb = xcd_barrier_post((unsigned*)(pak0->ws + WO_BAR), (volatile LAS unsigned*)&xb_words);
  const int G = gridDim.x, bid = blockIdx.x;
  const int vbid = (G & 7) ? bid : ((bid & 7) * (G >> 3) + (bid >> 3));
  const int W = G * (NTHR / 64);
#ifndef REPMASK
#define REPMASK 0u
#endif
  for (int ph = ph0; ph < ph1; ++ph) {
   const int nrep = ((REPMASK >> ph) & 1u) ? 2 : 1;
   for (int rep = 0; rep < nrep; ++rep) {
    if (rep) { GRID_SYNC(); }
    if (ph == 0) {
      LOADP();
      prep_phase(p, smem, bid, G, tidx);
    } else if (ph == 1) {
      LOADP();
      r_phase<0>(p, true, false, nullptr, nullptr, 0, 0.f, true, p.norm_w, p.MOD, 0, 1, p.X, gw, W, tidx);
    } else {
      const int q = ph - 2;
      const int l = q / 7, s = q % 7;
#define NWMOD() const float* nw = p.norm_w + l * 6 * DM; const float* modl = p.MOD + l * 3 * 9216
      switch (s) {
        case 0: case 5: { LOADP();
          const int f = s == 0 ? 0 : 1;
          const u16* w1 = p.W1T + (size_t)(l * 2 + f) * 5632 * 1024;
          gemm_phase<EPI_SWIGLU, 6>(p, p.H, w1, 1024, 64, 22, p.ACTU, DFF, smem, vbid, G, tidx, 1280);
          gemm_phase<EPI_SWIGLU, 3, true>(p, p.H, w1, 1024, 64, 22, p.ACTU, DFF, smem, vbid, G, tidx, 256, 1280);
        } break;
        case 1: case 4: case 6: { LOADP(); NWMOD();
          const u16* A_ = s == 4 ? p.H : p.ACTU;
          const u16* B_ = s == 4 ? (l == 0 ? p.EVOUT : p.ODOUT) : p.W2T + (size_t)(l * 2 + (s == 1 ? 0 : 1)) * 1024 * 2816;
          ResArgs ra;
          ra.gT = nw + (s == 1 ? 1 : (s == 4 ? 3 : 5)) * DM;
          ra.modg = modl; ra.gate = s == 1 ? 2 : (s == 4 ? 5 : 8); ra.gs = s == 4 ? 1.0f : 0.5f;
          ra.fin = (s == 6 && l == 1) ? 1 : 0;
          ra.g2 = s == 1 ? nw + 2 * DM : (s == 4 ? nw + 4 * DM : p.norm_w + 6 * DM);
          ra.modn = s == 6 ? p.MOD + 3 * 9216 : modl;
          ra.shi = s == 1 ? 3 : (s == 4 ? 6 : 0);
          ra.kuse = 3 * l + (s == 1 ? 0 : (s == 4 ? 1 : 2));
          gemm_phase<EPI_RES, 6>(p, A_, B_, s == 4 ? 1024 : DFF, 64, 4, nullptr, DM, smem, vbid, G, tidx, 1 << 30, 0, ra);
        } break;
        case 2: { LOADP();
          if (l == 0) gemm_phase<EPI_EVIN, 6>(p, p.H, p.EVIN, 1024, 64, 12, p.ACTU, 3072, smem, vbid, G, tidx);
          else {
            gemm_phase<EPI_ODIN, 6>(p, p.H, p.ODIN, 1024, 64, 5, p.ACTU, 1280, smem, vbid, G, tidx, 256);
            gemm_phase<EPI_ODIN, 3, true>(p, p.H, p.ODIN, 1024, 64, 5, p.ACTU, 1280, smem, vbid, G, tidx, 128, 256);
            GRID_SYNC();
            mix_odd_a(p, gw, W, tidx);
          }
        } break;
        case 3: { LOADP();
          if (l == 0) mix_even(p, gw, W, tidx);
          else {
            gemm_phase<EPI_POOL, 3>(p, (const u16*)p.T, p.POOLW, 512, 128, 2, p.H, DM, smem, vbid, G, tidx);
            mix_odd_b(p, gw, W, tidx, smem);
          }
        } break;
      }
    }
   }
    if (ph + 1 < ph1) { GRID_SYNC(); }
#ifdef EXTRA_SYNCS
    if (ph == 1) { for (int es = 0; es < EXTRA_SYNCS; ++es) { GRID_SYNC(); } }
#endif
  }
}

extern "C" void kernel_launch(void* const* d_in, const int* in_sizes, int n_in, void* d_out, int out_size,
                              void* d_ws, size_t ws_size, hipStream_t stream) {
  static int grid_blocks = 0;
  if (!grid_blocks) {
    int dev = 0, cus = 0, per_cu = 0;
    hipGetDevice(&dev);
    hipDeviceGetAttribute(&cus, hipDeviceAttributeMultiprocessorCount, dev);
    hipOccupancyMaxActiveBlocksPerMultiprocessor(&per_cu, mega, NTHR, 0);
    if (per_cu > 1) per_cu = 1;
    if (per_cu < 1) per_cu = 1;
    grid_blocks = cus * per_cu;
  }
  PA p{};
  for (int i = 0; i < 24; ++i) p.in[i] = (const float*)d_in[i];
  p.out = (float*)d_out;
  p.ws = (char*)d_ws;
  if (WO_END > ws_size) { fprintf(stderr, "workspace too small: need %zu have %zu\n", (size_t)WO_END, ws_size); return; }
  (void)hipMemsetAsync(p.ws + WO_BAR, 0, (size_t)(XCD_BAR_WORDS + 2048) * 4, stream);
  int ph0 = 0, ph1 = N_PHASES;
  void* args[] = { &p, &ph0, &ph1 };
  hipError_t e = hipLaunchCooperativeKernel((void*)mega, dim3(grid_blocks), dim3(NTHR), args, 0, stream);
  if (e != hipSuccess) fprintf(stderr, "cooperative launch failed: %s (grid %d)\n", hipGetErrorString(e), grid_blocks);
}
```

```cpp
#include <hip/hip_runtime.h>
#include <hip/hip_cooperative_groups.h>
#include <cstdio>
namespace cg = cooperative_groups;

typedef unsigned short u16;
using bf16x8 = __attribute__((ext_vector_type(8))) short;
using s16x4  = __attribute__((ext_vector_type(4))) short;
using f32x16 = __attribute__((ext_vector_type(16))) float;
#define DI __device__ __forceinline__
#define MFMA(a, b, c) __builtin_amdgcn_mfma_f32_32x32x16_bf16((a), (b), (c), 0, 0, 0)

constexpr int MTOK = 12288;
constexpr int MPR  = 8192;
constexpr int DM   = 1024;
constexpr int DFF  = 2816;
constexpr int NTHR = 512;
constexpr int LDS_BYTES = 131072;
constexpr int SROW = 72;

constexpr size_t OFF_SAK = 12582912, OFF_SAV = 16777216, OFF_SDK = 20971520, OFF_SDV = 22020096;

struct P {
  const float *x_prompt, *x_sample, *cache_a_k, *cache_a_v, *cache_d_k, *cache_d_v, *c, *c_ctx;
  const float *mod_w, *mod_b, *norm_w, *ffn_w1, *ffn_w2, *ev_w_in, *ev_rpb, *ev_conv_w, *ev_conv_b, *ev_w_out;
  const float *od_w_in, *od_pool_w, *od_pool_scale, *od_q_norm, *od_k_norm, *od_w_out;
  float* out;
  u16 *W1T, *W2T, *EVIN, *EVOUT, *ODIN, *ODOUT, *POOLW, *CAK, *CAVT, *CDK, *CDVT, *H, *ACTU, *VT, *KF;
  float *MOD, *X, *T;
  unsigned* BAR;
  float* XCH;
};
struct PA {
  const float* in[24];
  float* out;
  char* ws;
};
constexpr size_t al256(size_t b) { return (b + 255) & ~(size_t)255; }
constexpr size_t WO_W1T = 0;
constexpr size_t WO_W2T = WO_W1T + al256((size_t)4 * 5632 * 1024 * 2);
constexpr size_t WO_EVIN = WO_W2T + al256((size_t)4 * 1024 * 2816 * 2);
constexpr size_t WO_EVOUT = WO_EVIN + al256((size_t)3072 * 1024 * 2);
constexpr size_t WO_ODIN = WO_EVOUT + al256((size_t)1024 * 1024 * 2);
constexpr size_t WO_ODOUT = WO_ODIN + al256((size_t)1280 * 1024 * 2);
constexpr size_t WO_POOLW = WO_ODOUT + al256((size_t)1024 * 1024 * 2);
constexpr size_t WO_CAK = WO_POOLW + al256((size_t)512 * 512 * 2);
constexpr size_t WO_CAVT = WO_CAK + al256((size_t)262144 * 2);
constexpr size_t WO_CDK = WO_CAVT + al256((size_t)262144 * 2);
constexpr size_t WO_CDVT = WO_CDK + al256((size_t)65536 * 2);
constexpr size_t WO_H = WO_CDVT + al256((size_t)65536 * 2);
constexpr size_t WO_ACTU = WO_H + al256((size_t)12288 * 1024 * 2);
constexpr size_t WO_VT = WO_ACTU + al256((size_t)12288 * 3072 * 2);
constexpr size_t WO_MOD = WO_VT + al256((size_t)512 * 12288 * 2);
constexpr size_t WO_X = WO_MOD + al256((size_t)2 * 3 * 9216 * 4);
constexpr size_t WO_T = WO_X + al256((size_t)12288 * 1024 * 4);
constexpr size_t WO_BAR = WO_T + al256((size_t)12288 * 1024 * 4);
constexpr size_t WO_KF = WO_BAR + al256((size_t)(3456 + 2048) * 4);
constexpr size_t WO_XCH = WO_KF + al256((size_t)512 * 12288 * 2);
constexpr size_t WO_END = WO_XCH + al256((size_t)2 * 12288 * 4 * 4);

DI u16 f2bf(float x) { unsigned u = __float_as_uint(x); u += 0x7fffu + ((u >> 16) & 1u); return (u16)(u >> 16); }
DI float bf2f(u16 v) { return __uint_as_float(((unsigned)v) << 16); }
DI unsigned pack2(float a, float b) { unsigned r; asm("v_cvt_pk_bf16_f32 %0, %1, %2" : "=v"(r) : "v"(a), "v"(b)); return r; }
DI float row16_sum(float v) {
  v += __builtin_bit_cast(float, __builtin_amdgcn_update_dpp(0, __builtin_bit_cast(int, v), 0xB1, 0xF, 0xF, true));
  v += __builtin_bit_cast(float, __builtin_amdgcn_update_dpp(0, __builtin_bit_cast(int, v), 0x4E, 0xF, 0xF, true));
  v += __builtin_bit_cast(float, __builtin_amdgcn_update_dpp(0, __builtin_bit_cast(int, v), 0x141, 0xF, 0xF, true));
  v += __builtin_bit_cast(float, __builtin_amdgcn_update_dpp(0, __builtin_bit_cast(int, v), 0x140, 0xF, 0xF, true));
  return v;
}
DI float xor32_max(float v) { float a = v, b = v; asm volatile("s_nop 1\n\tv_permlane32_swap_b32 %0, %1" : "+v"(a), "+v"(b)); return fmaxf(a, b); }
DI float xor32_sum(float v) { float a = v, b = v; asm volatile("s_nop 1\n\tv_permlane32_swap_b32 %0, %1" : "+v"(a), "+v"(b)); return a + b; }
DI float xor16_sum(float v) { float a = v, b = v; asm volatile("s_nop 1\n\tv_permlane16_swap_b32 %0, %1" : "+v"(a), "+v"(b)); return a + b; }
DI float wave_sum(float v) {
#pragma unroll
  for (int o = 32; o > 0; o >>= 1) v += __shfl_xor(v, o);
  return v;
}
DI float wave_sum_dpp(float v) {
  return xor32_sum(xor16_sum(row16_sum(v)));
}
DI float bflo(unsigned u) { return __uint_as_float(u << 16); }
DI float bfhi(unsigned u) { return __uint_as_float(u & 0xffff0000u); }

__device__ void mod_item(const P& p, int it, char* smem, int tidx) {
  float* sS = (float*)smem;
  float* red = sS + 3072;
  const int tid = tidx;
  const int l = it / 144, n0 = (it % 144) * 64;
  for (int i = tid; i < 3072; i += 256) {
    int r = i >> 10, k = i & 1023;
    float v = r == 0 ? p.c_ctx[k] : p.c[(r - 1) * 1024 + k];
    sS[i] = v / (1.f + expf(-v));
  }
  __syncthreads();
  const int kq = tid >> 4, cq = tid & 15;
  const float* w = p.mod_w + (size_t)l * 1024 * 9216 + (size_t)(kq * 64) * 9216 + n0 + cq * 4;
  float a00 = 0, a01 = 0, a02 = 0, a03 = 0, a10 = 0, a11 = 0, a12 = 0, a13 = 0, a20 = 0, a21 = 0, a22 = 0, a23 = 0;
#pragma unroll 1
  for (int k0 = 0; k0 < 64; k0 += 8) {
    float4 wv[8];
#pragma unroll
    for (int k = 0; k < 8; ++k) wv[k] = *(const float4*)(w + (size_t)(k0 + k) * 9216);
#pragma unroll
    for (int k = 0; k < 8; ++k) {
      float4 w4 = wv[k];
      float s0 = sS[kq * 64 + k0 + k], s1 = sS[1024 + kq * 64 + k0 + k], s2 = sS[2048 + kq * 64 + k0 + k];
      a00 += s0 * w4.x; a01 += s0 * w4.y; a02 += s0 * w4.z; a03 += s0 * w4.w;
      a10 += s1 * w4.x; a11 += s1 * w4.y; a12 += s1 * w4.z; a13 += s1 * w4.w;
      a20 += s2 * w4.x; a21 += s2 * w4.y; a22 += s2 * w4.z; a23 += s2 * w4.w;
    }
  }
  float* r0 = red + (kq * 3 + 0) * 64 + cq * 4;
  r0[0] = a00; r0[1] = a01; r0[2] = a02; r0[3] = a03;
  r0[64] = a10; r0[65] = a11; r0[66] = a12; r0[67] = a13;
  r0[128] = a20; r0[129] = a21; r0[130] = a22; r0[131] = a23;
  __syncthreads();
  if (tid < 192) {
    int r = tid >> 6, n = tid & 63;
    float s = p.mod_b[l * 9216 + n0 + n];
#pragma unroll
    for (int q = 0; q < 16; ++q) s += red[(q * 3 + r) * 64 + n];
    p.MOD[(l * 3 + r) * 9216 + n0 + n] = s;
  }
  __syncthreads();
}

struct TrItem { const float* src; u16* dst; int N, Kd, k0, n0, perm; };
DI TrItem tr_decode(const P& p, int idx) {
  TrItem t; t.perm = 0; int kt, nt;
  if (idx < 2816) { int mat = idx / 704, r = idx % 704; kt = r / 44; nt = r % 44; t.src = p.ffn_w1 + (size_t)mat * 1024 * 5632; t.N = 5632; t.Kd = 1024; t.dst = p.W1T + (size_t)mat * 5632 * 1024; t.perm = 1; }
  else if (idx < 4224) { int r0 = idx - 2816; int mat = r0 / 352, r = r0 % 352; kt = r / 8; nt = r % 8; t.src = p.ffn_w2 + (size_t)mat * 2816 * 1024; t.N = 1024; t.Kd = 2816; t.dst = p.W2T + (size_t)mat * 1024 * 2816; }
  else if (idx < 4608) { int r = idx - 4224; kt = r / 24; nt = r % 24; t.src = p.ev_w_in; t.N = 3072; t.Kd = 1024; t.dst = p.EVIN; }
  else if (idx < 4736) { int r = idx - 4608; kt = r / 8; nt = r % 8; t.src = p.ev_w_out; t.N = 1024; t.Kd = 1024; t.dst = p.EVOUT; }
  else if (idx < 4896) { int r = idx - 4736; kt = r / 10; nt = r % 10; t.src = p.od_w_in; t.N = 1280; t.Kd = 1024; t.dst = p.ODIN; }
  else if (idx < 5024) { int r = idx - 4896; kt = r / 8; nt = r % 8; t.src = p.od_w_out; t.N = 1024; t.Kd = 1024; t.dst = p.ODOUT; }
  else { int r = idx - 5024; int mat = r >> 1; kt = r & 1; nt = 0; t.src = p.od_pool_w + mat * 16384; t.N = 128; t.Kd = 512; t.dst = p.POOLW + (size_t)(mat * 128) * 512 + mat * 128; }
  t.k0 = kt * 64; t.n0 = nt * 128;
  return t;
}

__device__ void prep_phase(const P& p, char* smem_all, int bid, int G, int tid512) {
  constexpr int N_MOD = 288, N_TR = 5032, N_CC = 448;
  const int half = tid512 >> 8, tid = tid512 & 255;
  char* smem = smem_all + half * 36864;
  for (int pi = bid; pi < N_MOD / 2; pi += G) mod_item(p, 2 * pi + half, smem, tid);
  {
    float* tl = (float*)smem;
    const int r = tid >> 5, c4 = (tid & 31) * 4;
    float4 v[8];
    int tp = bid;
    TrItem cur{};
    if (tp < N_TR / 2) {
      cur = tr_decode(p, 2 * tp + half);
      const float* sp = cur.src + (size_t)(cur.k0 + r) * cur.N + cur.n0 + c4;
#pragma unroll
      for (int q = 0; q < 8; ++q) v[q] = *(const float4*)(sp + (size_t)(8 * q) * cur.N);
    }
    for (; tp < N_TR / 2; tp += G) {
      float* tpp = tl + r * 129 + c4;
#pragma unroll
      for (int q = 0; q < 8; ++q) { tpp[q * 8 * 129] = v[q].x; tpp[q * 8 * 129 + 1] = v[q].y; tpp[q * 8 * 129 + 2] = v[q].z; tpp[q * 8 * 129 + 3] = v[q].w; }
      __syncthreads();
      const TrItem me = cur;
      if (tp + G < N_TR / 2) {
        cur = tr_decode(p, 2 * (tp + G) + half);
        const float* sp = cur.src + (size_t)(cur.k0 + r) * cur.N + cur.n0 + c4;
#pragma unroll
        for (int q = 0; q < 8; ++q) v[q] = *(const float4*)(sp + (size_t)(8 * q) * cur.N);
      }
#pragma unroll
      for (int q = 0; q < 4; ++q) {
        int nn = (tid >> 3) + 32 * q, kc = tid & 7;
        int n = me.n0 + nn, nd = n;
        if (me.perm) nd = n < DFF ? ((n >> 5) * 64 + (n & 31)) : ((((n - DFF) >> 5) * 64) + 32 + ((n - DFF) & 31));
        const float* t = tl + (kc * 8) * 129 + nn;
        uint4 o;
        o.x = pack2(t[0], t[129]); o.y = pack2(t[258], t[387]); o.z = pack2(t[516], t[645]); o.w = pack2(t[774], t[903]);
        *(uint4*)(me.dst + (size_t)nd * me.Kd + me.k0 + kc * 8) = o;
      }
      __syncthreads();
    }
  }
  for (int pi = bid; pi < N_CC / 2; pi += G) {
    const int idx = 2 * pi + half;
    {
      int e0 = idx * 2048 + tid * 8;
#pragma unroll 1
      for (int j = 0; j < 8; ++j) {
        int e = e0 + j;
        if (e < 589824 && (e < 262144 || e >= 524288)) {
          const bool isA = e < 262144; const int q = isA ? e : e - 524288;
          const int x = q & 7, ln = (q >> 3) & 63, sub = (q >> 9) & 3, T = (q >> 11) & 7, bh = q >> 14;
          const int key = T * 32 + (ln & 31), d = sub * 16 + (ln >> 5) * 8 + x;
          const float v = (isA ? p.cache_a_k : p.cache_d_k)[(bh * 256 + key) * 64 + d];
          (isA ? p.CAK : p.CDK)[q] = f2bf(v);
        } else if (e < 655360) {
          const bool isA = e < 524288; const int q = isA ? e - 262144 : e - 589824;
          const int x = q & 7, ln = (q >> 3) & 63, sub = (q >> 9) & 3, T = (q >> 11) & 7, bh = q >> 14;
          const int dim = (sub >> 1) * 32 + (ln & 31), key = T * 32 + 16 * (sub & 1) + 8 * (x >> 2) + 4 * (ln >> 5) + (x & 3);
          const float v = (isA ? p.cache_a_v : p.cache_d_v)[(bh * 256 + key) * 64 + dim];
          (isA ? p.CAVT : p.CDVT)[q] = f2bf(v);
        }
        else { int q = e - 655360; int n = q >> 9, k = q & 511; if ((n >> 7) != (k >> 7)) p.POOLW[q] = 0; }
      }
    }
  }
}

template <int RMODE>
__device__ void r_phase(const P& p, bool first_unused, bool hasT_unused, const float* gT, const float* modg, int gate_idx, float gscale,
                        bool writeH, const float* g2, const float* modn, int shift_idx, int scale_idx, float* xdst, int gw, int W, int tidx) {
  const int lane = tidx & 63;
  constexpr bool first = RMODE == 0, hasT = RMODE != 0;
  constexpr int NR = 6;
  for (int t0 = gw; t0 < MTOK; t0 += NR * W) {
    float4 xf[NR][4];
    uint2 xq[NR][4], tq[NR][4];
#pragma unroll
    for (int r = 0; r < NR; ++r) {
      const int t = t0 + r * W;
      if (t < MTOK) {
        if (first) {
          const float* xs = t < MPR ? p.x_prompt + (size_t)t * DM : p.x_sample + (size_t)(t - MPR) * DM;
#pragma unroll
          for (int j = 0; j < 4; ++j) xf[r][j] = *(const float4*)(xs + lane * 4 + 256 * j);
        } else {
          const u16* xs = (const u16*)p.X + (size_t)t * DM;
          const u16* ts = (const u16*)p.T + (size_t)t * DM;
#pragma unroll
          for (int j = 0; j < 4; ++j) { xq[r][j] = *(const uint2*)(xs + lane * 4 + 256 * j); tq[r][j] = *(const uint2*)(ts + lane * 4 + 256 * j); }
        }
      }
    }
#pragma unroll
    for (int r = 0; r < NR; ++r) {
      const int t = t0 + r * W;
      if (t < MTOK) {
        const int ci = t < MPR ? 0 : 1 + ((t - MPR) >> 11);
        float4 x[4];
        if (first) {
#pragma unroll
          for (int j = 0; j < 4; ++j) x[j] = xf[r][j];
        } else {
#pragma unroll
          for (int j = 0; j < 4; ++j) x[j] = make_float4(bflo(xq[r][j].x), bfhi(xq[r][j].x), bflo(xq[r][j].y), bfhi(xq[r][j].y));
        }
        if (hasT) {
          float4 tv[4];
          float ss = 0.f;
#pragma unroll
          for (int j = 0; j < 4; ++j) {
            tv[j] = make_float4(bflo(tq[r][j].x), bfhi(tq[r][j].x), bflo(tq[r][j].y), bfhi(tq[r][j].y));
            ss += tv[j].x * tv[j].x + tv[j].y * tv[j].y + tv[j].z * tv[j].z + tv[j].w * tv[j].w;
          }
          ss = wave_sum(ss);
          const float rs = rsqrtf(ss * (1.f / 1024.f) + 1e-6f) * gscale;
          const float* mg = modg + ci * 9216 + gate_idx * 1024;
#pragma unroll
          for (int j = 0; j < 4; ++j) {
            int c = lane * 4 + 256 * j;
            float4 g4 = *(const float4*)(gT + c), m4 = *(const float4*)(mg + c);
            x[j].x += m4.x * (tv[j].x * rs * g4.x); x[j].y += m4.y * (tv[j].y * rs * g4.y);
            x[j].z += m4.z * (tv[j].z * rs * g4.z); x[j].w += m4.w * (tv[j].w * rs * g4.w);
          }
        }
        if (RMODE == 2) {
#pragma unroll
          for (int j = 0; j < 4; ++j) *(float4*)(xdst + (size_t)t * DM + lane * 4 + 256 * j) = x[j];
        } else {
#pragma unroll
          for (int j = 0; j < 4; ++j) {
            uint2 o; o.x = pack2(x[j].x, x[j].y); o.y = pack2(x[j].z, x[j].w);
            *(uint2*)((u16*)xdst + (size_t)t * DM + lane * 4 + 256 * j) = o;
          }
          float ss = 0.f;
#pragma unroll
          for (int j = 0; j < 4; ++j) ss += x[j].x * x[j].x + x[j].y * x[j].y + x[j].z * x[j].z + x[j].w * x[j].w;
          ss = wave_sum(ss);
          const float r2 = rsqrtf(ss * (1.f / 1024.f) + 1e-6f);
          const float* sh = modn + ci * 9216 + shift_idx * 1024;
          const float* sc = modn + ci * 9216 + scale_idx * 1024;
#pragma unroll
          for (int j = 0; j < 4; ++j) {
            int c = lane * 4 + 256 * j;
            float4 g4 = *(const float4*)(g2 + c), s4 = *(const float4*)(sc + c), h4 = *(const float4*)(sh + c);
            float h0 = x[j].x * r2 * g4.x * (1.f + s4.x) + h4.x;
            float h1 = x[j].y * r2 * g4.y * (1.f + s4.y) + h4.y;
            float h2 = x[j].z * r2 * g4.z * (1.f + s4.z) + h4.z;
            float h3 = x[j].w * r2 * g4.w * (1.f + s4.w) + h4.w;
            uint2 o; o.x = pack2(h0, h1); o.y = pack2(h2, h3);
            *(uint2*)(p.H + (size_t)t * DM + c) = o;
          }
        }
      }
    }
  }
}

enum { EPI_SWIGLU = 0, EPI_F32 = 1, EPI_EVIN = 2, EPI_ODIN = 3, EPI_POOL = 4, EPI_RES = 5 };
struct ResArgs { const float* gT; const float* modg; const float* g2; const float* modn; int gate; int shi; float gs; int kuse; int fin; };
using f32x4 = __attribute__((ext_vector_type(4))) float;

DI int lds_byte2(int r, int c) {
  int st = (r >> 4) * 2 + (c >> 5), ob = (r & 15) * 64 + (c & 31) * 2;
  return st * 1024 + (ob ^ (((ob >> 9) & 1) << 5));
}
DI void stage_rc2(int b, int& R, int& C) {
  int st = b >> 10, sb = b & 1023, swz = sb ^ (((sb >> 9) & 1) << 5);
  R = (st >> 1) * 16 + (swz >> 6);
  C = (st & 1) * 32 + ((swz & 63) >> 1);
}
#define WAIT_V0() asm volatile("s_waitcnt vmcnt(0)" ::: "memory")

#define LDS_RD4(a, b, c, d, addr, o0, o1, o2, o3) asm volatile( \
    "ds_read_b128 %0, %4 offset:%5\n\tds_read_b128 %1, %4 offset:%6\n\tds_read_b128 %2, %4 offset:%7\n\tds_read_b128 %3, %4 offset:%8\n\ts_waitcnt lgkmcnt(0)" \
    : "=&v"(a), "=&v"(b), "=&v"(c), "=&v"(d) : "v"(addr), "n"(o0), "n"(o1), "n"(o2), "n"(o3) : "memory")
template <int EPI, int MF, bool TAIL = false>
__device__ __forceinline__ void gemm_phase(const P& p, const u16* __restrict__ A, const u16* __restrict__ Bt, int K,
                                           int nMT, int nNT, void* outp, int ldc, char* smem, int vbid, int G, int tidx, int tlimit = 1 << 30, int tbase = 0, ResArgs ra = ResArgs{}) {
  constexpr int TILE_B = 32768, STAGE_B = 65536;
  const int wid = __builtin_amdgcn_readfirstlane(tidx >> 6), lane = tidx & 63, wr = wid >> 2, wc = wid & 3, fr = lane & 15, fq = lane >> 4;
  int sOff0;
  { int R, C; stage_rc2(wid * 1024 + lane * 16, R, C); sOff0 = R * K + C; }
  const unsigned sOffB = (unsigned)sOff0 * 2u;
  const int aOff0 = lds_byte2(wr * (16 * MF) + fr, fq * 8);
  const int bOff0 = lds_byte2(wc * 64 + fr, fq * 8);
  const int ntiles = TAIL ? tlimit : min(nMT * nNT, tlimit), nt = K >> 6;
#define GLDS_STAGE(AB, BB, buf, kt) do { _Pragma("unroll") for (int i = 0; i < 4; ++i) { \
      if (wid + 8 * i < 4 * MF) __builtin_amdgcn_global_load_lds((const unsigned*)((const char*)((AB) + (size_t)(i * 64) * K + (kt) * 64) + sOffCur), (unsigned*)(smem + (buf) * STAGE_B + wid * 1024 + i * 8192), 16, 0, 0); \
      __builtin_amdgcn_global_load_lds((const unsigned*)((const char*)((BB) + (size_t)(i * 64) * K + (kt) * 64) + sOffCur), (unsigned*)(smem + (buf) * STAGE_B + TILE_B + wid * 1024 + i * 8192), 16, 0, 0); } } while (0)
#define TILE_COORDS(T, BR, BC) do { const int ts_ = TAIL ? tbase + ((T) >> 1) : (T); \
      const int grp_ = ts_ / (8 * nNT), r2_ = ts_ - grp_ * 8 * nNT; \
      BR = (grp_ * 8 + (r2_ & 7)) * (TAIL ? 192 : 32 * MF) + (TAIL ? ((T) & 1) * 96 : 0); BC = (r2_ >> 3) * 256; } while (0)
  if (vbid < ntiles) {
    unsigned sOffCur = sOffB; asm volatile("" : "+v"(sOffCur));
    int br_, bc_; TILE_COORDS(vbid, br_, bc_);
    GLDS_STAGE(A + (size_t)br_ * K, Bt + (size_t)bc_ * K, 0, 0);
  }
  for (int tile = vbid; tile < ntiles; tile += G) {
    int brow, bcol; TILE_COORDS(tile, brow, bcol);
    unsigned sOffCur = sOffB; asm volatile("" : "+v"(sOffCur));
    const u16* Ab = A + (size_t)brow * K;
    const u16* Bb = Bt + (size_t)bcol * K;
    f32x4 acc[MF][4];
#pragma unroll
    for (int m = 0; m < MF; ++m)
#pragma unroll
      for (int n = 0; n < 4; ++n) { acc[m][n][0] = 0.f; acc[m][n][1] = 0.f; acc[m][n][2] = 0.f; acc[m][n][3] = 0.f; }
#define LDS_RD(dst, base, off) asm volatile("ds_read_b128 %0, %1 offset:%2" : "=v"(dst) : "v"(base), "n"(off))
    bf16x8 A0[MF], B0[4], A1[MF], B1[4];
    const unsigned lbase = (unsigned)(size_t)(smem);
    WAIT_V0(); __syncthreads();
    if (nt > 1) GLDS_STAGE(Ab, Bb, 1, 1);
    asm volatile("s_waitcnt lgkmcnt(0)" ::: "memory");
    {
      const unsigned la = lbase + aOff0, lb = lbase + TILE_B + bOff0;
#pragma unroll
      for (int n = 0; n < 4; ++n) LDS_RD(B0[n], lb, n * 2048);
#pragma unroll
      for (int m = 0; m < MF; ++m) LDS_RD(A0[m], la, m * 2048);
    }
    for (int t = 0; t < nt; ++t) {
      const int cur = t & 1;
      const unsigned la = lbase + cur * STAGE_B + aOff0, lb = lbase + cur * STAGE_B + TILE_B + bOff0;
      const unsigned lan = lbase + (cur ^ 1) * STAGE_B + aOff0, lbn = lbase + (cur ^ 1) * STAGE_B + TILE_B + bOff0;
#pragma unroll
      for (int n = 0; n < 4; ++n) LDS_RD(B1[n], lb, n * 2048 + 1024);
#pragma unroll
      for (int m = 0; m < MF; ++m) LDS_RD(A1[m], la, m * 2048 + 1024);
      __builtin_amdgcn_sched_barrier(0);
#pragma unroll
      for (int m = 0; m < MF; ++m) {
        if (m == 0) asm volatile("s_waitcnt lgkmcnt(%5)" : "+v"(A0[0]), "+v"(B0[0]), "+v"(B0[1]), "+v"(B0[2]), "+v"(B0[3]) : "n"(4 + MF + MF - 1));
        else asm volatile("s_waitcnt lgkmcnt(%1)" : "+v"(A0[m]) : "n"(4 + MF + MF - 1 - m));
#pragma unroll
        for (int n = 0; n < 4; ++n) acc[m][n] = __builtin_amdgcn_mfma_f32_16x16x32_bf16(A0[m], B0[n], acc[m][n], 0, 0, 0);
        __builtin_amdgcn_sched_barrier(0);
      }
      if (MF == 3) asm volatile("s_waitcnt lgkmcnt(0)" : "+v"(A1[0]), "+v"(A1[1]), "+v"(A1[MF - 1]), "+v"(B1[0]), "+v"(B1[1]), "+v"(B1[2]), "+v"(B1[3]));
      else if (MF == 6) asm volatile("s_waitcnt lgkmcnt(0)" : "+v"(A1[0]), "+v"(A1[1]), "+v"(A1[2]), "+v"(A1[3]), "+v"(A1[4]), "+v"(A1[MF - 1]), "+v"(B1[0]), "+v"(B1[1]), "+v"(B1[2]), "+v"(B1[3]));
      else asm volatile("s_waitcnt lgkmcnt(0)" : "+v"(A1[0]), "+v"(A1[1]), "+v"(A1[2]), "+v"(A1[3]), "+v"(A1[4]), "+v"(A1[5]), "+v"(A1[MF - 2]), "+v"(A1[MF - 1]), "+v"(B1[0]), "+v"(B1[1]), "+v"(B1[2]), "+v"(B1[3]));
      WAIT_V0(); __syncthreads();
      if (t + 2 < nt) { GLDS_STAGE(Ab, Bb, cur, t + 2); }
      else if (t + 1 == nt && tile + G < ntiles) {
        int br_, bc_; TILE_COORDS(tile + G, br_, bc_);
        GLDS_STAGE(A + (size_t)br_ * K, Bt + (size_t)bc_ * K, 0, 0);
      }
      if (t + 1 < nt) {
#pragma unroll
        for (int n = 0; n < 4; ++n) LDS_RD(B0[n], lbn, n * 2048);
#pragma unroll
        for (int m = 0; m < MF; ++m) LDS_RD(A0[m], lan, m * 2048);
      }
      __builtin_amdgcn_sched_barrier(0);
#pragma unroll
      for (int m = 0; m < MF; ++m) {
#pragma unroll
        for (int n = 0; n < 4; ++n) acc[m][n] = __builtin_amdgcn_mfma_f32_16x16x32_bf16(A1[m], B1[n], acc[m][n], 0, 0, 0);
      }
      __builtin_amdgcn_sched_barrier(0);
    }
#undef LDS_RD
    unsigned zl_ = 0u; asm volatile("" : "+v"(zl_));
    const int le = (int)__builtin_amdgcn_mbcnt_hi(~0u, __builtin_amdgcn_mbcnt_lo(~0u, zl_));
    const int fre = le & 15, fqe = le >> 4;
    float* Ew = (float*)(smem + STAGE_B + wid * 4352);
    const int r0 = brow + wr * (16 * MF), c0 = bcol + wc * 64;
    if (EPI == EPI_RES) {
      const int te = wid * 64 + le;
      float* rp = (float*)(smem + STAGE_B + 8 * 4352);
      float* rstat = rp + 192 * 4;
      const int mt = brow / 192, ntl = bcol >> 8;
      unsigned* flag = p.BAR + 3456 + mt * 32;
      const unsigned target = 4u * (unsigned)(ra.kuse + 1);
      float* xch0 = p.XCH + (size_t)brow * 4;
      float* xch1 = p.XCH + (size_t)(12288 + brow) * 4;
#define XCH_ST(ptr, v) __hip_atomic_store((ptr), (v), __ATOMIC_RELAXED, __HIP_MEMORY_SCOPE_AGENT)
#define XCH_LD(ptr) __hip_atomic_load((ptr), __ATOMIC_RELAXED, __HIP_MEMORY_SCOPE_AGENT)
#define ROW_EXCHANGE(FL) do { \
        asm volatile("s_waitcnt vmcnt(0)" ::: "memory"); \
        __syncthreads(); \
        if (te == 0) { \
          (void)__hip_atomic_fetch_add((FL), 1u, __ATOMIC_RELAXED, __HIP_MEMORY_SCOPE_AGENT); \
          unsigned sp_ = 0; \
          while (__hip_atomic_load((FL), __ATOMIC_RELAXED, __HIP_MEMORY_SCOPE_AGENT) < target) { __builtin_amdgcn_s_sleep(1); if (++sp_ > (1u << 22)) break; } \
        } \
        __syncthreads(); } while (0)
      const int c4 = (le & 15) * 4;
      u16* X16 = (u16*)p.X;
      uint2 xpre[MF][4];
      float4 mgpre[MF];
#pragma unroll
      for (int m = 0; m < MF; ++m) {
        const int rm = r0 + m * 16;
        const int ci = rm < MPR ? 0 : 1 + ((rm - MPR) >> 11);
        mgpre[m] = *(const float4*)(ra.modg + ci * 9216 + ra.gate * 1024 + c0 + c4);
#pragma unroll
        for (int ps = 0; ps < 4; ++ps)
          xpre[m][ps] = *(const uint2*)(X16 + (size_t)(brow + wr * 96 + m * 16 + (le >> 4) + 4 * ps) * DM + c0 + c4);
      }
#pragma unroll
      for (int m = 0; m < MF; ++m)
#pragma unroll
        for (int j = 0; j < 4; ++j) {
          float s = acc[m][0][j] * acc[m][0][j] + acc[m][1][j] * acc[m][1][j] + acc[m][2][j] * acc[m][2][j] + acc[m][3][j] * acc[m][3][j];
          s = row16_sum(s);
          if (fre == 0) rp[(wr * 96 + m * 16 + fqe * 4 + j) * 4 + wc] = s;
        }
      __syncthreads();
      if (te < 192) XCH_ST(xch0 + te * 4 + ntl, rp[te * 4] + rp[te * 4 + 1] + rp[te * 4 + 2] + rp[te * 4 + 3]);
      ROW_EXCHANGE(flag);
      if (te < 192) { const float qs = XCH_LD(xch0 + te * 4) + XCH_LD(xch0 + te * 4 + 1) + XCH_LD(xch0 + te * 4 + 2) + XCH_LD(xch0 + te * 4 + 3); rstat[te] = rsqrtf(qs * (1.f / 1024.f) + 1e-6f) * ra.gs; }
      __syncthreads();
      const float4 gT4 = *(const float4*)(ra.gT + c0 + c4);
      float4 xn[MF][4];
#pragma unroll
      for (int m = 0; m < MF; ++m) {
        const int rm = r0 + m * 16;
        const int ci = rm < MPR ? 0 : 1 + ((rm - MPR) >> 11);
        const float4 mg4 = mgpre[m];
#pragma unroll
        for (int n = 0; n < 4; ++n)
#pragma unroll
          for (int j = 0; j < 4; ++j) Ew[(fqe * 4 + j) * 68 + n * 16 + fre] = acc[m][n][j];
        f32x4 q0, q1, q2, q3;
        LDS_RD4(q0, q1, q2, q3, (unsigned)(size_t)(Ew + (le >> 4) * 68 + c4), 0, 1088, 2176, 3264);
#pragma unroll
        for (int ps = 0; ps < 4; ++ps) {
          const f32x4 qv = ps == 0 ? q0 : (ps == 1 ? q1 : (ps == 2 ? q2 : q3));
          const int rl = wr * 96 + m * 16 + (le >> 4) + 4 * ps;
          const size_t ro = (size_t)(brow + rl) * DM + c0 + c4;
          const float rs = rstat[rl];
          const uint2 xq = xpre[m][ps];
          float4 y;
          y.x = bflo(xq.x) + mg4.x * (qv[0] * rs * gT4.x); y.y = bfhi(xq.x) + mg4.y * (qv[1] * rs * gT4.y);
          y.z = bflo(xq.y) + mg4.z * (qv[2] * rs * gT4.z); y.w = bfhi(xq.y) + mg4.w * (qv[3] * rs * gT4.w);
          xn[m][ps] = y;
          if (ra.fin) { *(float4*)(p.out + ro) = y; }
          else {
            uint2 o; o.x = pack2(y.x, y.y); o.y = pack2(y.z, y.w);
            *(uint2*)(X16 + ro) = o;
            float s = y.x * y.x + y.y * y.y + y.z * y.z + y.w * y.w;
            s = row16_sum(s);
            if ((le & 15) == 0) rp[rl * 4 + wc] = s;
          }
        }
      }
      float4 shpre[MF], scpre[MF];
      float4 g24 = make_float4(0.f, 0.f, 0.f, 0.f);
      if (!ra.fin) {
        g24 = *(const float4*)(ra.g2 + c0 + c4);
#pragma unroll
        for (int m = 0; m < MF; ++m) {
          const int rm = r0 + m * 16;
          const int ci = rm < MPR ? 0 : 1 + ((rm - MPR) >> 11);
          shpre[m] = *(const float4*)(ra.modn + ci * 9216 + ra.shi * 1024 + c0 + c4);
          scpre[m] = *(const float4*)(ra.modn + ci * 9216 + (ra.shi + 1) * 1024 + c0 + c4);
        }
      }
      if (!ra.fin) {
        __syncthreads();
        if (te < 192) XCH_ST(xch1 + te * 4 + ntl, rp[te * 4] + rp[te * 4 + 1] + rp[te * 4 + 2] + rp[te * 4 + 3]);
        ROW_EXCHANGE(flag + 16);
        if (te < 192) { const float qs = XCH_LD(xch1 + te * 4) + XCH_LD(xch1 + te * 4 + 1) + XCH_LD(xch1 + te * 4 + 2) + XCH_LD(xch1 + te * 4 + 3); rstat[te] = rsqrtf(qs * (1.f / 1024.f) + 1e-6f); }
        __syncthreads();
#pragma unroll
        for (int m = 0; m < MF; ++m) {
          const float4 sh4 = shpre[m], sc4 = scpre[m];
#pragma unroll
          for (int ps = 0; ps < 4; ++ps) {
            const int rl = wr * 96 + m * 16 + (le >> 4) + 4 * ps;
            const float r2 = rstat[rl];
            const float4 y = xn[m][ps];
            uint2 o;
            o.x = pack2(y.x * r2 * g24.x * (1.f + sc4.x) + sh4.x, y.y * r2 * g24.y * (1.f + sc4.y) + sh4.y);
            o.y = pack2(y.z * r2 * g24.z * (1.f + sc4.z) + sh4.z, y.w * r2 * g24.w * (1.f + sc4.w) + sh4.w);
            *(uint2*)(p.H + (size_t)(brow + rl) * DM + c0 + c4) = o;
          }
        }
      }
#undef ROW_EXCHANGE
#undef XCH_ST
#undef XCH_LD
      continue;
    }
    constexpr int vlo = (EPI == EPI_EVIN) ? 1024 : 1152, vhi = (EPI == EPI_EVIN) ? 1536 : 1280;
    const bool isV = (EPI == EPI_EVIN || EPI == EPI_ODIN) && c0 >= vlo && c0 < vhi;
    float* sbase = nullptr; int hd = 0, nh = 8;
    if (EPI == EPI_EVIN) {
      if (c0 >= 512 && c0 < 1024) { sbase = p.out + OFF_SAK; hd = (c0 - 512) >> 6; }
      else if (c0 >= 1024 && c0 < 1536) { sbase = p.out + OFF_SAV; hd = (c0 - 1024) >> 6; }
    } else if (EPI == EPI_ODIN) {
      nh = 2;
      if (c0 >= 1152 && c0 < 1280) { sbase = p.out + OFF_SDV; hd = (c0 - 1152) >> 6; }
    }
    const int c4 = (le & 15) * 4;
    float4 psc = make_float4(1.f, 1.f, 1.f, 1.f);
    if (EPI == EPI_POOL) psc = *(const float4*)(p.od_pool_scale + c0 + c4);
    constexpr int ESZ = 2;
    char* orow = (EPI == EPI_SWIGLU)
        ? (char*)outp + ((size_t)(r0 + (le >> 3)) * ldc + (c0 >> 1) + (le & 7) * 4) * 2
        : (char*)outp + ((size_t)(r0 + (le >> 4)) * ldc + c0 + c4) * ESZ;
    const size_t rstride = (size_t)ldc * ESZ;
#pragma unroll
    for (int m = 0; m < MF; ++m) {
      asm volatile("" : "+v"(orow));
      const int rm = r0 + m * 16;
      float* srow = (sbase && rm < MPR) ? sbase + ((size_t)((rm >> 8) * nh + hd) * 256 + (rm & 255) + (le >> 4)) * 64 + c4 : nullptr;
      if (EPI == EPI_EVIN || EPI == EPI_ODIN) {
        if (isV) {
          const int t0 = rm + fqe * 4, kk16 = t0 & 15;
          u16* vb = p.VT + ((size_t)(((c0 - vlo) >> 6) * 384 + (t0 >> 5)) * 4 + ((t0 >> 4) & 1)) * 512 + (((kk16 >> 2) & 1) * 32) * 8 + (kk16 >> 3) * 4;
#pragma unroll
          for (int n = 0; n < 4; ++n) {
            const int dim = n * 16 + fre;
            uint2 o; o.x = pack2(acc[m][n][0], acc[m][n][1]); o.y = pack2(acc[m][n][2], acc[m][n][3]);
            *(uint2*)(vb + (dim >> 5) * 1024 + (dim & 31) * 8) = o;
          }
        }
      }
      if (EPI != EPI_SWIGLU) {
#pragma unroll
      for (int n = 0; n < 4; ++n)
#pragma unroll
        for (int j = 0; j < 4; ++j) Ew[(fqe * 4 + j) * 68 + n * 16 + fre] = acc[m][n][j];
      }
      if (EPI == EPI_EVIN) {
        if (c0 >= 512 && c0 < 1024) {
#pragma unroll
          for (int ps = 0; ps < 2; ++ps) {
            const int slot = le + 64 * ps, row = slot >> 3, ch = slot & 7;
            const float4 a = *(const float4*)(Ew + row * 68 + ch * 8), b4 = *(const float4*)(Ew + row * 68 + ch * 8 + 4);
            uint4 o; o.x = pack2(a.x, a.y); o.y = pack2(a.z, a.w); o.z = pack2(b4.x, b4.y); o.w = pack2(b4.z, b4.w);
            const int t = rm + row;
            *(uint4*)(p.KF + ((size_t)(((c0 - 512) >> 6) * 384 + (t >> 5)) * 4 + (ch >> 1)) * 512 + ((ch & 1) * 32 + (t & 31)) * 8) = o;
          }
        }
      }
      if (EPI == EPI_SWIGLU) {
        u16* ab = (u16*)outp + (size_t)(rm + fqe * 4) * ldc + (c0 >> 1) + fre;
#pragma unroll
        for (int j = 0; j < 4; ++j)
#pragma unroll
          for (int n = 0; n < 2; ++n) {
            const float g = acc[m][n][j], u = acc[m][n + 2][j];
            ab[(size_t)j * ldc + n * 16] = (u16)pack2(g * u * __builtin_amdgcn_rcpf(1.f + __expf(-g)), 0.f);
          }
      } else {
        f32x4 q0, q1, q2, q3;
        LDS_RD4(q0, q1, q2, q3, (unsigned)(size_t)(Ew + (le >> 4) * 68 + c4), 0, 1088, 2176, 3264);
#pragma unroll
        for (int ps = 0; ps < 4; ++ps) {
          const f32x4 qv = ps == 0 ? q0 : (ps == 1 ? q1 : (ps == 2 ? q2 : q3));
          float4 v = make_float4(qv[0], qv[1], qv[2], qv[3]);
          if (EPI == EPI_F32) {
            uint2 o; o.x = pack2(v.x, v.y); o.y = pack2(v.z, v.w);
            *(uint2*)(orow + (size_t)(4 * ps) * rstride) = o;
          } else if (EPI == EPI_POOL) {
            uint2 o; o.x = pack2(v.x * psc.x, v.y * psc.y); o.y = pack2(v.z * psc.z, v.w * psc.w);
            *(uint2*)(orow + (size_t)(4 * ps) * rstride) = o;
          } else {
            uint2 o; o.x = pack2(v.x, v.y); o.y = pack2(v.z, v.w);
            *(uint2*)(orow + (size_t)(4 * ps) * rstride) = o;
            if (srow) *(float4*)(srow + (4 * ps) * 64) = v;
          }
        }
      }
      orow += 16 * rstride;
    }
  }
#undef GLDS_STAGE
#undef TILE_COORDS
  __syncthreads();
}

struct Seg { const u16* KF; const u16* VF; int n; };

template <bool BIAS>
__device__ __forceinline__ void attn_core(const u16* __restrict__ Q, int ldq, Seg s0, Seg s1, f32x16& o0, f32x16& o1, float& m, float& l,
                                          const float* __restrict__ rpb_h, int qr, int qc0, int rs, int tidx) {
  const int lane = tidx & 63, l31 = lane & 31, lh = lane >> 5;
  bf16x8 bq[4];
#pragma unroll
  for (int kk = 0; kk < 4; ++kk) bq[kk] = *(const bf16x8*)(Q + (size_t)l31 * ldq + kk * 16 + lh * 8);
  m = -1e30f; l = 0.f;
#pragma unroll
  for (int e = 0; e < 16; ++e) { o0[e] = 0.f; o1[e] = 0.f; }
  const int qc = qc0 + l31;
  const int cs = min(max(qc - 8, 0), 48);
  const int nt0 = s0.n >> 5, ntot = nt0 + (s1.n >> 5);
  const u16* k0p = s0.KF + lane * 8;
  const u16* k1p = s1.KF + lane * 8;
  const u16* v0p = s0.VF + lane * 8;
  const u16* v1p = s1.VF + lane * 8;
  bf16x8 kA[4], kB[4], vA[4], vB[4];
#define KLOAD(dst, i_) do { const int j_ = min((i_), ntot - 1); const bool n1_ = j_ >= nt0; \
    const u16* Kp_ = n1_ ? k1p + (size_t)(j_ - nt0) * 2048 : k0p + (size_t)j_ * 2048; \
    _Pragma("unroll") for (int kk = 0; kk < 4; ++kk) dst[kk] = *(const bf16x8*)(Kp_ + kk * 512); } while (0)
#define VLOAD(dst, i_) do { const int j_ = min((i_), ntot - 1); const bool n1_ = j_ >= nt0; \
    const u16* vp_ = n1_ ? v1p + (size_t)(j_ - nt0) * 2048 : v0p + (size_t)j_ * 2048; \
    _Pragma("unroll") for (int q = 0; q < 4; ++q) dst[q] = *(const bf16x8*)(vp_ + q * 512); } while (0)
#define ATT_STEP(kf, vf, i_, kd_, vd_) do { \
    const bool in1 = (i_) >= nt0; const int kt = in1 ? (i_) - nt0 : (i_); \
    f32x16 sc; _Pragma("unroll") for (int e = 0; e < 16; ++e) sc[e] = 0.f; \
    _Pragma("unroll") for (int kk = 0; kk < 4; ++kk) sc = MFMA(kf[kk], bq[kk], sc); \
    KLOAD(kf, (i_) + (kd_)); \
    float mx = -1e30f; \
    _Pragma("unroll") for (int e = 0; e < 16; ++e) { \
      float v = sc[e] * 0.125f; \
      if (BIAS) { if (in1) { \
          const float* brow_ = rpb_h + (rs + (kt >> 1) - qr + 7) * 31;     \
          int kc = (kt & 1) * 32 + 8 * (e >> 2) + 4 * lh + (e & 3); \
          bool valid = (kc >= cs) && (kc < cs + 16); \
          unsigned co = (unsigned)min(max(kc - qc + 15, 0), 30); \
          float bv = brow_[co]; \
          v = valid ? v + bv : -1e30f; } } \
      sc[e] = v; mx = fmaxf(mx, v); \
      if (BIAS && (e & 3) == 3) __builtin_amdgcn_sched_barrier(0); } \
    mx = xor32_max(mx); \
    const float mnew = fmaxf(m, mx); \
    const float corr = __expf(m - mnew); \
    float rsum = 0.f; \
    _Pragma("unroll") for (int e = 0; e < 16; ++e) { float pv = __expf(sc[e] - mnew); sc[e] = pv; rsum += pv; } \
    rsum = xor32_sum(rsum); \
    l = l * corr + rsum; m = mnew; \
    _Pragma("unroll") for (int e = 0; e < 16; ++e) { o0[e] *= corr; o1[e] *= corr; } \
    uint4 t0, t1; \
    t0.x = pack2(sc[0], sc[1]); t0.y = pack2(sc[2], sc[3]); t0.z = pack2(sc[4], sc[5]); t0.w = pack2(sc[6], sc[7]); \
    t1.x = pack2(sc[8], sc[9]); t1.y = pack2(sc[10], sc[11]); t1.z = pack2(sc[12], sc[13]); t1.w = pack2(sc[14], sc[15]); \
    const bf16x8 pb0 = __builtin_bit_cast(bf16x8, t0), pb1 = __builtin_bit_cast(bf16x8, t1); \
    o0 = MFMA(vf[0], pb0, o0); o0 = MFMA(vf[1], pb1, o0); \
    o1 = MFMA(vf[2], pb0, o1); o1 = MFMA(vf[3], pb1, o1); \
    VLOAD(vf, (i_) + (vd_)); } while (0)
  KLOAD(kA, 0); VLOAD(vA, 0);
  if (!BIAS) { KLOAD(kB, 1); VLOAD(vB, 1); }
#pragma unroll 1
  for (int i = 0; i < ntot; i += 2) {
    if (BIAS) {
      ATT_STEP(kA, vA, i, 1, 1);
      ATT_STEP(kA, vA, i + 1, 1, 1);
    } else {
      ATT_STEP(kA, vA, i, 2, 2);
      ATT_STEP(kB, vB, i + 1, 2, 2);
    }
  }
#undef KLOAD
#undef VLOAD
#undef ATT_STEP
}

__device__ __forceinline__ void attn_store(const f32x16& o0, const f32x16& o1, float inv, u16* __restrict__ O, int ldo, int tidx) {
  const int lane = tidx & 63, l31 = lane & 31, lh = lane >> 5;
  u16* op = O + (size_t)l31 * ldo + 4 * lh;
#pragma unroll
  for (int q4 = 0; q4 < 4; ++q4) {
    uint2 a, b;
    a.x = pack2(o0[4 * q4] * inv, o0[4 * q4 + 1] * inv); a.y = pack2(o0[4 * q4 + 2] * inv, o0[4 * q4 + 3] * inv);
    b.x = pack2(o1[4 * q4] * inv, o1[4 * q4 + 1] * inv); b.y = pack2(o1[4 * q4 + 2] * inv, o1[4 * q4 + 3] * inv);
    *(uint2*)(op + 8 * q4) = a;
    *(uint2*)(op + 32 + 8 * q4) = b;
  }
}

template <bool BIAS>
__device__ __forceinline__ void attn_unit(const u16* __restrict__ Q, int ldq, Seg s0, Seg s1, u16* __restrict__ O, int ldo,
                                          const float* __restrict__ rpb_h, int qr, int qc0, int rs, int tidx) {
  f32x16 o0, o1; float m, l;
  attn_core<BIAS>(Q, ldq, s0, s1, o0, o1, m, l, rpb_h, qr, qc0, rs, tidx);
  attn_store(o0, o1, 1.f / l, O, ldo, tidx);
}

__device__ void mix_even(const P& p, int gw, int W, int tidx) {
  const int lane = tidx & 63;
  const u16* U = p.ACTU;
  u16* MO = p.H;
  for (int u0 = gw; u0 < 2048 + MTOK; u0 += W) {
   for (int sub = 0; sub < 2; ++sub) {
    int u;
    if (u0 < 1024) { if (sub) break; u = u0; }
    else if (u0 < 2048) { u = 1024 + 2 * (u0 - 1024) + sub; }
    else if (W != 2048) { if (sub) break; u = u0 + 1024; }
    else {
      if (gw < 1024) break;
      u = 3072 + (gw - 1024) + (2 * ((u0 - 2048) / W) + sub) * 1024;
    }
    if (u < 1024) {
      int b = u >> 9, h = (u >> 6) & 7, r = (u >> 1) & 31, hf = u & 1;
      int tb = MPR + b * 2048;
      int rs = min(max(r - 4, 0), 24);
      Seg s0 = { p.CAK + (size_t)((b * 8 + h) * 8) * 2048, p.CAVT + (size_t)((b * 8 + h) * 8) * 2048, 256 };
      const size_t lt = (size_t)(h * 384 + ((tb + rs * 64) >> 5)) * 2048;
      Seg s1 = { p.KF + lt, p.VT + lt, 512 };
      int q0 = tb + r * 64 + hf * 32;
      attn_unit<true>(U + (size_t)q0 * 3072 + h * 64, 3072, s0, s1, MO + (size_t)q0 * DM + h * 64, DM, p.ev_rpb + h * 465, r, hf * 32, rs, tidx);
    } else if (u < 3072) {
      int v = u - 1024; int b = v >> 6, h = (v >> 3) & 7, qb = v & 7;
      const size_t lt = (size_t)(h * 384 + b * 8) * 2048;
      Seg s0 = { p.KF + lt, p.VT + lt, 256 };
      Seg s1 = { s0.KF, s0.VF, 0 };
      int q0 = b * 256 + qb * 32;
      attn_unit<false>(U + (size_t)q0 * 3072 + h * 64, 3072, s0, s1, MO + (size_t)q0 * DM + h * 64, DM, nullptr, 0, 0, 0, tidx);
    } else {
      int t = u - 3072;
      int s, L;
      if (t < MPR) { s = t & 255; L = 256; } else { s = (t - MPR) & 2047; L = 2048; }
      const int c = lane * 8;
      float z[3][8];
#pragma unroll
      for (int d = 0; d < 3; ++d) {
        int sd = s + d - 1;
        if (sd >= 0 && sd < L) {
          const u16* row = U + (size_t)(t + d - 1) * 3072;
          uint4 cg4 = *(const uint4*)(row + 2048 + c), xb4 = *(const uint4*)(row + 2560 + c);
          z[d][0] = bflo(cg4.x) * bflo(xb4.x); z[d][1] = bfhi(cg4.x) * bfhi(xb4.x);
          z[d][2] = bflo(cg4.y) * bflo(xb4.y); z[d][3] = bfhi(cg4.y) * bfhi(xb4.y);
          z[d][4] = bflo(cg4.z) * bflo(xb4.z); z[d][5] = bfhi(cg4.z) * bfhi(xb4.z);
          z[d][6] = bflo(cg4.w) * bflo(xb4.w); z[d][7] = bfhi(cg4.w) * bfhi(xb4.w);
        } else {
#pragma unroll
          for (int j = 0; j < 8; ++j) z[d][j] = 0.f;
        }
      }
      uint4 bg4 = *(const uint4*)(U + (size_t)t * 3072 + 1536 + c);
      float bg[8] = { bflo(bg4.x), bfhi(bg4.x), bflo(bg4.y), bfhi(bg4.y), bflo(bg4.z), bfhi(bg4.z), bflo(bg4.w), bfhi(bg4.w) };
      float y[8];
#pragma unroll
      for (int j = 0; j < 8; ++j) {
        float w0 = p.ev_conv_w[c + j], w1 = p.ev_conv_w[512 + c + j], w2 = p.ev_conv_w[1024 + c + j];
        y[j] = bg[j] * (z[0][j] * w0 + z[1][j] * w1 + z[2][j] * w2 + p.ev_conv_b[c + j]);
      }
      uint4 o; o.x = pack2(y[0], y[1]); o.y = pack2(y[2], y[3]); o.z = pack2(y[4], y[5]); o.w = pack2(y[6], y[7]);
      *(uint4*)(MO + (size_t)t * DM + 512 + c) = o;
    }
   }
  }
}

__device__ void mix_odd_a(const P& p, int gw, int W, int tidx) {
  const int lane = tidx & 63;
  u16* U = p.ACTU;
  u16* POOLED = (u16*)p.T;
  const float invf = exp2f(-(float)((lane >> 1) & 15) * (13.287712379549449f / 16.f));
  for (int t = gw; t < MTOK; t += W) {
    const bool smp = t >= MPR;
    int s, L, base;
    if (!smp) { s = t & 255; L = 256; base = t - s; } else { s = (t - MPR) & 2047; L = 2048; base = t - s; }
    float cs_ = 1.f, sn_ = 0.f;
    if (smp) {
      float pos = (lane < 32) ? (float)(s >> 6) : (float)(s & 63);
      float ang = pos * invf;
      cs_ = cosf(ang); sn_ = sinf(ang);
    }
    u16* row = U + (size_t)t * 1280;
#pragma unroll 1
    for (int hd = 0; hd < 10; ++hd) {
      float v = bf2f(row[512 + hd * 64 + lane]);
      float ss = wave_sum_dpp(v * v);
      float w = hd < 8 ? p.od_q_norm[lane] : p.od_k_norm[lane];
      float nv = v * rsqrtf(ss * (1.f / 64.f) + 1e-6f) * w;
      float outv = nv;
      if (smp) {
        float pr = __builtin_bit_cast(float, __builtin_amdgcn_update_dpp(0, __builtin_bit_cast(int, nv), 0xB1, 0xF, 0xF, true));
        outv = (lane & 1) ? (pr * sn_ + nv * cs_) : (nv * cs_ - pr * sn_);
      } else if (hd >= 8) {
        int b = t >> 8;
        p.out[OFF_SDK + ((size_t)(b * 2 + (hd - 8)) * 256 + s) * 64 + lane] = nv;
      }
      if (hd < 8) row[512 + hd * 64 + lane] = f2bf(outv);
      else p.KF[((size_t)((hd - 8) * 384 + (t >> 5)) * 4 + (lane >> 4)) * 512 + (((lane >> 3) & 1) * 32 + (t & 31)) * 8 + (lane & 7)] = f2bf(outv);
    }
    {
      const int half = 1 << (lane >> 4);
      const int lo = max(s - half, 0), hi = min(s + half, L);
      const int c = lane * 8;
      float a[8];
#pragma unroll
      for (int j = 0; j < 8; ++j) a[j] = 0.f;
      for (int j = lo; j < hi; ++j) {
        uint4 v = *(const uint4*)(U + (size_t)(base + j) * 1280 + c);
        a[0] += bflo(v.x); a[1] += bfhi(v.x); a[2] += bflo(v.y); a[3] += bfhi(v.y);
        a[4] += bflo(v.z); a[5] += bfhi(v.z); a[6] += bflo(v.w); a[7] += bfhi(v.w);
      }
      const float rn = 1.f / (float)(hi - lo);
      uint4 sv = *(const uint4*)(U + (size_t)t * 1280 + c);
      uint4 o;
      o.x = pack2(a[0] * rn - bflo(sv.x), a[1] * rn - bfhi(sv.x));
      o.y = pack2(a[2] * rn - bflo(sv.y), a[3] * rn - bfhi(sv.y));
      o.z = pack2(a[4] * rn - bflo(sv.z), a[5] * rn - bfhi(sv.z));
      o.w = pack2(a[6] * rn - bflo(sv.w), a[7] * rn - bfhi(sv.w));
      *(uint4*)(POOLED + (size_t)t * 512 + c) = o;
    }
  }
}

__device__ void mix_odd_b(const P& p, int gw, int W, int tidx, char* smem) {
  const u16* U = p.ACTU;
  u16* MO = p.H;
  const int lane = tidx & 63, wave = tidx >> 6;
  for (int hu = gw; hu < 2048; hu += W) {
    const int v = hu >> 1, half = hu & 1;
    const int b = v >> 9, hq = (v >> 6) & 7, qb = v & 63, kvh = hq >> 2;
    const int tb = MPR + b * 2048;
    const size_t lt = (size_t)(kvh * 384 + (tb >> 5)) * 2048;
    Seg s0, s1;
    if (half == 0) {
      s0 = Seg{ p.CDK + (size_t)((b * 2 + kvh) * 8) * 2048, p.CDVT + (size_t)((b * 2 + kvh) * 8) * 2048, 256 };
      s1 = Seg{ p.KF + lt, p.VT + lt, 896 };
    } else {
      s0 = Seg{ p.KF + lt + (size_t)28 * 2048, p.VT + lt + (size_t)28 * 2048, 1152 };
      s1 = Seg{ p.KF + lt, p.VT + lt, 0 };
    }
    const int q0 = tb + qb * 32;
    f32x16 o0, o1; float m, l;
    attn_core<false>(U + (size_t)q0 * 1280 + 512 + hq * 64, 1280, s0, s1, o0, o1, m, l, nullptr, 0, 0, 0, tidx);
    float* cb = (float*)smem + (wave >> 1) * (34 * 64) + lane;
    if (half == 1) {
      cb[0] = m; cb[64] = l;
#pragma unroll
      for (int e = 0; e < 16; ++e) { cb[(2 + e) * 64] = o0[e]; cb[(18 + e) * 64] = o1[e]; }
    }
    __syncthreads();
    if (half == 0) {
      const float m2 = cb[0], l2 = cb[64];
      const float M = fmaxf(m, m2);
      const float a1 = __expf(m - M), a2 = __expf(m2 - M);
      const float inv = 1.f / (l * a1 + l2 * a2);
#pragma unroll
      for (int e = 0; e < 16; ++e) { o0[e] = o0[e] * a1 + cb[(2 + e) * 64] * a2; o1[e] = o1[e] * a1 + cb[(18 + e) * 64] * a2; }
      attn_store(o0, o1, inv, MO + (size_t)q0 * DM + 512 + hq * 64, DM, tidx);
    }
    __syncthreads();
  }
  for (int v = gw; v < 2048; v += W) {
    int b = v >> 6, hq = (v >> 3) & 7, qb = v & 7, kvh = hq >> 2;
    const size_t lt = (size_t)(kvh * 384 + b * 8) * 2048;
    Seg s0 = { p.KF + lt, p.VT + lt, 256 };
    Seg s1 = { s0.KF, s0.VF, 0 };
    int q0 = b * 256 + qb * 32;
    attn_unit<false>(U + (size_t)q0 * 1280 + 512 + hq * 64, 1280, s0, s1, MO + (size_t)q0 * DM + 512 + hq * 64, DM, nullptr, 0, 0, 0, tidx);
  }
}

#define XB_TMO      128
#define XB_XCNT(j)  (256  + 64 * (j))
#define XB_XSUB(j)  (1280 + 64 * (j))
#define XB_XGEN(j)  (2304 + 64 * (j))
#define XB_TOP      3328
#define XB_TOPGEN   3392
#define XCD_BAR_WORDS 3456
#define XB_SPIN_CAP (1u << 20)
#define LAS __attribute__((address_space(3)))
DI unsigned xb_ld(unsigned* p)              { return __hip_atomic_load(p, __ATOMIC_RELAXED, __HIP_MEMORY_SCOPE_AGENT); }
DI unsigned xb_add(unsigned* p, unsigned v) { return __hip_atomic_fetch_add(p, v, __ATOMIC_RELAXED, __HIP_MEMORY_SCOPE_AGENT); }
DI unsigned xb_xcc_id() { return (unsigned)__builtin_amdgcn_s_getreg((3 << 11) | 20) & 0xFu; }
#define XB_SPIN(cond, bar) do { unsigned _sp = 0; while (cond) { __builtin_amdgcn_s_sleep(1); \
    if ((++_sp & 255u) == 0u) { if (xb_ld(&(bar)[XB_TMO])) break; if (_sp > XB_SPIN_CAP) { atomicAdd(&(bar)[XB_TMO], 1u); break; } } } } while (0)
struct XcdBarrier { unsigned* bar; unsigned x; volatile LAS unsigned* st; };
DI XcdBarrier xcd_barrier_post(unsigned* bar, volatile LAS unsigned* st) {
  XcdBarrier b; b.bar = bar; b.x = xb_xcc_id(); b.st = st;
  if (threadIdx.x == 0) (void)xb_add(&bar[XB_XCNT(b.x)], 1u);
  return b;
}
DI void xcd_barrier_complete(unsigned* bar, unsigned x, unsigned& nloc, unsigned& nx) {
  const unsigned G = gridDim.x * gridDim.y * gridDim.z;
  unsigned sum, cnt, mine, sp = 0u;
  for (;;) {
    sum = 0u; cnt = 0u; mine = 0u;
#pragma unroll
    for (unsigned j = 0; j < 16; ++j) { const unsigned c = xb_ld(&bar[XB_XCNT(j)]); sum += c; cnt += (c > 0u) ? 1u : 0u; mine = (j == x) ? c : mine; }
    if (sum == G) break;
    __builtin_amdgcn_s_sleep(1);
    if ((++sp & 255u) == 0u) { if (xb_ld(&bar[XB_TMO])) break; if (sp > XB_SPIN_CAP) { atomicAdd(&bar[XB_TMO], 1u); break; } }
  }
  nloc = mine > 0u ? mine : 1u; nx = cnt > 0u ? cnt : 1u;
}
DI void xcd_barrier(const XcdBarrier& b, bool leader) {
  asm volatile("s_waitcnt vmcnt(0)" ::: "memory");
  __syncthreads();
  if (leader) {
    unsigned* bar = b.bar;
    __builtin_amdgcn_s_waitcnt(0);
    unsigned nloc = b.st[0], nx = b.st[1];
    if (nloc == 0u) { xcd_barrier_complete(bar, b.x, nloc, nx); b.st[0] = nloc; b.st[1] = nx; }
    const unsigned old = xb_add(&bar[XB_XSUB(b.x)], 1u);
    const unsigned gen = old / nloc;
    if (old + 1u == (gen + 1u) * nloc) {
      __builtin_amdgcn_fence(__ATOMIC_RELEASE, "agent");
      asm volatile("s_waitcnt vmcnt(0)" ::: "memory");
      const unsigned og = xb_add(&bar[XB_TOP], 1u);
      const unsigned tg = og / nx;
      if (og + 1u == (tg + 1u) * nx) xb_add(&bar[XB_TOPGEN], 1u);
      else XB_SPIN(xb_ld(&bar[XB_TOPGEN]) == tg, bar);
      __builtin_amdgcn_fence(__ATOMIC_ACQUIRE, "agent");
      xb_add(&bar[XB_XGEN(b.x)], 1u);
      asm volatile("s_waitcnt vmcnt(0)" ::: "memory");
    } else {
      XB_SPIN(xb_ld(&bar[XB_XGEN(b.x)]) == gen, bar);
      __builtin_amdgcn_fence(__ATOMIC_ACQUIRE, "agent");
      asm volatile("s_waitcnt vmcnt(0)" ::: "memory");
    }
  }
  __syncthreads();
}

constexpr int N_PHASES = 16;
#define GRID_SYNC() xcd_barrier(xb, wave_s == 0 && __builtin_amdgcn_mbcnt_hi(~0u, __builtin_amdgcn_mbcnt_lo(~0u, 0u)) == 0u)

#define LOADP() unsigned zop = 0u; asm volatile("" : "+v"(zop)); \
    const int tidx = wave_s * 64 + (int)__builtin_amdgcn_mbcnt_hi(~0u, __builtin_amdgcn_mbcnt_lo(~0u, zop)); \
    const int gw = vbid * (NTHR / 64) + wave_s; \
    PAK pa = pak0; asm volatile("" : "+s"(pa)); P p; \
    p.x_prompt = pa->in[0]; p.x_sample = pa->in[1]; p.cache_a_k = pa->in[2]; p.cache_a_v = pa->in[3]; p.cache_d_k = pa->in[4]; p.cache_d_v = pa->in[5]; \
    p.c = pa->in[6]; p.c_ctx = pa->in[7]; p.mod_w = pa->in[8]; p.mod_b = pa->in[9]; p.norm_w = pa->in[10]; p.ffn_w1 = pa->in[11]; p.ffn_w2 = pa->in[12]; \
    p.ev_w_in = pa->in[13]; p.ev_rpb = pa->in[14]; p.ev_conv_w = pa->in[15]; p.ev_conv_b = pa->in[16]; p.ev_w_out = pa->in[17]; \
    p.od_w_in = pa->in[18]; p.od_pool_w = pa->in[19]; p.od_pool_scale = pa->in[20]; p.od_q_norm = pa->in[21]; p.od_k_norm = pa->in[22]; p.od_w_out = pa->in[23]; \
    p.out = pa->out; \
    { char* ws = pa->ws; \
      p.W1T = (u16*)(ws + WO_W1T); p.W2T = (u16*)(ws + WO_W2T); p.EVIN = (u16*)(ws + WO_EVIN); p.EVOUT = (u16*)(ws + WO_EVOUT); \
      p.ODIN = (u16*)(ws + WO_ODIN); p.ODOUT = (u16*)(ws + WO_ODOUT); p.POOLW = (u16*)(ws + WO_POOLW); \
      p.CAK = (u16*)(ws + WO_CAK); p.CAVT = (u16*)(ws + WO_CAVT); p.CDK = (u16*)(ws + WO_CDK); p.CDVT = (u16*)(ws + WO_CDVT); \
      p.H = (u16*)(ws + WO_H); p.ACTU = (u16*)(ws + WO_ACTU); p.VT = (u16*)(ws + WO_VT); \
      p.MOD = (float*)(ws + WO_MOD); p.X = (float*)(ws + WO_X); p.T = (float*)(ws + WO_T); p.BAR = (unsigned*)(ws + WO_BAR); p.KF = (u16*)(ws + WO_KF); p.XCH = (float*)(ws + WO_XCH); }
typedef const __attribute__((address_space(4))) PA* PAK;
__global__ void __launch_bounds__(NTHR, 2) mega(PA pa_unused, int ph0, int ph1) {
  __shared__ __attribute__((aligned(1024))) char smem[LDS_BYTES];
  __shared__ uint4 xb_words;
  const int wave_s = __builtin_amdgcn_readfirstlane((int)(threadIdx.x >> 6));
  cg::grid_group grid = cg::this_grid();
  if (ph1 == 0x7fffffff) grid.sync();
  if (threadIdx.x == 0) xb_words = make_uint4(0u, 0u, 0u, 0u);
  __syncthreads();
  const PAK pak0 = (PAK)__builtin_amdgcn_kernarg_segment_ptr();
  const XcdBarrier xb = xcd_barrier_post((unsigned*)(pak0->ws + WO_BAR), (volatile LAS unsigned*)&xb_words);
  const int G = gridDim.x, bid = blockIdx.x;
  const int vbid = (G & 7) ? bid : ((bid & 7) * (G >> 3) + (bid >> 3));
  const int W = G * (NTHR / 64);
#ifndef REPMASK
#define REPMASK 0u
#endif
  for (int ph = ph0; ph < ph1; ++ph) {
   const int nrep = ((REPMASK >> ph) & 1u) ? 2 : 1;
   for (int rep = 0; rep < nrep; ++rep) {
    if (rep) { GRID_SYNC(); }
    if (ph == 0) {
      LOADP();
      prep_phase(p, smem, bid, G, tidx);
    } else if (ph == 1) {
      LOADP();
      r_phase<0>(p, true, false, nullptr, nullptr, 0, 0.f, true, p.norm_w, p.MOD, 0, 1, p.X, gw, W, tidx);
    } else {
      const int q = ph - 2;
      const int l = q / 7, s = q % 7;
#define NWMOD() const float* nw = p.norm_w + l * 6 * DM; const float* modl = p.MOD + l * 3 * 9216
      switch (s) {
        case 0: case 5: { LOADP();
          const int f = s == 0 ? 0 : 1;
          const u16* w1 = p.W1T + (size_t)(l * 2 + f) * 5632 * 1024;
          gemm_phase<EPI_SWIGLU, 6>(p, p.H, w1, 1024, 64, 22, p.ACTU, DFF, smem, vbid, G, tidx, 1280);
          gemm_phase<EPI_SWIGLU, 3, true>(p, p.H, w1, 1024, 64, 22, p.ACTU, DFF, smem, vbid, G, tidx, 256, 1280);
        } break;
        case 1: case 4: case 6: { LOADP(); NWMOD();
          const u16* A_ = s == 4 ? p.H : p.ACTU;
          const u16* B_ = s == 4 ? (l == 0 ? p.EVOUT : p.ODOUT) : p.W2T + (size_t)(l * 2 + (s == 1 ? 0 : 1)) * 1024 * 2816;
          ResArgs ra;
          ra.gT = nw + (s == 1 ? 1 : (s == 4 ? 3 : 5)) * DM;
          ra.modg = modl; ra.gate = s == 1 ? 2 : (s == 4 ? 5 : 8); ra.gs = s == 4 ? 1.0f : 0.5f;
          ra.fin = (s == 6 && l == 1) ? 1 : 0;
          ra.g2 = s == 1 ? nw + 2 * DM : (s == 4 ? nw + 4 * DM : p.norm_w + 6 * DM);
          ra.modn = s == 6 ? p.MOD + 3 * 9216 : modl;
          ra.shi = s == 1 ? 3 : (s == 4 ? 6 : 0);
          ra.kuse = 3 * l + (s == 1 ? 0 : (s == 4 ? 1 : 2));
          gemm_phase<EPI_RES, 6>(p, A_, B_, s == 4 ? 1024 : DFF, 64, 4, nullptr, DM, smem, vbid, G, tidx, 1 << 30, 0, ra);
        } break;
        case 2: { LOADP();
          if (l == 0) gemm_phase<EPI_EVIN, 6>(p, p.H, p.EVIN, 1024, 64, 12, p.ACTU, 3072, smem, vbid, G, tidx);
          else {
            gemm_phase<EPI_ODIN, 6>(p, p.H, p.ODIN, 1024, 64, 5, p.ACTU, 1280, smem, vbid, G, tidx, 256);
            gemm_phase<EPI_ODIN, 3, true>(p, p.H, p.ODIN, 1024, 64, 5, p.ACTU, 1280, smem, vbid, G, tidx, 128, 256);
            GRID_SYNC();
            mix_odd_a(p, gw, W, tidx);
          }
        } break;
        case 3: { LOADP();
          if (l == 0) mix_even(p, gw, W, tidx);
          else {
            gemm_phase<EPI_POOL, 3>(p, (const u16*)p.T, p.POOLW, 512, 128, 2, p.H, DM, smem, vbid, G, tidx);
            mix_odd_b(p, gw, W, tidx, smem);
          }
        } break;
      }
    }
   }
    if (ph + 1 < ph1) { GRID_SYNC(); }
#ifdef EXTRA_SYNCS
    if (ph == 1) { for (int es = 0; es < EXTRA_SYNCS; ++es) { GRID_SYNC(); } }
#endif
  }
}

extern "C" void kernel_launch(void* const* d_in, const int* in_sizes, int n_in, void* d_out, int out_size,
                              void* d_ws, size_t ws_size, hipStream_t stream) {
  static int grid_blocks = 0;
  if (!grid_blocks) {
    int dev = 0, cus = 0, per_cu = 0;
    hipGetDevice(&dev);
    hipDeviceGetAttribute(&cus, hipDeviceAttributeMultiprocessorCount, dev);
    hipOccupancyMaxActiveBlocksPerMultiprocessor(&per_cu, mega, NTHR, 0);
    if (per_cu > 1) per_cu = 1;
    if (per_cu < 1) per_cu = 1;
    grid_blocks = cus * per_cu;
  }
  PA p{};
  for (int i = 0; i < 24; ++i) p.in[i] = (const float*)d_in[i];
  p.out = (float*)d_out;
  p.ws = (char*)d_ws;
  if (WO_END > ws_size) { fprintf(stderr, "workspace too small: need %zu have %zu\n", (size_t)WO_END, ws_size); return; }
  (void)hipMemsetAsync(p.ws + WO_BAR, 0, (size_t)(XCD_BAR_WORDS + 2048) * 4, stream);
  int ph0 = 0, ph1 = N_PHASES;
  void* args[] = { &p, &ph0, &ph1 };
  hipError_t e = hipLaunchCooperativeKernel((void*)mega, dim3(grid_blocks), dim3(NTHR), args, 0, stream);
  if (e != hipSuccess) fprintf(stderr, "cooperative launch failed: %s (grid %d)\n", hipGetErrorString(e), grid_blocks);
}
```

```cpp
#include <hip/hip_runtime.h>
#include <hip/hip_cooperative_groups.h>
#include <cstdio>
namespace cg = cooperative_groups;

typedef unsigned short u16;
using bf16x8 = __attribute__((ext_vector_type(8))) short;
using s16x4  = __attribute__((ext_vector_type(4))) short;
using f32x16 = __attribute__((ext_vector_type(16))) float;
#define DI __device__ __forceinline__
#define MFMA(a, b, c) __builtin_amdgcn_mfma_f32_32x32x16_bf16((a), (b), (c), 0, 0, 0)

constexpr int MTOK = 12288;
constexpr int MPR  = 8192;
constexpr int DM   = 1024;
constexpr int DFF  = 2816;
constexpr int NTHR = 512;
constexpr int LDS_BYTES = 131072;
constexpr int SROW = 72;

constexpr size_t OFF_SAK = 12582912, OFF_SAV = 16777216, OFF_SDK = 20971520, OFF_SDV = 22020096;

struct P {
  const float *x_prompt, *x_sample, *cache_a_k, *cache_a_v, *cache_d_k, *cache_d_v, *c, *c_ctx;
  const float *mod_w, *mod_b, *norm_w, *ffn_w1, *ffn_w2, *ev_w_in, *ev_rpb, *ev_conv_w, *ev_conv_b, *ev_w_out;
  const float *od_w_in, *od_pool_w, *od_pool_scale, *od_q_norm, *od_k_norm, *od_w_out;
  float* out;
  u16 *W1T, *W2T, *EVIN, *EVOUT, *ODIN, *ODOUT, *POOLW, *CAK, *CAVT, *CDK, *CDVT, *H, *ACTU, *VT, *KF;
  float *MOD, *X, *T;
  unsigned* BAR;
  float* XCH;
};
struct PA {
  const float* in[24];
  float* out;
  char* ws;
};
constexpr size_t al256(size_t b) { return (b + 255) & ~(size_t)255; }
constexpr size_t WO_W1T = 0;
constexpr size_t WO_W2T = WO_W1T + al256((size_t)4 * 5632 * 1024 * 2);
constexpr size_t WO_EVIN = WO_W2T + al256((size_t)4 * 1024 * 2816 * 2);
constexpr size_t WO_EVOUT = WO_EVIN + al256((size_t)3072 * 1024 * 2);
constexpr size_t WO_ODIN = WO_EVOUT + al256((size_t)1024 * 1024 * 2);
constexpr size_t WO_ODOUT = WO_ODIN + al256((size_t)1280 * 1024 * 2);
constexpr size_t WO_POOLW = WO_ODOUT + al256((size_t)1024 * 1024 * 2);
constexpr size_t WO_CAK = WO_POOLW + al256((size_t)512 * 512 * 2);
constexpr size_t WO_CAVT = WO_CAK + al256((size_t)262144 * 2);
constexpr size_t WO_CDK = WO_CAVT + al256((size_t)262144 * 2);
constexpr size_t WO_CDVT = WO_CDK + al256((size_t)65536 * 2);
constexpr size_t WO_H = WO_CDVT + al256((size_t)65536 * 2);
constexpr size_t WO_ACTU = WO_H + al256((size_t)12288 * 1024 * 2);
constexpr size_t WO_VT = WO_ACTU + al256((size_t)12288 * 3072 * 2);
constexpr size_t WO_MOD = WO_VT + al256((size_t)512 * 12288 * 2);
constexpr size_t WO_X = WO_MOD + al256((size_t)2 * 3 * 9216 * 4);
constexpr size_t WO_T = WO_X + al256((size_t)12288 * 1024 * 4);
constexpr size_t WO_BAR = WO_T + al256((size_t)12288 * 1024 * 4);
constexpr size_t WO_KF = WO_BAR + al256((size_t)(3456 + 2048) * 4);
constexpr size_t WO_XCH = WO_KF + al256((size_t)512 * 12288 * 2);
constexpr size_t WO_END = WO_XCH + al256((size_t)2 * 12288 * 4 * 4);

DI u16 f2bf(float x) { unsigned u = __float_as_uint(x); u += 0x7fffu + ((u >> 16) & 1u); return (u16)(u >> 16); }
DI float bf2f(u16 v) { return __uint_as_float(((unsigned)v) << 16); }
DI unsigned pack2(float a, float b) { unsigned r; asm("v_cvt_pk_bf16_f32 %0, %1, %2" : "=v"(r) : "v"(a), "v"(b)); return r; }
DI float row16_sum(float v) {
  v += __builtin_bit_cast(float, __builtin_amdgcn_update_dpp(0, __builtin_bit_cast(int, v), 0xB1, 0xF, 0xF, true));
  v += __builtin_bit_cast(float, __builtin_amdgcn_update_dpp(0, __builtin_bit_cast(int, v), 0x4E, 0xF, 0xF, true));
  v += __builtin_bit_cast(float, __builtin_amdgcn_update_dpp(0, __builtin_bit_cast(int, v), 0x141, 0xF, 0xF, true));
  v += __builtin_bit_cast(float, __builtin_amdgcn_update_dpp(0, __builtin_bit_cast(int, v), 0x140, 0xF, 0xF, true));
  return v;
}
DI float xor32_max(float v) { float a = v, b = v; asm volatile("s_nop 1\n\tv_permlane32_swap_b32 %0, %1" : "+v"(a), "+v"(b)); return fmaxf(a, b); }
DI float xor32_sum(float v) { float a = v, b = v; asm volatile("s_nop 1\n\tv_permlane32_swap_b32 %0, %1" : "+v"(a), "+v"(b)); return a + b; }
DI float xor16_sum(float v) { float a = v, b = v; asm volatile("s_nop 1\n\tv_permlane16_swap_b32 %0, %1" : "+v"(a), "+v"(b)); return a + b; }
DI float wave_sum(float v) {
#pragma unroll
  for (int o = 32; o > 0; o >>= 1) v += __shfl_xor(v, o);
  return v;
}
DI float wave_sum_dpp(float v) {
  return xor32_sum(xor16_sum(row16_sum(v)));
}
DI float bflo(unsigned u) { return __uint_as_float(u << 16); }
DI float bfhi(unsigned u) { return __uint_as_float(u & 0xffff0000u); }

__device__ void mod_item(const P& p, int it, char* smem, int tidx) {
  float* sS = (float*)smem;
  float* red = sS + 3072;
  const int tid = tidx;
  const int l = it / 144, n0 = (it % 144) * 64;
  for (int i = tid; i < 3072; i += 256) {
    int r = i >> 10, k = i & 1023;
    float v = r == 0 ? p.c_ctx[k] : p.c[(r - 1) * 1024 + k];
    sS[i] = v / (1.f + expf(-v));
  }
  __syncthreads();
  const int kq = tid >> 4, cq = tid & 15;
  const float* w = p.mod_w + (size_t)l * 1024 * 9216 + (size_t)(kq * 64) * 9216 + n0 + cq * 4;
  float a00 = 0, a01 = 0, a02 = 0, a03 = 0, a10 = 0, a11 = 0, a12 = 0, a13 = 0, a20 = 0, a21 = 0, a22 = 0, a23 = 0;
#pragma unroll 1
  for (int k0 = 0; k0 < 64; k0 += 8) {
    float4 wv[8];
#pragma unroll
    for (int k = 0; k < 8; ++k) wv[k] = *(const float4*)(w + (size_t)(k0 + k) * 9216);
#pragma unroll
    for (int k = 0; k < 8; ++k) {
      float4 w4 = wv[k];
      float s0 = sS[kq * 64 + k0 + k], s1 = sS[1024 + kq * 64 + k0 + k], s2 = sS[2048 + kq * 64 + k0 + k];
      a00 += s0 * w4.x; a01 += s0 * w4.y; a02 += s0 * w4.z; a03 += s0 * w4.w;
      a10 += s1 * w4.x; a11 += s1 * w4.y; a12 += s1 * w4.z; a13 += s1 * w4.w;
      a20 += s2 * w4.x; a21 += s2 * w4.y; a22 += s2 * w4.z; a23 += s2 * w4.w;
    }
  }
  float* r0 = red + (kq * 3 + 0) * 64 + cq * 4;
  r0[0] = a00; r0[1] = a01; r0[2] = a02; r0[3] = a03;
  r0[64] = a10; r0[65] = a11; r0[66] = a12; r0[67] = a13;
  r0[128] = a20; r0[129] = a21; r0[130] = a22; r0[131] = a23;
  __syncthreads();
  if (tid < 192) {
    int r = tid >> 6, n = tid & 63;
    float s = p.mod_b[l * 9216 + n0 + n];
#pragma unroll
    for (int q = 0; q < 16; ++q) s += red[(q * 3 + r) * 64 + n];
    p.MOD[(l * 3 + r) * 9216 + n0 + n] = s;
  }
  __syncthreads();
}

struct TrItem { const float* src; u16* dst; int N, Kd, k0, n0, perm; };
DI TrItem tr_decode(const P& p, int idx) {
  TrItem t; t.perm = 0; int kt, nt;
  if (idx < 2816) { int mat = idx / 704, r = idx % 704; kt = r / 44; nt = r % 44; t.src = p.ffn_w1 + (size_t)mat * 1024 * 5632; t.N = 5632; t.Kd = 1024; t.dst = p.W1T + (size_t)mat * 5632 * 1024; t.perm = 1; }
  else if (idx < 4224) { int r0 = idx - 2816; int mat = r0 / 352, r = r0 % 352; kt = r / 8; nt = r % 8; t.src = p.ffn_w2 + (size_t)mat * 2816 * 1024; t.N = 1024; t.Kd = 2816; t.dst = p.W2T + (size_t)mat * 1024 * 2816; }
  else if (idx < 4608) { int r = idx - 4224; kt = r / 24; nt = r % 24; t.src = p.ev_w_in; t.N = 3072; t.Kd = 1024; t.dst = p.EVIN; }
  else if (idx < 4736) { int r = idx - 4608; kt = r / 8; nt = r % 8; t.src = p.ev_w_out; t.N = 1024; t.Kd = 1024; t.dst = p.EVOUT; }
  else if (idx < 4896) { int r = idx - 4736; kt = r / 10; nt = r % 10; t.src = p.od_w_in; t.N = 1280; t.Kd = 1024; t.dst = p.ODIN; }
  else if (idx < 5024) { int r = idx - 4896; kt = r / 8; nt = r % 8; t.src = p.od_w_out; t.N = 1024; t.Kd = 1024; t.dst = p.ODOUT; }
  else { int r = idx - 5024; int mat = r >> 1; kt = r & 1; nt = 0; t.src = p.od_pool_w + mat * 16384; t.N = 128; t.Kd = 512; t.dst = p.POOLW + (size_t)(mat * 128) * 512 + mat * 128; }
  t.k0 = kt * 64; t.n0 = nt * 128;
  return t;
}

__device__ void prep_phase(const P& p, char* smem_all, int bid, int G, int tid512) {
  constexpr int N_MOD = 288, N_TR = 5032, N_CC = 448;
  const int half = tid512 >> 8, tid = tid512 & 255;
  char* smem = smem_all + half * 36864;
  for (int pi = bid; pi < N_MOD / 2; pi += G) mod_item(p, 2 * pi + half, smem, tid);
  {
    float* tl = (float*)smem;
    const int r = tid >> 5, c4 = (tid & 31) * 4;
    float4 v[8];
    int tp = bid;
    TrItem cur{};
    if (tp < N_TR / 2) {
      cur = tr_decode(p, 2 * tp + half);
      const float* sp = cur.src + (size_t)(cur.k0 + r) * cur.N + cur.n0 + c4;
#pragma unroll
      for (int q = 0; q < 8; ++q) v[q] = *(const float4*)(sp + (size_t)(8 * q) * cur.N);
    }
    for (; tp < N_TR / 2; tp += G) {
      float* tpp = tl + r * 129 + c4;
#pragma unroll
      for (int q = 0; q < 8; ++q) { tpp[q * 8 * 129] = v[q].x; tpp[q * 8 * 129 + 1] = v[q].y; tpp[q * 8 * 129 + 2] = v[q].z; tpp[q * 8 * 129 + 3] = v[q].w; }
      __syncthreads();
      const TrItem me = cur;
      if (tp + G < N_TR / 2) {
        cur = tr_decode(p, 2 * (tp + G) + half);
        const float* sp = cur.src + (size_t)(cur.k0 + r) * cur.N + cur.n0 + c4;
#pragma unroll
        for (int q = 0; q < 8; ++q) v[q] = *(const float4*)(sp + (size_t)(8 * q) * cur.N);
      }
#pragma unroll
      for (int q = 0; q < 4; ++q) {
        int nn = (tid >> 3) + 32 * q, kc = tid & 7;
        int n = me.n0 + nn, nd = n;
        if (me.perm) nd = n < DFF ? ((n >> 5) * 64 + (n & 31)) : ((((n - DFF) >> 5) * 64) + 32 + ((n - DFF) & 31));
        const float* t = tl + (kc * 8) * 129 + nn;
        uint4 o;
        o.x = pack2(t[0], t[129]); o.y = pack2(t[258], t[387]); o.z = pack2(t[516], t[645]); o.w = pack2(t[774], t[903]);
        *(uint4*)(me.dst + (size_t)nd * me.Kd + me.k0 + kc * 8) = o;
      }
      __syncthreads();
    }
  }
  for (int pi = bid; pi < N_CC / 2; pi += G) {
    const int idx = 2 * pi + half;
    {
      int e0 = idx * 2048 + tid * 8;
#pragma unroll 1
      for (int j = 0; j < 8; ++j) {
        int e = e0 + j;
        if (e < 589824 && (e < 262144 || e >= 524288)) {
          const bool isA = e < 262144; const int q = isA ? e : e - 524288;
          const int x = q & 7, ln = (q >> 3) & 63, sub = (q >> 9) & 3, T = (q >> 11) & 7, bh = q >> 14;
          const int key = T * 32 + (ln & 31), d = sub * 16 + (ln >> 5) * 8 + x;
          const float v = (isA ? p.cache_a_k : p.cache_d_k)[(bh * 256 + key) * 64 + d];
          (isA ? p.CAK : p.CDK)[q] = f2bf(v);
        } else if (e < 655360) {
          const bool isA = e < 524288; const int q = isA ? e - 262144 : e - 589824;
          const int x = q & 7, ln = (q >> 3) & 63, sub = (q >> 9) & 3, T = (q >> 11) & 7, bh = q >> 14;
          const int dim = (sub >> 1) * 32 + (ln & 31), key = T * 32 + 16 * (sub & 1) + 8 * (x >> 2) + 4 * (ln >> 5) + (x & 3);
          const float v = (isA ? p.cache_a_v : p.cache_d_v)[(bh * 256 + key) * 64 + dim];
          (isA ? p.CAVT : p.CDVT)[q] = f2bf(v);
        }
        else { int q = e - 655360; int n = q >> 9, k = q & 511; if ((n >> 7) != (k >> 7)) p.POOLW[q] = 0; }
      }
    }
  }
}

template <int RMODE>
__device__ void r_phase(const P& p, bool first_unused, bool hasT_unused, const float* gT, const float* modg, int gate_idx, float gscale,
                        bool writeH, const float* g2, const float* modn, int shift_idx, int scale_idx, float* xdst, int gw, int W, int tidx) {
  const int lane = tidx & 63;
  constexpr bool first = RMODE == 0, hasT = RMODE != 0;
  constexpr int NR = 6;
  for (int t0 = gw; t0 < MTOK; t0 += NR * W) {
    float4 xf[NR][4];
    uint2 xq[NR][4], tq[NR][4];
#pragma unroll
    for (int r = 0; r < NR; ++r) {
      const int t = t0 + r * W;
      if (t < MTOK) {
        if (first) {
          const float* xs = t < MPR ? p.x_prompt + (size_t)t * DM : p.x_sample + (size_t)(t - MPR) * DM;
#pragma unroll
          for (int j = 0; j < 4; ++j) xf[r][j] = *(const float4*)(xs + lane * 4 + 256 * j);
        } else {
          const u16* xs = (const u16*)p.X + (size_t)t * DM;
          const u16* ts = (const u16*)p.T + (size_t)t * DM;
#pragma unroll
          for (int j = 0; j < 4; ++j) { xq[r][j] = *(const uint2*)(xs + lane * 4 + 256 * j); tq[r][j] = *(const uint2*)(ts + lane * 4 + 256 * j); }
        }
      }
    }
#pragma unroll
    for (int r = 0; r < NR; ++r) {
      const int t = t0 + r * W;
      if (t < MTOK) {
        const int ci = t < MPR ? 0 : 1 + ((t - MPR) >> 11);
        float4 x[4];
        if (first) {
#pragma unroll
          for (int j = 0; j < 4; ++j) x[j] = xf[r][j];
        } else {
#pragma unroll
          for (int j = 0; j < 4; ++j) x[j] = make_float4(bflo(xq[r][j].x), bfhi(xq[r][j].x), bflo(xq[r][j].y), bfhi(xq[r][j].y));
        }
        if (hasT) {
          float4 tv[4];
          float ss = 0.f;
#pragma unroll
          for (int j = 0; j < 4; ++j) {
            tv[j] = make_float4(bflo(tq[r][j].x), bfhi(tq[r][j].x), bflo(tq[r][j].y), bfhi(tq[r][j].y));
            ss += tv[j].x * tv[j].x + tv[j].y * tv[j].y + tv[j].z * tv[j].z + tv[j].w * tv[j].w;
          }
          ss = wave_sum(ss);
          const float rs = rsqrtf(ss * (1.f / 1024.f) + 1e-6f) * gscale;
          const float* mg = modg + ci * 9216 + gate_idx * 1024;
#pragma unroll
          for (int j = 0; j < 4; ++j) {
            int c = lane * 4 + 256 * j;
            float4 g4 = *(const float4*)(gT + c), m4 = *(const float4*)(mg + c);
            x[j].x += m4.x * (tv[j].x * rs * g4.x); x[j].y += m4.y * (tv[j].y * rs * g4.y);
            x[j].z += m4.z * (tv[j].z * rs * g4.z); x[j].w += m4.w * (tv[j].w * rs * g4.w);
          }
        }
        if (RMODE == 2) {
#pragma unroll
          for (int j = 0; j < 4; ++j) *(float4*)(xdst + (size_t)t * DM + lane * 4 + 256 * j) = x[j];
        } else {
#pragma unroll
          for (int j = 0; j < 4; ++j) {
            uint2 o; o.x = pack2(x[j].x, x[j].y); o.y = pack2(x[j].z, x[j].w);
            *(uint2*)((u16*)xdst + (size_t)t * DM + lane * 4 + 256 * j) = o;
          }
          float ss = 0.f;
#pragma unroll
          for (int j = 0; j < 4; ++j) ss += x[j].x * x[j].x + x[j].y * x[j].y + x[j].z * x[j].z + x[j].w * x[j].w;
          ss = wave_sum(ss);
          const float r2 = rsqrtf(ss * (1.f / 1024.f) + 1e-6f);
          const float* sh = modn + ci * 9216 + shift_idx * 1024;
          const float* sc = modn + ci * 9216 + scale_idx * 1024;
#pragma unroll
          for (int j = 0; j < 4; ++j) {
            int c = lane * 4 + 256 * j;
            float4 g4 = *(const float4*)(g2 + c), s4 = *(const float4*)(sc + c), h4 = *(const float4*)(sh + c);
            float h0 = x[j].x * r2 * g4.x * (1.f + s4.x) + h4.x;
            float h1 = x[j].y * r2 * g4.y * (1.f + s4.y) + h4.y;
            float h2 = x[j].z * r2 * g4.z * (1.f + s4.z) + h4.z;
            float h3 = x[j].w * r2 * g4.w * (1.f + s4.w) + h4.w;
            uint2 o; o.x = pack2(h0, h1); o.y = pack2(h2, h3);
            *(uint2*)(p.H + (size_t)t * DM + c) = o;
          }
        }
      }
    }
  }
}

enum { EPI_SWIGLU = 0, EPI_F32 = 1, EPI_EVIN = 2, EPI_ODIN = 3, EPI_POOL = 4, EPI_RES = 5 };
struct ResArgs { const float* gT; const float* modg; const float* g2; const float* modn; int gate; int shi; float gs; int kuse; int fin; };
using f32x4 = __attribute__((ext_vector_type(4))) float;

DI int lds_byte2(int r, int c) {
  int st = (r >> 4) * 2 + (c >> 5), ob = (r & 15) * 64 + (c & 31) * 2;
  return st * 1024 + (ob ^ (((ob >> 9) & 1) << 5));
}
DI void stage_rc2(int b, int& R, int& C) {
  int st = b >> 10, sb = b & 1023, swz = sb ^ (((sb >> 9) & 1) << 5);
  R = (st >> 1) * 16 + (swz >> 6);
  C = (st & 1) * 32 + ((swz & 63) >> 1);
}
#define WAIT_V0() asm volatile("s_waitcnt vmcnt(0)" ::: "memory")

#define LDS_RD4(a, b, c, d, addr, o0, o1, o2, o3) asm volatile( \
    "ds_read_b128 %0, %4 offset:%5\n\tds_read_b128 %1, %4 offset:%6\n\tds_read_b128 %2, %4 offset:%7\n\tds_read_b128 %3, %4 offset:%8\n\ts_waitcnt lgkmcnt(0)" \
    : "=&v"(a), "=&v"(b), "=&v"(c), "=&v"(d) : "v"(addr), "n"(o0), "n"(o1), "n"(o2), "n"(o3) : "memory")
template <int EPI, int MF, bool TAIL = false>
__device__ __forceinline__ void gemm_phase(const P& p, const u16* __restrict__ A, const u16* __restrict__ Bt, int K,
                                           int nMT, int nNT, void* outp, int ldc, char* smem, int vbid, int G, int tidx, int tlimit = 1 << 30, int tbase = 0, ResArgs ra = ResArgs{}) {
  constexpr int TILE_B = 32768, STAGE_B = 65536;
  const int wid = __builtin_amdgcn_readfirstlane(tidx >> 6), lane = tidx & 63, wr = wid >> 2, wc = wid & 3, fr = lane & 15, fq = lane >> 4;
  int sOff0;
  { int R, C; stage_rc2(wid * 1024 + lane * 16, R, C); sOff0 = R * K + C; }
  const unsigned sOffB = (unsigned)sOff0 * 2u;
  const int aOff0 = lds_byte2(wr * (16 * MF) + fr, fq * 8);
  const int bOff0 = lds_byte2(wc * 64 + fr, fq * 8);
  const int ntiles = TAIL ? tlimit : min(nMT * nNT, tlimit), nt = K >> 6;
#define GLDS_STAGE(AB, BB, buf, kt) do { _Pragma("unroll") for (int i = 0; i < 4; ++i) { \
      if (wid + 8 * i < 4 * MF) __builtin_amdgcn_global_load_lds((const unsigned*)((const char*)((AB) + (size_t)(i * 64) * K + (kt) * 64) + sOffCur), (unsigned*)(smem + (buf) * STAGE_B + wid * 1024 + i * 8192), 16, 0, 0); \
      __builtin_amdgcn_global_load_lds((const unsigned*)((const char*)((BB) + (size_t)(i * 64) * K + (kt) * 64) + sOffCur), (unsigned*)(smem + (buf) * STAGE_B + TILE_B + wid * 1024 + i * 8192), 16, 0, 0); } } while (0)
#define TILE_COORDS(T, BR, BC) do { const int ts_ = TAIL ? tbase + ((T) >> 1) : (T); \
      const int grp_ = ts_ / (8 * nNT), r2_ = ts_ - grp_ * 8 * nNT; \
      BR = (grp_ * 8 + (r2_ & 7)) * (TAIL ? 192 : 32 * MF) + (TAIL ? ((T) & 1) * 96 : 0); BC = (r2_ >> 3) * 256; } while (0)
  if (vbid < ntiles) {
    unsigned sOffCur = sOffB; asm volatile("" : "+v"(sOffCur));
    int br_, bc_; TILE_COORDS(vbid, br_, bc_);
    GLDS_STAGE(A + (size_t)br_ * K, Bt + (size_t)bc_ * K, 0, 0);
  }
  for (int tile = vbid; tile < ntiles; tile += G) {
    int brow, bcol; TILE_COORDS(tile, brow, bcol);
    unsigned sOffCur = sOffB; asm volatile("" : "+v"(sOffCur));
    const u16* Ab = A + (size_t)brow * K;
    const u16* Bb = Bt + (size_t)bcol * K;
    f32x4 acc[MF][4];
#pragma unroll
    for (int m = 0; m < MF; ++m)
#pragma unroll
      for (int n = 0; n < 4; ++n) { acc[m][n][0] = 0.f; acc[m][n][1] = 0.f; acc[m][n][2] = 0.f; acc[m][n][3] = 0.f; }
#define LDS_RD(dst, base, off) asm volatile("ds_read_b128 %0, %1 offset:%2" : "=v"(dst) : "v"(base), "n"(off))
    bf16x8 A0[MF], B0[4], A1[MF], B1[4];
    const unsigned lbase = (unsigned)(size_t)(smem);
    WAIT_V0(); __syncthreads();
    if (nt > 1) GLDS_STAGE(Ab, Bb, 1, 1);
    asm volatile("s_waitcnt lgkmcnt(0)" ::: "memory");
    {
      const unsigned la = lbase + aOff0, lb = lbase + TILE_B + bOff0;
#pragma unroll
      for (int n = 0; n < 4; ++n) LDS_RD(B0[n], lb, n * 2048);
#pragma unroll
      for (int m = 0; m < MF; ++m) LDS_RD(A0[m], la, m * 2048);
    }
    for (int t = 0; t < nt; ++t) {
      const int cur = t & 1;
      const unsigned la = lbase + cur * STAGE_B + aOff0, lb = lbase + cur * STAGE_B + TILE_B + bOff0;
      const unsigned lan = lbase + (cur ^ 1) * STAGE_B + aOff0, lbn = lbase + (cur ^ 1) * STAGE_B + TILE_B + bOff0;
#pragma unroll
      for (int n = 0; n < 4; ++n) LDS_RD(B1[n], lb, n * 2048 + 1024);
#pragma unroll
      for (int m = 0; m < MF; ++m) LDS_RD(A1[m], la, m * 2048 + 1024);
      __builtin_amdgcn_sched_barrier(0);
#pragma unroll
      for (int m = 0; m < MF; ++m) {
        if (m == 0) asm volatile("s_waitcnt lgkmcnt(%5)" : "+v"(A0[0]), "+v"(B0[0]), "+v"(B0[1]), "+v"(B0[2]), "+v"(B0[3]) : "n"(4 + MF + MF - 1));
        else asm volatile("s_waitcnt lgkmcnt(%1)" : "+v"(A0[m]) : "n"(4 + MF + MF - 1 - m));
#pragma unroll
        for (int n = 0; n < 4; ++n) acc[m][n] = __builtin_amdgcn_mfma_f32_16x16x32_bf16(A0[m], B0[n], acc[m][n], 0, 0, 0);
        __builtin_amdgcn_sched_barrier(0);
      }
      if (MF == 3) asm volatile("s_waitcnt lgkmcnt(0)" : "+v"(A1[0]), "+v"(A1[1]), "+v"(A1[MF - 1]), "+v"(B1[0]), "+v"(B1[1]), "+v"(B1[2]), "+v"(B1[3]));
      else if (MF == 6) asm volatile("s_waitcnt lgkmcnt(0)" : "+v"(A1[0]), "+v"(A1[1]), "+v"(A1[2]), "+v"(A1[3]), "+v"(A1[4]), "+v"(A1[MF - 1]), "+v"(B1[0]), "+v"(B1[1]), "+v"(B1[2]), "+v"(B1[3]));
      else asm volatile("s_waitcnt lgkmcnt(0)" : "+v"(A1[0]), "+v"(A1[1]), "+v"(A1[2]), "+v"(A1[3]), "+v"(A1[4]), "+v"(A1[5]), "+v"(A1[MF - 2]), "+v"(A1[MF - 1]), "+v"(B1[0]), "+v"(B1[1]), "+v"(B1[2]), "+v"(B1[3]));
      WAIT_V0(); __syncthreads();
      if (t + 2 < nt) { GLDS_STAGE(Ab, Bb, cur, t + 2); }
      else if (t + 1 == nt && tile + G < ntiles) {
        int br_, bc_; TILE_COORDS(tile + G, br_, bc_);
        GLDS_STAGE(A + (size_t)br_ * K, Bt + (size_t)bc_ * K, 0, 0);
      }
      if (t + 1 < nt) {
#pragma unroll
        for (int n = 0; n < 4; ++n) LDS_RD(B0[n], lbn, n * 2048);
#pragma unroll
        for (int m = 0; m < MF; ++m) LDS_RD(A0[m], lan, m * 2048);
      }
      __builtin_amdgcn_sched_barrier(0);
#pragma unroll
      for (int m = 0; m < MF; ++m) {
#pragma unroll
        for (int n = 0; n < 4; ++n) acc[m][n] = __builtin_amdgcn_mfma_f32_16x16x32_bf16(A1[m], B1[n], acc[m][n], 0, 0, 0);
      }
      __builtin_amdgcn_sched_barrier(0);
    }
#undef LDS_RD
    unsigned zl_ = 0u; asm volatile("" : "+v"(zl_));
    const int le = (int)__builtin_amdgcn_mbcnt_hi(~0u, __builtin_amdgcn_mbcnt_lo(~0u, zl_));
    const int fre = le & 15, fqe = le >> 4;
    float* Ew = (float*)(smem + STAGE_B + wid * 4352);
    const int r0 = brow + wr * (16 * MF), c0 = bcol + wc * 64;
    if (EPI == EPI_RES) {
      const int te = wid * 64 + le;
      float* rp = (float*)(smem + STAGE_B + 8 * 4352);
      float* rstat = rp + 192 * 4;
      const int mt = brow / 192, ntl = bcol >> 8;
      unsigned* flag = p.BAR + 3456 + mt * 32;
      const unsigned target = 4u * (unsigned)(ra.kuse + 1);
      float* xch0 = p.XCH + (size_t)brow * 4;
      float* xch1 = p.XCH + (size_t)(12288 + brow) * 4;
#define XCH_ST(ptr, v) __hip_atomic_store((ptr), (v), __ATOMIC_RELAXED, __HIP_MEMORY_SCOPE_AGENT)
#define XCH_LD(ptr) __hip_atomic_load((ptr), __ATOMIC_RELAXED, __HIP_MEMORY_SCOPE_AGENT)
#define ROW_EXCHANGE(FL) do { \
        asm volatile("s_waitcnt vmcnt(0)" ::: "memory"); \
        __syncthreads(); \
        if (te == 0) { \
          (void)__hip_atomic_fetch_add((FL), 1u, __ATOMIC_RELAXED, __HIP_MEMORY_SCOPE_AGENT); \
          unsigned sp_ = 0; \
          while (__hip_atomic_load((FL), __ATOMIC_RELAXED, __HIP_MEMORY_SCOPE_AGENT) < target) { __builtin_amdgcn_s_sleep(1); if (++sp_ > (1u << 22)) break; } \
        } \
        __syncthreads(); } while (0)
      const int c4 = (le & 15) * 4;
      u16* X16 = (u16*)p.X;
      uint2 xpre[MF][4];
      float4 mgpre[MF];
#pragma unroll
      for (int m = 0; m < MF; ++m) {
        const int rm = r0 + m * 16;
        const int ci = rm < MPR ? 0 : 1 + ((rm - MPR) >> 11);
        mgpre[m] = *(const float4*)(ra.modg + ci * 9216 + ra.gate * 1024 + c0 + c4);
#pragma unroll
        for (int ps = 0; ps < 4; ++ps)
          xpre[m][ps] = *(const uint2*)(X16 + (size_t)(brow + wr * 96 + m * 16 + (le >> 4) + 4 * ps) * DM + c0 + c4);
      }
#pragma unroll
      for (int m = 0; m < MF; ++m)
#pragma unroll
        for (int j = 0; j < 4; ++j) {
          float s = acc[m][0][j] * acc[m][0][j] + acc[m][1][j] * acc[m][1][j] + acc[m][2][j] * acc[m][2][j] + acc[m][3][j] * acc[m][3][j];
          s = row16_sum(s);
          if (fre == 0) rp[(wr * 96 + m * 16 + fqe * 4 + j) * 4 + wc] = s;
        }
      __syncthreads();
      if (te < 192) XCH_ST(xch0 + te * 4 + ntl, rp[te * 4] + rp[te * 4 + 1] + rp[te * 4 + 2] + rp[te * 4 + 3]);
      ROW_EXCHANGE(flag);
      if (te < 192) { const float qs = XCH_LD(xch0 + te * 4) + XCH_LD(xch0 + te * 4 + 1) + XCH_LD(xch0 + te * 4 + 2) + XCH_LD(xch0 + te * 4 + 3); rstat[te] = rsqrtf(qs * (1.f / 1024.f) + 1e-6f) * ra.gs; }
      __syncthreads();
      const float4 gT4 = *(const float4*)(ra.gT + c0 + c4);
      float4 xn[MF][4];
#pragma unroll
      for (int m = 0; m < MF; ++m) {
        const int rm = r0 + m * 16;
        const int ci = rm < MPR ? 0 : 1 + ((rm - MPR) >> 11);
        const float4 mg4 = mgpre[m];
#pragma unroll
        for (int n = 0; n < 4; ++n)
#pragma unroll
          for (int j = 0; j < 4; ++j) Ew[(fqe * 4 + j) * 68 + n * 16 + fre] = acc[m][n][j];
        f32x4 q0, q1, q2, q3;
        LDS_RD4(q0, q1, q2, q3, (unsigned)(size_t)(Ew + (le >> 4) * 68 + c4), 0, 1088, 2176, 3264);
#pragma unroll
        for (int ps = 0; ps < 4; ++ps) {
          const f32x4 qv = ps == 0 ? q0 : (ps == 1 ? q1 : (ps == 2 ? q2 : q3));
          const int rl = wr * 96 + m * 16 + (le >> 4) + 4 * ps;
          const size_t ro = (size_t)(brow + rl) * DM + c0 + c4;
          const float rs = rstat[rl];
          const uint2 xq = xpre[m][ps];
          float4 y;
          y.x = bflo(xq.x) + mg4.x * (qv[0] * rs * gT4.x); y.y = bfhi(xq.x) + mg4.y * (qv[1] * rs * gT4.y);
          y.z = bflo(xq.y) + mg4.z * (qv[2] * rs * gT4.z); y.w = bfhi(xq.y) + mg4.w * (qv[3] * rs * gT4.w);
          xn[m][ps] = y;
          if (ra.fin) { *(float4*)(p.out + ro) = y; }
          else {
            uint2 o; o.x = pack2(y.x, y.y); o.y = pack2(y.z, y.w);
            *(uint2*)(X16 + ro) = o;
            float s = y.x * y.x + y.y * y.y + y.z * y.z + y.w * y.w;
            s = row16_sum(s);
            if ((le & 15) == 0) rp[rl * 4 + wc] = s;
          }
        }
      }
      float4 shpre[MF], scpre[MF];
      float4 g24 = make_float4(0.f, 0.f, 0.f, 0.f);
      if (!ra.fin) {
        g24 = *(const float4*)(ra.g2 + c0 + c4);
#pragma unroll
        for (int m = 0; m < MF; ++m) {
          const int rm = r0 + m * 16;
          const int ci = rm < MPR ? 0 : 1 + ((rm - MPR) >> 11);
          shpre[m] = *(const float4*)(ra.modn + ci * 9216 + ra.shi * 1024 + c0 + c4);
          scpre[m] = *(const float4*)(ra.modn + ci * 9216 + (ra.shi + 1) * 1024 + c0 + c4);
        }
      }
      if (!ra.fin) {
        __syncthreads();
        if (te < 192) XCH_ST(xch1 + te * 4 + ntl, rp[te * 4] + rp[te * 4 + 1] + rp[te * 4 + 2] + rp[te * 4 + 3]);
        ROW_EXCHANGE(flag + 16);
        if (te < 192) { const float qs = XCH_LD(xch1 + te * 4) + XCH_LD(xch1 + te * 4 + 1) + XCH_LD(xch1 + te * 4 + 2) + XCH_LD(xch1 + te * 4 + 3); rstat[te] = rsqrtf(qs * (1.f / 1024.f) + 1e-6f); }
        __syncthreads();
#pragma unroll
        for (int m = 0; m < MF; ++m) {
          const float4 sh4 = shpre[m], sc4 = scpre[m];
#pragma unroll
          for (int ps = 0; ps < 4; ++ps) {
            const int rl = wr * 96 + m * 16 + (le >> 4) + 4 * ps;
            const float r2 = rstat[rl];
            const float4 y = xn[m][ps];
            uint2 o;
            o.x = pack2(y.x * r2 * g24.x * (1.f + sc4.x) + sh4.x, y.y * r2 * g24.y * (1.f + sc4.y) + sh4.y);
            o.y = pack2(y.z * r2 * g24.z * (1.f + sc4.z) + sh4.z, y.w * r2 * g24.w * (1.f + sc4.w) + sh4.w);
            *(uint2*)(p.H + (size_t)(brow + rl) * DM + c0 + c4) = o;
          }
        }
      }
#undef ROW_EXCHANGE
#undef XCH_ST
#undef XCH_LD
      continue;
    }
    constexpr int vlo = (EPI == EPI_EVIN) ? 1024 : 1152, vhi = (EPI == EPI_EVIN) ? 1536 : 1280;
    const bool isV = (EPI == EPI_EVIN || EPI == EPI_ODIN) && c0 >= vlo && c0 < vhi;
    float* sbase = nullptr; int hd = 0, nh = 8;
    if (EPI == EPI_EVIN) {
      if (c0 >= 512 && c0 < 1024) { sbase = p.out + OFF_SAK; hd = (c0 - 512) >> 6; }
      else if (c0 >= 1024 && c0 < 1536) { sbase = p.out + OFF_SAV; hd = (c0 - 1024) >> 6; }
    } else if (EPI == EPI_ODIN) {
      nh = 2;
      if (c0 >= 1152 && c0 < 1280) { sbase = p.out + OFF_SDV; hd = (c0 - 1152) >> 6; }
    }
    const int c4 = (le & 15) * 4;
    float4 psc = make_float4(1.f, 1.f, 1.f, 1.f);
    if (EPI == EPI_POOL) psc = *(const float4*)(p.od_pool_scale + c0 + c4);
    constexpr int ESZ = 2;
    char* orow = (EPI == EPI_SWIGLU)
        ? (char*)outp + ((size_t)(r0 + (le >> 3)) * ldc + (c0 >> 1) + (le & 7) * 4) * 2
        : (char*)outp + ((size_t)(r0 + (le >> 4)) * ldc + c0 + c4) * ESZ;
    const size_t rstride = (size_t)ldc * ESZ;
#pragma unroll
    for (int m = 0; m < MF; ++m) {
      asm volatile("" : "+v"(orow));
      const int rm = r0 + m * 16;
      float* srow = (sbase && rm < MPR) ? sbase + ((size_t)((rm >> 8) * nh + hd) * 256 + (rm & 255) + (le >> 4)) * 64 + c4 : nullptr;
      if (EPI == EPI_EVIN || EPI == EPI_ODIN) {
        if (isV) {
          const int t0 = rm + fqe * 4, kk16 = t0 & 15;
          u16* vb = p.VT + ((size_t)(((c0 - vlo) >> 6) * 384 + (t0 >> 5)) * 4 + ((t0 >> 4) & 1)) * 512 + (((kk16 >> 2) & 1) * 32) * 8 + (kk16 >> 3) * 4;
#pragma unroll
          for (int n = 0; n < 4; ++n) {
            const int dim = n * 16 + fre;
            uint2 o; o.x = pack2(acc[m][n][0], acc[m][n][1]); o.y = pack2(acc[m][n][2], acc[m][n][3]);
            *(uint2*)(vb + (dim >> 5) * 1024 + (dim & 31) * 8) = o;
          }
        }
      }
      if (EPI != EPI_SWIGLU) {
#pragma unroll
      for (int n = 0; n < 4; ++n)
#pragma unroll
        for (int j = 0; j < 4; ++j) Ew[(fqe * 4 + j) * 68 + n * 16 + fre] = acc[m][n][j];
      }
      if (EPI == EPI_EVIN) {
        if (c0 >= 512 && c0 < 1024) {
#pragma unroll
          for (int ps = 0; ps < 2; ++ps) {
            const int slot = le + 64 * ps, row = slot >> 3, ch = slot & 7;
            const float4 a = *(const float4*)(Ew + row * 68 + ch * 8), b4 = *(const float4*)(Ew + row * 68 + ch * 8 + 4);
            uint4 o; o.x = pack2(a.x, a.y); o.y = pack2(a.z, a.w); o.z = pack2(b4.x, b4.y); o.w = pack2(b4.z, b4.w);
            const int t = rm + row;
            *(uint4*)(p.KF + ((size_t)(((c0 - 512) >> 6) * 384 + (t >> 5)) * 4 + (ch >> 1)) * 512 + ((ch & 1) * 32 + (t & 31)) * 8) = o;
          }
        }
      }
      if (EPI == EPI_SWIGLU) {
        u16* ab = (u16*)outp + (size_t)(rm + fqe * 4) * ldc + (c0 >> 1) + fre;
#pragma unroll
        for (int j = 0; j < 4; ++j)
#pragma unroll
          for (int n = 0; n < 2; ++n) {
            const float g = acc[m][n][j], u = acc[m][n + 2][j];
            ab[(size_t)j * ldc + n * 16] = (u16)pack2(g * u * __builtin_amdgcn_rcpf(1.f + __expf(-g)), 0.f);
          }
      } else {
        f32x4 q0, q1, q2, q3;
        LDS_RD4(q0, q1, q2, q3, (unsigned)(size_t)(Ew + (le >> 4) * 68 + c4), 0, 1088, 2176, 3264);
#pragma unroll
        for (int ps = 0; ps < 4; ++ps) {
          const f32x4 qv = ps == 0 ? q0 : (ps == 1 ? q1 : (ps == 2 ? q2 : q3));
          float4 v = make_float4(qv[0], qv[1], qv[2], qv[3]);
          if (EPI == EPI_F32) {
            uint2 o; o.x = pack2(v.x, v.y); o.y = pack2(v.z, v.w);
            *(uint2*)(orow + (size_t)(4 * ps) * rstride) = o;
          } else if (EPI == EPI_POOL) {
            uint2 o; o.x = pack2(v.x * psc.x, v.y * psc.y); o.y = pack2(v.z * psc.z, v.w * psc.w);
            *(uint2*)(orow + (size_t)(4 * ps) * rstride) = o;
          } else {
            uint2 o; o.x = pack2(v.x, v.y); o.y = pack2(v.z, v.w);
            *(uint2*)(orow + (size_t)(4 * ps) * rstride) = o;
            if (srow) *(float4*)(srow + (4 * ps) * 64) = v;
          }
        }
      }
      orow += 16 * rstride;
    }
  }
#undef GLDS_STAGE
#undef TILE_COORDS
  __syncthreads();
}

struct Seg { const u16* KF; const u16* VF; int n; };

template <bool BIAS>
__device__ __forceinline__ void attn_core(const u16* __restrict__ Q, int ldq, Seg s0, Seg s1, f32x16& o0, f32x16& o1, float& m, float& l,
                                          const float* __restrict__ rpb_h, int qr, int qc0, int rs, int tidx) {
  const int lane = tidx & 63, l31 = lane & 31, lh = lane >> 5;
  bf16x8 bq[4];
#pragma unroll
  for (int kk = 0; kk < 4; ++kk) bq[kk] = *(const bf16x8*)(Q + (size_t)l31 * ldq + kk * 16 + lh * 8);
  m = -1e30f; l = 0.f;
#pragma unroll
  for (int e = 0; e < 16; ++e) { o0[e] = 0.f; o1[e] = 0.f; }
  const int qc = qc0 + l31;
  const int cs = min(max(qc - 8, 0), 48);
  const int nt0 = s0.n >> 5, ntot = nt0 + (s1.n >> 5);
  const u16* k0p = s0.KF + lane * 8;
  const u16* k1p = s1.KF + lane * 8;
  const u16* v0p = s0.VF + lane * 8;
  const u16* v1p = s1.VF + lane * 8;
  bf16x8 kA[4], kB[4], vA[4], vB[4];
#define KLOAD(dst, i_) do { const int j_ = min((i_), ntot - 1); const bool n1_ = j_ >= nt0; \
    const u16* Kp_ = n1_ ? k1p + (size_t)(j_ - nt0) * 2048 : k0p + (size_t)j_ * 2048; \
    _Pragma("unroll") for (int kk = 0; kk < 4; ++kk) dst[kk] = *(const bf16x8*)(Kp_ + kk * 512); } while (0)
#define VLOAD(dst, i_) do { const int j_ = min((i_), ntot - 1); const bool n1_ = j_ >= nt0; \
    const u16* vp_ = n1_ ? v1p + (size_t)(j_ - nt0) * 2048 : v0p + (size_t)j_ * 2048; \
    _Pragma("unroll") for (int q = 0; q < 4; ++q) dst[q] = *(const bf16x8*)(vp_ + q * 512); } while (0)
#define ATT_STEP(kf, vf, i_, kd_, vd_) do { \
    const bool in1 = (i_) >= nt0; const int kt = in1 ? (i_) - nt0 : (i_); \
    f32x16 sc; _Pragma("unroll") for (int e = 0; e < 16; ++e) sc[e] = 0.f; \
    _Pragma("unroll") for (int kk = 0; kk < 4; ++kk) sc = MFMA(kf[kk], bq[kk], sc); \
    KLOAD(kf, (i_) + (kd_)); \
    float mx = -1e30f; \
    _Pragma("unroll") for (int e = 0; e < 16; ++e) { \
      float v = sc[e] * 0.125f; \
      if (BIAS) { if (in1) { \
          const float* brow_ = rpb_h + (rs + (kt >> 1) - qr + 7) * 31;     \
          int kc = (kt & 1) * 32 + 8 * (e >> 2) + 4 * lh + (e & 3); \
          bool valid = (kc >= cs) && (kc < cs + 16); \
          unsigned co = (unsigned)min(max(kc - qc + 15, 0), 30); \
          float bv = brow_[co]; \
          v = valid ? v + bv : -1e30f; } } \
      sc[e] = v; mx = fmaxf(mx, v); \
      if (BIAS && (e & 3) == 3) __builtin_amdgcn_sched_barrier(0); } \
    mx = xor32_max(mx); \
    const float mnew = fmaxf(m, mx); \
    const float corr = __expf(m - mnew); \
    float rsum = 0.f; \
    _Pragma("unroll") for (int e = 0; e < 16; ++e) { float pv = __expf(sc[e] - mnew); sc[e] = pv; rsum += pv; } \
    rsum = xor32_sum(rsum); \
    l = l * corr + rsum; m = mnew; \
    _Pragma("unroll") for (int e = 0; e < 16; ++e) { o0[e] *= corr; o1[e] *= corr; } \
    uint4 t0, t1; \
    t0.x = pack2(sc[0], sc[1]); t0.y = pack2(sc[2], sc[3]); t0.z = pack2(sc[4], sc[5]); t0.w = pack2(sc[6], sc[7]); \
    t1.x = pack2(sc[8], sc[9]); t1.y = pack2(sc[10], sc[11]); t1.z = pack2(sc[12], sc[13]); t1.w = pack2(sc[14], sc[15]); \
    const bf16x8 pb0 = __builtin_bit_cast(bf16x8, t0), pb1 = __builtin_bit_cast(bf16x8, t1); \
    o0 = MFMA(vf[0], pb0, o0); o0 = MFMA(vf[1], pb1, o0); \
    o1 = MFMA(vf[2], pb0, o1); o1 = MFMA(vf[3], pb1, o1); \
    VLOAD(vf, (i_) + (vd_)); } while (0)
  KLOAD(kA, 0); VLOAD(vA, 0);
  if (!BIAS) { KLOAD(kB, 1); VLOAD(vB, 1); }
#pragma unroll 1
  for (int i = 0; i < ntot; i += 2) {
    if (BIAS) {
      ATT_STEP(kA, vA, i, 1, 1);
      ATT_STEP(kA, vA, i + 1, 1, 1);
    } else {
      ATT_STEP(kA, vA, i, 2, 2);
      ATT_STEP(kB, vB, i + 1, 2, 2);
    }
  }
#undef KLOAD
#undef VLOAD
#undef ATT_STEP
}

__device__ __forceinline__ void attn_store(const f32x16& o0, const f32x16& o1, float inv, u16* __restrict__ O, int ldo, int tidx) {
  const int lane = tidx & 63, l31 = lane & 31, lh = lane >> 5;
  u16* op = O + (size_t)l31 * ldo + 4 * lh;
#pragma unroll
  for (int q4 = 0; q4 < 4; ++q4) {
    uint2 a, b;
    a.x = pack2(o0[4 * q4] * inv, o0[4 * q4 + 1] * inv); a.y = pack2(o0[4 * q4 + 2] * inv, o0[4 * q4 + 3] * inv);
    b.x = pack2(o1[4 * q4] * inv, o1[4 * q4 + 1] * inv); b.y = pack2(o1[4 * q4 + 2] * inv, o1[4 * q4 + 3] * inv);
    *(uint2*)(op + 8 * q4) = a;
    *(uint2*)(op + 32 + 8 * q4) = b;
  }
}

template <bool BIAS>
__device__ __forceinline__ void attn_unit(const u16* __restrict__ Q, int ldq, Seg s0, Seg s1, u16* __restrict__ O, int ldo,
                                          const float* __restrict__ rpb_h, int qr, int qc0, int rs, int tidx) {
  f32x16 o0, o1; float m, l;
  attn_core<BIAS>(Q, ldq, s0, s1, o0, o1, m, l, rpb_h, qr, qc0, rs, tidx);
  attn_store(o0, o1, 1.f / l, O, ldo, tidx);
}

__device__ void mix_even(const P& p, int gw, int W, int tidx) {
  const int lane = tidx & 63;
  const u16* U = p.ACTU;
  u16* MO = p.H;
  for (int u0 = gw; u0 < 2048 + MTOK; u0 += W) {
   for (int sub = 0; sub < 2; ++sub) {
    int u;
    if (u0 < 1024) { if (sub) break; u = u0; }
    else if (u0 < 2048) { u = 1024 + 2 * (u0 - 1024) + sub; }
    else if (W != 2048) { if (sub) break; u = u0 + 1024; }
    else {
      if (gw < 1024) break;
      u = 3072 + (gw - 1024) + (2 * ((u0 - 2048) / W) + sub) * 1024;
    }
    if (u < 1024) {
      int b = u >> 9, h = (u >> 6) & 7, r = (u >> 1) & 31, hf = u & 1;
      int tb = MPR + b * 2048;
      int rs = min(max(r - 4, 0), 24);
      Seg s0 = { p.CAK + (size_t)((b * 8 + h) * 8) * 2048, p.CAVT + (size_t)((b * 8 + h) * 8) * 2048, 256 };
      const size_t lt = (size_t)(h * 384 + ((tb + rs * 64) >> 5)) * 2048;
      Seg s1 = { p.KF + lt, p.VT + lt, 512 };
      int q0 = tb + r * 64 + hf * 32;
      attn_unit<true>(U + (size_t)q0 * 3072 + h * 64, 3072, s0, s1, MO + (size_t)q0 * DM + h * 64, DM, p.ev_rpb + h * 465, r, hf * 32, rs, tidx);
    } else if (u < 3072) {
      int v = u - 1024; int b = v >> 6, h = (v >> 3) & 7, qb = v & 7;
      const size_t lt = (size_t)(h * 384 + b * 8) * 2048;
      Seg s0 = { p.KF + lt, p.VT + lt, 256 };
      Seg s1 = { s0.KF, s0.VF, 0 };
      int q0 = b * 256 + qb * 32;
      attn_unit<false>(U + (size_t)q0 * 3072 + h * 64, 3072, s0, s1, MO + (size_t)q0 * DM + h * 64, DM, nullptr, 0, 0, 0, tidx);
    } else {
      int t = u - 3072;
      int s, L;
      if (t < MPR) { s = t & 255; L = 256; } else { s = (t - MPR) & 2047; L = 2048; }
      const int c = lane * 8;
      float z[3][8];
#pragma unroll
      for (int d = 0; d < 3; ++d) {
        int sd = s + d - 1;
        if (sd >= 0 && sd < L) {
          const u16* row = U + (size_t)(t + d - 1) * 3072;
          uint4 cg4 = *(const uint4*)(row + 2048 + c), xb4 = *(const uint4*)(row + 2560 + c);
          z[d][0] = bflo(cg4.x) * bflo(xb4.x); z[d][1] = bfhi(cg4.x) * bfhi(xb4.x);
          z[d][2] = bflo(cg4.y) * bflo(xb4.y); z[d][3] = bfhi(cg4.y) * bfhi(xb4.y);
          z[d][4] = bflo(cg4.z) * bflo(xb4.z); z[d][5] = bfhi(cg4.z) * bfhi(xb4.z);
          z[d][6] = bflo(cg4.w) * bflo(xb4.w); z[d][7] = bfhi(cg4.w) * bfhi(xb4.w);
        } else {
#pragma unroll
          for (int j = 0; j < 8; ++j) z[d][j] = 0.f;
        }
      }
      uint4 bg4 = *(const uint4*)(U + (size_t)t * 3072 + 1536 + c);
      float bg[8] = { bflo(bg4.x), bfhi(bg4.x), bflo(bg4.y), bfhi(bg4.y), bflo(bg4.z), bfhi(bg4.z), bflo(bg4.w), bfhi(bg4.w) };
      float y[8];
#pragma unroll
      for (int j = 0; j < 8; ++j) {
        float w0 = p.ev_conv_w[c + j], w1 = p.ev_conv_w[512 + c + j], w2 = p.ev_conv_w[1024 + c + j];
        y[j] = bg[j] * (z[0][j] * w0 + z[1][j] * w1 + z[2][j] * w2 + p.ev_conv_b[c + j]);
      }
      uint4 o; o.x = pack2(y[0], y[1]); o.y = pack2(y[2], y[3]); o.z = pack2(y[4], y[5]); o.w = pack2(y[6], y[7]);
      *(uint4*)(MO + (size_t)t * DM + 512 + c) = o;
    }
   }
  }
}

__device__ void mix_odd_a(const P& p, int gw, int W, int tidx) {
  const int lane = tidx & 63;
  u16* U = p.ACTU;
  u16* POOLED = (u16*)p.T;
  const float invf = exp2f(-(float)((lane >> 1) & 15) * (13.287712379549449f / 16.f));
  for (int t = gw; t < MTOK; t += W) {
    const bool smp = t >= MPR;
    int s, L, base;
    if (!smp) { s = t & 255; L = 256; base = t - s; } else { s = (t - MPR) & 2047; L = 2048; base = t - s; }
    float cs_ = 1.f, sn_ = 0.f;
    if (smp) {
      float pos = (lane < 32) ? (float)(s >> 6) : (float)(s & 63);
      float ang = pos * invf;
      cs_ = __cosf(ang); sn_ = __sinf(ang);
    }
    u16* row = U + (size_t)t * 1280;
    const float qw = p.od_q_norm[lane], kw = p.od_k_norm[lane];
    u16 hv[10];
#pragma unroll
    for (int hd = 0; hd < 10; ++hd) hv[hd] = row[512 + hd * 64 + lane];
#pragma unroll
    for (int hd = 0; hd < 10; ++hd) {
      float v = bf2f(hv[hd]);
      float ss = wave_sum_dpp(v * v);
      float w = hd < 8 ? qw : kw;
      float nv = v * rsqrtf(ss * (1.f / 64.f) + 1e-6f) * w;
      float outv = nv;
      if (smp) {
        float pr = __builtin_bit_cast(float, __builtin_amdgcn_update_dpp(0, __builtin_bit_cast(int, nv), 0xB1, 0xF, 0xF, true));
        outv = (lane & 1) ? (pr * sn_ + nv * cs_) : (nv * cs_ - pr * sn_);
      } else if (hd >= 8) {
        int b = t >> 8;
        p.out[OFF_SDK + ((size_t)(b * 2 + (hd - 8)) * 256 + s) * 64 + lane] = nv;
      }
      if (hd < 8) row[512 + hd * 64 + lane] = (u16)pack2(outv, 0.f);
      else p.KF[((size_t)((hd - 8) * 384 + (t >> 5)) * 4 + (lane >> 4)) * 512 + (((lane >> 3) & 1) * 32 + (t & 31)) * 8 + (lane & 7)] = (u16)pack2(outv, 0.f);
    }
    {
      const int half = 1 << (lane >> 4);
      const int lo = max(s - half, 0), hi = min(s + half, L);
      const int c = lane * 8;
      float a[8];
#pragma unroll
      for (int j = 0; j < 8; ++j) a[j] = 0.f;
      for (int j = lo; j < hi; ++j) {
        uint4 v = *(const uint4*)(U + (size_t)(base + j) * 1280 + c);
        a[0] += bflo(v.x); a[1] += bfhi(v.x); a[2] += bflo(v.y); a[3] += bfhi(v.y);
        a[4] += bflo(v.z); a[5] += bfhi(v.z); a[6] += bflo(v.w); a[7] += bfhi(v.w);
      }
      const float rn = __builtin_amdgcn_rcpf((float)(hi - lo));
      uint4 sv = *(const uint4*)(U + (size_t)t * 1280 + c);
      uint4 o;
      o.x = pack2(a[0] * rn - bflo(sv.x), a[1] * rn - bfhi(sv.x));
      o.y = pack2(a[2] * rn - bflo(sv.y), a[3] * rn - bfhi(sv.y));
      o.z = pack2(a[4] * rn - bflo(sv.z), a[5] * rn - bfhi(sv.z));
      o.w = pack2(a[6] * rn - bflo(sv.w), a[7] * rn - bfhi(sv.w));
      *(uint4*)(POOLED + (size_t)t * 512 + c) = o;
    }
  }
}

__device__ void mix_odd_b(const P& p, int gw, int W, int tidx, char* smem) {
  const u16* U = p.ACTU;
  u16* MO = p.H;
  const int lane = tidx & 63, wave = tidx >> 6;
  for (int hu = gw; hu < 2048; hu += W) {
    const int v = hu >> 1, half = hu & 1;
    const int b = v >> 9, hq = (v >> 6) & 7, qb = v & 63, kvh = hq >> 2;
    const int tb = MPR + b * 2048;
    const size_t lt = (size_t)(kvh * 384 + (tb >> 5)) * 2048;
    Seg s0, s1;
    if (half == 0) {
      s0 = Seg{ p.CDK + (size_t)((b * 2 + kvh) * 8) * 2048, p.CDVT + (size_t)((b * 2 + kvh) * 8) * 2048, 256 };
      s1 = Seg{ p.KF + lt, p.VT + lt, 896 };
    } else {
      s0 = Seg{ p.KF + lt + (size_t)28 * 2048, p.VT + lt + (size_t)28 * 2048, 1152 };
      s1 = Seg{ p.KF + lt, p.VT + lt, 0 };
    }
    const int q0 = tb + qb * 32;
    f32x16 o0, o1; float m, l;
    attn_core<false>(U + (size_t)q0 * 1280 + 512 + hq * 64, 1280, s0, s1, o0, o1, m, l, nullptr, 0, 0, 0, tidx);
    float* cb = (float*)smem + (wave >> 1) * (34 * 64) + lane;
    if (half == 1) {
      cb[0] = m; cb[64] = l;
#pragma unroll
      for (int e = 0; e < 16; ++e) { cb[(2 + e) * 64] = o0[e]; cb[(18 + e) * 64] = o1[e]; }
    }
    __syncthreads();
    if (half == 0) {
      const float m2 = cb[0], l2 = cb[64];
      const float M = fmaxf(m, m2);
      const float a1 = __expf(m - M), a2 = __expf(m2 - M);
      const float inv = 1.f / (l * a1 + l2 * a2);
#pragma unroll
      for (int e = 0; e < 16; ++e) { o0[e] = o0[e] * a1 + cb[(2 + e) * 64] * a2; o1[e] = o1[e] * a1 + cb[(18 + e) * 64] * a2; }
      attn_store(o0, o1, inv, MO + (size_t)q0 * DM + 512 + hq * 64, DM, tidx);
    }
    __syncthreads();
  }
  for (int v = gw; v < 2048; v += W) {
    int b = v >> 6, hq = (v >> 3) & 7, qb = v & 7, kvh = hq >> 2;
    const size_t lt = (size_t)(kvh * 384 + b * 8) * 2048;
    Seg s0 = { p.KF + lt, p.VT + lt, 256 };
    Seg s1 = { s0.KF, s0.VF, 0 };
    int q0 = b * 256 + qb * 32;
    attn_unit<false>(U + (size_t)q0 * 1280 + 512 + hq * 64, 1280, s0, s1, MO + (size_t)q0 * DM + 512 + hq * 64, DM, nullptr, 0, 0, 0, tidx);
  }
}

#define XB_TMO      128
#define XB_XCNT(j)  (256  + 64 * (j))
#define XB_XSUB(j)  (1280 + 64 * (j))
#define XB_XGEN(j)  (2304 + 64 * (j))
#define XB_TOP      3328
#define XB_TOPGEN   3392
#define XCD_BAR_WORDS 3456
#define XB_SPIN_CAP (1u << 20)
#define LAS __attribute__((address_space(3)))
DI unsigned xb_ld(unsigned* p)              { return __hip_atomic_load(p, __ATOMIC_RELAXED, __HIP_MEMORY_SCOPE_AGENT); }
DI unsigned xb_add(unsigned* p, unsigned v) { return __hip_atomic_fetch_add(p, v, __ATOMIC_RELAXED, __HIP_MEMORY_SCOPE_AGENT); }
DI unsigned xb_xcc_id() { return (unsigned)__builtin_amdgcn_s_getreg((3 << 11) | 20) & 0xFu; }
#define XB_SPIN(cond, bar) do { unsigned _sp = 0; while (cond) { __builtin_amdgcn_s_sleep(1); \
    if ((++_sp & 255u) == 0u) { if (xb_ld(&(bar)[XB_TMO])) break; if (_sp > XB_SPIN_CAP) { atomicAdd(&(bar)[XB_TMO], 1u); break; } } } } while (0)
struct XcdBarrier { unsigned* bar; unsigned x; volatile LAS unsigned* st; };
DI XcdBarrier xcd_barrier_post(unsigned* bar, volatile LAS unsigned* st) {
  XcdBarrier b; b.bar = bar; b.x = xb_xcc_id(); b.st = st;
  if (threadIdx.x == 0) (void)xb_add(&bar[XB_XCNT(b.x)], 1u);
  return b;
}
DI void xcd_barrier_complete(unsigned* bar, unsigned x, unsigned& nloc, unsigned& nx) {
  const unsigned G = gridDim.x * gridDim.y * gridDim.z;
  unsigned sum, cnt, mine, sp = 0u;
  for (;;) {
    sum = 0u; cnt = 0u; mine = 0u;
#pragma unroll
    for (unsigned j = 0; j < 16; ++j) { const unsigned c = xb_ld(&bar[XB_XCNT(j)]); sum += c; cnt += (c > 0u) ? 1u : 0u; mine = (j == x) ? c : mine; }
    if (sum == G) break;
    __builtin_amdgcn_s_sleep(1);
    if ((++sp & 255u) == 0u) { if (xb_ld(&bar[XB_TMO])) break; if (sp > XB_SPIN_CAP) { atomicAdd(&bar[XB_TMO], 1u); break; } }
  }
  nloc = mine > 0u ? mine : 1u; nx = cnt > 0u ? cnt : 1u;
}
DI void xcd_barrier(const XcdBarrier& b, bool leader) {
  asm volatile("s_waitcnt vmcnt(0)" ::: "memory");
  __syncthreads();
  if (leader) {
    unsigned* bar = b.bar;
    __builtin_amdgcn_s_waitcnt(0);
    unsigned nloc = b.st[0], nx = b.st[1];
    if (nloc == 0u) { xcd_barrier_complete(bar, b.x, nloc, nx); b.st[0] = nloc; b.st[1] = nx; }
    const unsigned old = xb_add(&bar[XB_XSUB(b.x)], 1u);
    const unsigned gen = old / nloc;
    if (old + 1u == (gen + 1u) * nloc) {
      __builtin_amdgcn_fence(__ATOMIC_RELEASE, "agent");
      asm volatile("s_waitcnt vmcnt(0)" ::: "memory");
      const unsigned og = xb_add(&bar[XB_TOP], 1u);
      const unsigned tg = og / nx;
      if (og + 1u == (tg + 1u) * nx) xb_add(&bar[XB_TOPGEN], 1u);
      else XB_SPIN(xb_ld(&bar[XB_TOPGEN]) == tg, bar);
      __builtin_amdgcn_fence(__ATOMIC_ACQUIRE, "agent");
      xb_add(&bar[XB_XGEN(b.x)], 1u);
      asm volatile("s_waitcnt vmcnt(0)" ::: "memory");
    } else {
      XB_SPIN(xb_ld(&bar[XB_XGEN(b.x)]) == gen, bar);
      __builtin_amdgcn_fence(__ATOMIC_ACQUIRE, "agent");
      asm volatile("s_waitcnt vmcnt(0)" ::: "memory");
    }
  }
  __syncthreads();
}

constexpr int N_PHASES = 16;
#define GRID_SYNC() xcd_barrier(xb, wave_s == 0 && __builtin_amdgcn_mbcnt_hi(~0u, __builtin_amdgcn_mbcnt_lo(~0u, 0u)) == 0u)

#define LOADP() unsigned zop = 0u; asm volatile("" : "+v"(zop)); \
    const int tidx = wave_s * 64 + (int)__builtin_amdgcn_mbcnt_hi(~0u, __builtin_amdgcn_mbcnt_lo(~0u, zop)); \
    const int gw = vbid * (NTHR / 64) + wave_s; \
    PAK pa = pak0; asm volatile("" : "+s"(pa)); P p; \
    p.x_prompt = pa->in[0]; p.x_sample = pa->in[1]; p.cache_a_k = pa->in[2]; p.cache_a_v = pa->in[3]; p.cache_d_k = pa->in[4]; p.cache_d_v = pa->in[5]; \
    p.c = pa->in[6]; p.c_ctx = pa->in[7]; p.mod_w = pa->in[8]; p.mod_b = pa->in[9]; p.norm_w = pa->in[10]; p.ffn_w1 = pa->in[11]; p.ffn_w2 = pa->in[12]; \
    p.ev_w_in = pa->in[13]; p.ev_rpb = pa->in[14]; p.ev_conv_w = pa->in[15]; p.ev_conv_b = pa->in[16]; p.ev_w_out = pa->in[17]; \
    p.od_w_in = pa->in[18]; p.od_pool_w = pa->in[19]; p.od_pool_scale = pa->in[20]; p.od_q_norm = pa->in[21]; p.od_k_norm = pa->in[22]; p.od_w_out = pa->in[23]; \
    p.out = pa->out; \
    { char* ws = pa->ws; \
      p.W1T = (u16*)(ws + WO_W1T); p.W2T = (u16*)(ws + WO_W2T); p.EVIN = (u16*)(ws + WO_EVIN); p.EVOUT = (u16*)(ws + WO_EVOUT); \
      p.ODIN = (u16*)(ws + WO_ODIN); p.ODOUT = (u16*)(ws + WO_ODOUT); p.POOLW = (u16*)(ws + WO_POOLW); \
      p.CAK = (u16*)(ws + WO_CAK); p.CAVT = (u16*)(ws + WO_CAVT); p.CDK = (u16*)(ws + WO_CDK); p.CDVT = (u16*)(ws + WO_CDVT); \
      p.H = (u16*)(ws + WO_H); p.ACTU = (u16*)(ws + WO_ACTU); p.VT = (u16*)(ws + WO_VT); \
      p.MOD = (float*)(ws + WO_MOD); p.X = (float*)(ws + WO_X); p.T = (float*)(ws + WO_T); p.BAR = (unsigned*)(ws + WO_BAR); p.KF = (u16*)(ws + WO_KF); p.XCH = (float*)(ws + WO_XCH); }
typedef const __attribute__((address_space(4))) PA* PAK;
__global__ void __launch_bounds__(NTHR, 2) mega(PA pa_unused, int ph0, int ph1) {
  __shared__ __attribute__((aligned(1024))) char smem[LDS_BYTES];
  __shared__ uint4 xb_words;
  const int wave_s = __builtin_amdgcn_readfirstlane((int)(threadIdx.x >> 6));
  cg::grid_group grid = cg::this_grid();
  if (ph1 == 0x7fffffff) grid.sync();
  if (threadIdx.x == 0) xb_words = make_uint4(0u, 0u, 0u, 0u);
  __syncthreads();
  const PAK pak0 = (PAK)__builtin_amdgcn_kernarg_segment_ptr();
  const XcdBarrier xb = xcd_barrier_post((unsigned*)(pak0->ws + WO_BAR), (volatile LAS unsigned*)&xb_words);
  const int G = gridDim.x, bid = blockIdx.x;
  const int vbid = (G & 7) ? bid : ((bid & 7) * (G >> 3) + (bid >> 3));
  const int W = G * (NTHR / 64);
#ifndef REPMASK
#define REPMASK 0u
#endif
  for (int ph = ph0; ph < ph1; ++ph) {
   const int nrep = ((REPMASK >> ph) & 1u) ? 2 : 1;
   for (int rep = 0; rep < nrep; ++rep) {
    if (rep) { GRID_SYNC(); }
    if (ph == 0) {
      LOADP();
      prep_phase(p, smem, bid, G, tidx);
    } else if (ph == 1) {
      LOADP();
      r_phase<0>(p, true, false, nullptr, nullptr, 0, 0.f, true, p.norm_w, p.MOD, 0, 1, p.X, gw, W, tidx);
    } else {
      const int q = ph - 2;
      const int l = q / 7, s = q % 7;
#define NWMOD() const float* nw = p.norm_w + l * 6 * DM; const float* modl = p.MOD + l * 3 * 9216
      switch (s) {
        case 0: case 5: { LOADP();
          const int f = s == 0 ? 0 : 1;
          const u16* w1 = p.W1T + (size_t)(l * 2 + f) * 5632 * 1024;
          gemm_phase<EPI_SWIGLU, 6>(p, p.H, w1, 1024, 64, 22, p.ACTU, DFF, smem, vbid, G, tidx, 1280);
          gemm_phase<EPI_SWIGLU, 3, true>(p, p.H, w1, 1024, 64, 22, p.ACTU, DFF, smem, vbid, G, tidx, 256, 1280);
        } break;
        case 1: case 4: case 6: { LOADP(); NWMOD();
          const u16* A_ = s == 4 ? p.H : p.ACTU;
          const u16* B_ = s == 4 ? (l == 0 ? p.EVOUT : p.ODOUT) : p.W2T + (size_t)(l * 2 + (s == 1 ? 0 : 1)) * 1024 * 2816;
          ResArgs ra;
          ra.gT = nw + (s == 1 ? 1 : (s == 4 ? 3 : 5)) * DM;
          ra.modg = modl; ra.gate = s == 1 ? 2 : (s == 4 ? 5 : 8); ra.gs = s == 4 ? 1.0f : 0.5f;
          ra.fin = (s == 6 && l == 1) ? 1 : 0;
          ra.g2 = s == 1 ? nw + 2 * DM : (s == 4 ? nw + 4 * DM : p.norm_w + 6 * DM);
          ra.modn = s == 6 ? p.MOD + 3 * 9216 : modl;
          ra.shi = s == 1 ? 3 : (s == 4 ? 6 : 0);
          ra.kuse = 3 * l + (s == 1 ? 0 : (s == 4 ? 1 : 2));
          gemm_phase<EPI_RES, 6>(p, A_, B_, s == 4 ? 1024 : DFF, 64, 4, nullptr, DM, smem, vbid, G, tidx, 1 << 30, 0, ra);
        } break;
        case 2: { LOADP();
          if (l == 0) gemm_phase<EPI_EVIN, 6>(p, p.H, p.EVIN, 1024, 64, 12, p.ACTU, 3072, smem, vbid, G, tidx);
          else {
            gemm_phase<EPI_ODIN, 6>(p, p.H, p.ODIN, 1024, 64, 5, p.ACTU, 1280, smem, vbid, G, tidx, 256);
            gemm_phase<EPI_ODIN, 3, true>(p, p.H, p.ODIN, 1024, 64, 5, p.ACTU, 1280, smem, vbid, G, tidx, 128, 256);
            GRID_SYNC();
            mix_odd_a(p, gw, W, tidx);
          }
        } break;
        case 3: { LOADP();
          if (l == 0) mix_even(p, gw, W, tidx);
          else {
            gemm_phase<EPI_POOL, 3>(p, (const u16*)p.T, p.POOLW, 512, 128, 2, p.H, DM, smem, vbid, G, tidx);
            mix_odd_b(p, gw, W, tidx, smem);
          }
        } break;
      }
    }
   }
    if (ph + 1 < ph1) { GRID_SYNC(); }
#ifdef EXTRA_SYNCS
    if (ph == 1) { for (int es = 0; es < EXTRA_SYNCS; ++es) { GRID_SYNC(); } }
#endif
  }
}

extern "C" void kernel_launch(void* const* d_in, const int* in_sizes, int n_in, void* d_out, int out_size,
                              void* d_ws, size_t ws_size, hipStream_t stream) {
  static int grid_blocks = 0;
  if (!grid_blocks) {
    int dev = 0, cus = 0, per_cu = 0;
    hipGetDevice(&dev);
    hipDeviceGetAttribute(&cus, hipDeviceAttributeMultiprocessorCount, dev);
    hipOccupancyMaxActiveBlocksPerMultiprocessor(&per_cu, mega, NTHR, 0);
    if (per_cu > 1) per_cu = 1;
    if (per_cu < 1) per_cu = 1;
    grid_blocks = cus * per_cu;
  }
  PA p{};
  for (int i = 0; i < 24; ++i) p.in[i] = (const float*)d_in[i];
  p.out = (float*)d_out;
  p.ws = (char*)d_ws;
  if (WO_END > ws_size) { fprintf(stderr, "workspace too small: need %zu have %zu\n", (size_t)WO_END, ws_size); return; }
  (void)hipMemsetAsync(p.ws + WO_BAR, 0, (size_t)(XCD_BAR_WORDS + 2048) * 4, stream);
  int ph0 = 0, ph1 = N_PHASES;
  void* args[] = { &p, &ph0, &ph1 };
  hipError_t e = hipLaunchCooperativeKernel((void*)mega, dim3(grid_blocks), dim3(NTHR), args, 0, stream);
  if (e != hipSuccess) fprintf(stderr, "cooperative launch failed: %s (grid %d)\n", hipGetErrorString(e), grid_blocks);
}
```

```cpp
#include <hip/hip_runtime.h>
#include <hip/hip_cooperative_groups.h>
#include <cstdio>
namespace cg = cooperative_groups;

typedef unsigned short u16;
using bf16x8 = __attribute__((ext_vector_type(8))) short;
using s16x4  = __attribute__((ext_vector_type(4))) short;
using f32x16 = __attribute__((ext_vector_type(16))) float;
#define DI __device__ __forceinline__
#define MFMA(a, b, c) __builtin_amdgcn_mfma_f32_32x32x16_bf16((a), (b), (c), 0, 0, 0)

constexpr int MTOK = 12288;
constexpr int MPR  = 8192;
constexpr int DM   = 1024;
constexpr int DFF  = 2816;
constexpr int NTHR = 512;
constexpr int LDS_BYTES = 131072;
constexpr int SROW = 72;

constexpr size_t OFF_SAK = 12582912, OFF_SAV = 16777216, OFF_SDK = 20971520, OFF_SDV = 22020096;

struct P {
  const float *x_prompt, *x_sample, *cache_a_k, *cache_a_v, *cache_d_k, *cache_d_v, *c, *c_ctx;
  const float *mod_w, *mod_b, *norm_w, *ffn_w1, *ffn_w2, *ev_w_in, *ev_rpb, *ev_conv_w, *ev_conv_b, *ev_w_out;
  const float *od_w_in, *od_pool_w, *od_pool_scale, *od_q_norm, *od_k_norm, *od_w_out;
  float* out;
  u16 *W1T, *W2T, *EVIN, *EVOUT, *ODIN, *ODOUT, *POOLW, *CAK, *CAVT, *CDK, *CDVT, *H, *ACTU, *VT, *KF;
  float *MOD, *X, *T;
  unsigned* BAR;
  float* XCH;
};
struct PA {
  const float* in[24];
  float* out;
  char* ws;
};
constexpr size_t al256(size_t b) { return (b + 255) & ~(size_t)255; }
constexpr size_t WO_W1T = 0;
constexpr size_t WO_W2T = WO_W1T + al256((size_t)4 * 5632 * 1024 * 2);
constexpr size_t WO_EVIN = WO_W2T + al256((size_t)4 * 1024 * 2816 * 2);
constexpr size_t WO_EVOUT = WO_EVIN + al256((size_t)3072 * 1024 * 2);
constexpr size_t WO_ODIN = WO_EVOUT + al256((size_t)1024 * 1024 * 2);
constexpr size_t WO_ODOUT = WO_ODIN + al256((size_t)1280 * 1024 * 2);
constexpr size_t WO_POOLW = WO_ODOUT + al256((size_t)1024 * 1024 * 2);
constexpr size_t WO_CAK = WO_POOLW + al256((size_t)512 * 512 * 2);
constexpr size_t WO_CAVT = WO_CAK + al256((size_t)262144 * 2);
constexpr size_t WO_CDK = WO_CAVT + al256((size_t)262144 * 2);
constexpr size_t WO_CDVT = WO_CDK + al256((size_t)65536 * 2);
constexpr size_t WO_H = WO_CDVT + al256((size_t)65536 * 2);
constexpr size_t WO_ACTU = WO_H + al256((size_t)12288 * 1024 * 2);
constexpr size_t WO_VT = WO_ACTU + al256((size_t)12288 * 3072 * 2);
constexpr size_t WO_MOD = WO_VT + al256((size_t)512 * 12288 * 2);
constexpr size_t WO_X = WO_MOD + al256((size_t)2 * 3 * 9216 * 4);
constexpr size_t WO_T = WO_X + al256((size_t)12288 * 1024 * 4);
constexpr size_t WO_BAR = WO_T + al256((size_t)12288 * 1024 * 4);
constexpr size_t WO_KF = WO_BAR + al256((size_t)(3456 + 2048) * 4);
constexpr size_t WO_XCH = WO_KF + al256((size_t)512 * 12288 * 2);
constexpr size_t WO_END = WO_XCH + al256((size_t)2 * 12288 * 4 * 4);

DI u16 f2bf(float x) { unsigned u = __float_as_uint(x); u += 0x7fffu + ((u >> 16) & 1u); return (u16)(u >> 16); }
DI float bf2f(u16 v) { return __uint_as_float(((unsigned)v) << 16); }
DI unsigned pack2(float a, float b) { unsigned r; asm("v_cvt_pk_bf16_f32 %0, %1, %2" : "=v"(r) : "v"(a), "v"(b)); return r; }
DI float row16_sum(float v) {
  v += __builtin_bit_cast(float, __builtin_amdgcn_update_dpp(0, __builtin_bit_cast(int, v), 0xB1, 0xF, 0xF, true));
  v += __builtin_bit_cast(float, __builtin_amdgcn_update_dpp(0, __builtin_bit_cast(int, v), 0x4E, 0xF, 0xF, true));
  v += __builtin_bit_cast(float, __builtin_amdgcn_update_dpp(0, __builtin_bit_cast(int, v), 0x141, 0xF, 0xF, true));
  v += __builtin_bit_cast(float, __builtin_amdgcn_update_dpp(0, __builtin_bit_cast(int, v), 0x140, 0xF, 0xF, true));
  return v;
}
DI float xor32_max(float v) { float a = v, b = v; asm volatile("s_nop 1\n\tv_permlane32_swap_b32 %0, %1" : "+v"(a), "+v"(b)); return fmaxf(a, b); }
DI float xor32_sum(float v) { float a = v, b = v; asm volatile("s_nop 1\n\tv_permlane32_swap_b32 %0, %1" : "+v"(a), "+v"(b)); return a + b; }
DI float xor16_sum(float v) { float a = v, b = v; asm volatile("s_nop 1\n\tv_permlane16_swap_b32 %0, %1" : "+v"(a), "+v"(b)); return a + b; }
DI float wave_sum(float v) {
#pragma unroll
  for (int o = 32; o > 0; o >>= 1) v += __shfl_xor(v, o);
  return v;
}
DI float wave_sum_dpp(float v) {
  return xor32_sum(xor16_sum(row16_sum(v)));
}
DI float bflo(unsigned u) { return __uint_as_float(u << 16); }
DI float bfhi(unsigned u) { return __uint_as_float(u & 0xffff0000u); }

__device__ void mod_item(const P& p, int it, char* smem, int tidx) {
  float* sS = (float*)smem;
  float* red = sS + 3072;
  const int tid = tidx;
  const int l = it / 144, n0 = (it % 144) * 64;
  for (int i = tid; i < 3072; i += 256) {
    int r = i >> 10, k = i & 1023;
    float v = r == 0 ? p.c_ctx[k] : p.c[(r - 1) * 1024 + k];
    sS[i] = v / (1.f + expf(-v));
  }
  __syncthreads();
  const int kq = tid >> 4, cq = tid & 15;
  const float* w = p.mod_w + (size_t)l * 1024 * 9216 + (size_t)(kq * 64) * 9216 + n0 + cq * 4;
  float a00 = 0, a01 = 0, a02 = 0, a03 = 0, a10 = 0, a11 = 0, a12 = 0, a13 = 0, a20 = 0, a21 = 0, a22 = 0, a23 = 0;
#pragma unroll 1
  for (int k0 = 0; k0 < 64; k0 += 8) {
    float4 wv[8];
#pragma unroll
    for (int k = 0; k < 8; ++k) wv[k] = *(const float4*)(w + (size_t)(k0 + k) * 9216);
#pragma unroll
    for (int k = 0; k < 8; ++k) {
      float4 w4 = wv[k];
      float s0 = sS[kq * 64 + k0 + k], s1 = sS[1024 + kq * 64 + k0 + k], s2 = sS[2048 + kq * 64 + k0 + k];
      a00 += s0 * w4.x; a01 += s0 * w4.y; a02 += s0 * w4.z; a03 += s0 * w4.w;
      a10 += s1 * w4.x; a11 += s1 * w4.y; a12 += s1 * w4.z; a13 += s1 * w4.w;
      a20 += s2 * w4.x; a21 += s2 * w4.y; a22 += s2 * w4.z; a23 += s2 * w4.w;
    }
  }
  float* r0 = red + (kq * 3 + 0) * 64 + cq * 4;
  r0[0] = a00; r0[1] = a01; r0[2] = a02; r0[3] = a03;
  r0[64] = a10; r0[65] = a11; r0[66] = a12; r0[67] = a13;
  r0[128] = a20; r0[129] = a21; r0[130] = a22; r0[131] = a23;
  __syncthreads();
  if (tid < 192) {
    int r = tid >> 6, n = tid & 63;
    float s = p.mod_b[l * 9216 + n0 + n];
#pragma unroll
    for (int q = 0; q < 16; ++q) s += red[(q * 3 + r) * 64 + n];
    p.MOD[(l * 3 + r) * 9216 + n0 + n] = s;
  }
  __syncthreads();
}

struct TrItem { const float* src; u16* dst; int N, Kd, k0, n0, perm; };
DI TrItem tr_decode(const P& p, int idx) {
  TrItem t; t.perm = 0; int kt, nt;
  if (idx < 2816) { int mat = idx / 704, r = idx % 704; kt = r / 44; nt = r % 44; t.src = p.ffn_w1 + (size_t)mat * 1024 * 5632; t.N = 5632; t.Kd = 1024; t.dst = p.W1T + (size_t)mat * 5632 * 1024; t.perm = 1; }
  else if (idx < 4224) { int r0 = idx - 2816; int mat = r0 / 352, r = r0 % 352; kt = r / 8; nt = r % 8; t.src = p.ffn_w2 + (size_t)mat * 2816 * 1024; t.N = 1024; t.Kd = 2816; t.dst = p.W2T + (size_t)mat * 1024 * 2816; }
  else if (idx < 4608) { int r = idx - 4224; kt = r / 24; nt = r % 24; t.src = p.ev_w_in; t.N = 3072; t.Kd = 1024; t.dst = p.EVIN; }
  else if (idx < 4736) { int r = idx - 4608; kt = r / 8; nt = r % 8; t.src = p.ev_w_out; t.N = 1024; t.Kd = 1024; t.dst = p.EVOUT; }
  else if (idx < 4896) { int r = idx - 4736; kt = r / 10; nt = r % 10; t.src = p.od_w_in; t.N = 1280; t.Kd = 1024; t.dst = p.ODIN; }
  else if (idx < 5024) { int r = idx - 4896; kt = r / 8; nt = r % 8; t.src = p.od_w_out; t.N = 1024; t.Kd = 1024; t.dst = p.ODOUT; }
  else { int r = idx - 5024; int mat = r >> 1; kt = r & 1; nt = 0; t.src = p.od_pool_w + mat * 16384; t.N = 128; t.Kd = 512; t.dst = p.POOLW + (size_t)(mat * 128) * 512 + mat * 128; }
  t.k0 = kt * 64; t.n0 = nt * 128;
  return t;
}

__device__ void prep_phase(const P& p, char* smem_all, int bid, int G, int tid512) {
  constexpr int N_MOD = 288, N_TR = 5032, N_CC = 448;
  const int half = tid512 >> 8, tid = tid512 & 255;
  char* smem = smem_all + half * 36864;
  for (int pi = bid; pi < N_MOD / 2; pi += G) mod_item(p, 2 * pi + half, smem, tid);
  {
    float* tl = (float*)smem;
    const int r = tid >> 5, c4 = (tid & 31) * 4;
    float4 v[8];
    int tp = bid;
    TrItem cur{};
    if (tp < N_TR / 2) {
      cur = tr_decode(p, 2 * tp + half);
      const float* sp = cur.src + (size_t)(cur.k0 + r) * cur.N + cur.n0 + c4;
#pragma unroll
      for (int q = 0; q < 8; ++q) v[q] = *(const float4*)(sp + (size_t)(8 * q) * cur.N);
    }
    for (; tp < N_TR / 2; tp += G) {
      float* tpp = tl + r * 129 + c4;
#pragma unroll
      for (int q = 0; q < 8; ++q) { tpp[q * 8 * 129] = v[q].x; tpp[q * 8 * 129 + 1] = v[q].y; tpp[q * 8 * 129 + 2] = v[q].z; tpp[q * 8 * 129 + 3] = v[q].w; }
      __syncthreads();
      const TrItem me = cur;
      if (tp + G < N_TR / 2) {
        cur = tr_decode(p, 2 * (tp + G) + half);
        const float* sp = cur.src + (size_t)(cur.k0 + r) * cur.N + cur.n0 + c4;
#pragma unroll
        for (int q = 0; q < 8; ++q) v[q] = *(const float4*)(sp + (size_t)(8 * q) * cur.N);
      }
#pragma unroll
      for (int q = 0; q < 4; ++q) {
        int nn = (tid >> 3) + 32 * q, kc = tid & 7;
        int n = me.n0 + nn, nd = n;
        if (me.perm) nd = n < DFF ? ((n >> 5) * 64 + (n & 31)) : ((((n - DFF) >> 5) * 64) + 32 + ((n - DFF) & 31));
        const float* t = tl + (kc * 8) * 129 + nn;
        uint4 o;
        o.x = pack2(t[0], t[129]); o.y = pack2(t[258], t[387]); o.z = pack2(t[516], t[645]); o.w = pack2(t[774], t[903]);
        *(uint4*)(me.dst + (size_t)nd * me.Kd + me.k0 + kc * 8) = o;
      }
      __syncthreads();
    }
  }
  for (int pi = bid; pi < N_CC / 2; pi += G) {
    const int idx = 2 * pi + half;
    {
      int e0 = idx * 2048 + tid * 8;
#pragma unroll 8
      for (int j = 0; j < 8; ++j) {
        int e = e0 + j;
        if (e < 589824 && (e < 262144 || e >= 524288)) {
          const bool isA = e < 262144; const int q = isA ? e : e - 524288;
          const int x = q & 7, ln = (q >> 3) & 63, sub = (q >> 9) & 3, T = (q >> 11) & 7, bh = q >> 14;
          const int key = T * 32 + (ln & 31), d = sub * 16 + (ln >> 5) * 8 + x;
          const float v = (isA ? p.cache_a_k : p.cache_d_k)[(bh * 256 + key) * 64 + d];
          (isA ? p.CAK : p.CDK)[q] = f2bf(v);
        } else if (e < 655360) {
          const bool isA = e < 524288; const int q = isA ? e - 262144 : e - 589824;
          const int x = q & 7, ln = (q >> 3) & 63, sub = (q >> 9) & 3, T = (q >> 11) & 7, bh = q >> 14;
          const int dim = (sub >> 1) * 32 + (ln & 31), key = T * 32 + 16 * (sub & 1) + 8 * (x >> 2) + 4 * (ln >> 5) + (x & 3);
          const float v = (isA ? p.cache_a_v : p.cache_d_v)[(bh * 256 + key) * 64 + dim];
          (isA ? p.CAVT : p.CDVT)[q] = f2bf(v);
        }
        else { int q = e - 655360; int n = q >> 9, k = q & 511; if ((n >> 7) != (k >> 7)) p.POOLW[q] = 0; }
      }
    }
  }
}

template <int RMODE>
__device__ void r_phase(const P& p, bool first_unused, bool hasT_unused, const float* gT, const float* modg, int gate_idx, float gscale,
                        bool writeH, const float* g2, const float* modn, int shift_idx, int scale_idx, float* xdst, int gw, int W, int tidx) {
  const int lane = tidx & 63;
  constexpr bool first = RMODE == 0, hasT = RMODE != 0;
  constexpr int NR = 6;
  for (int t0 = gw; t0 < MTOK; t0 += NR * W) {
    float4 xf[NR][4];
    uint2 xq[NR][4], tq[NR][4];
#pragma unroll
    for (int r = 0; r < NR; ++r) {
      const int t = t0 + r * W;
      if (t < MTOK) {
        if (first) {
          const float* xs = t < MPR ? p.x_prompt + (size_t)t * DM : p.x_sample + (size_t)(t - MPR) * DM;
#pragma unroll
          for (int j = 0; j < 4; ++j) xf[r][j] = *(const float4*)(xs + lane * 4 + 256 * j);
        } else {
          const u16* xs = (const u16*)p.X + (size_t)t * DM;
          const u16* ts = (const u16*)p.T + (size_t)t * DM;
#pragma unroll
          for (int j = 0; j < 4; ++j) { xq[r][j] = *(const uint2*)(xs + lane * 4 + 256 * j); tq[r][j] = *(const uint2*)(ts + lane * 4 + 256 * j); }
        }
      }
    }
#pragma unroll
    for (int r = 0; r < NR; ++r) {
      const int t = t0 + r * W;
      if (t < MTOK) {
        const int ci = t < MPR ? 0 : 1 + ((t - MPR) >> 11);
        float4 x[4];
        if (first) {
#pragma unroll
          for (int j = 0; j < 4; ++j) x[j] = xf[r][j];
        } else {
#pragma unroll
          for (int j = 0; j < 4; ++j) x[j] = make_float4(bflo(xq[r][j].x), bfhi(xq[r][j].x), bflo(xq[r][j].y), bfhi(xq[r][j].y));
        }
        if (hasT) {
          float4 tv[4];
          float ss = 0.f;
#pragma unroll
          for (int j = 0; j < 4; ++j) {
            tv[j] = make_float4(bflo(tq[r][j].x), bfhi(tq[r][j].x), bflo(tq[r][j].y), bfhi(tq[r][j].y));
            ss += tv[j].x * tv[j].x + tv[j].y * tv[j].y + tv[j].z * tv[j].z + tv[j].w * tv[j].w;
          }
          ss = wave_sum(ss);
          const float rs = rsqrtf(ss * (1.f / 1024.f) + 1e-6f) * gscale;
          const float* mg = modg + ci * 9216 + gate_idx * 1024;
#pragma unroll
          for (int j = 0; j < 4; ++j) {
            int c = lane * 4 + 256 * j;
            float4 g4 = *(const float4*)(gT + c), m4 = *(const float4*)(mg + c);
            x[j].x += m4.x * (tv[j].x * rs * g4.x); x[j].y += m4.y * (tv[j].y * rs * g4.y);
            x[j].z += m4.z * (tv[j].z * rs * g4.z); x[j].w += m4.w * (tv[j].w * rs * g4.w);
          }
        }
        if (RMODE == 2) {
#pragma unroll
          for (int j = 0; j < 4; ++j) *(float4*)(xdst + (size_t)t * DM + lane * 4 + 256 * j) = x[j];
        } else {
#pragma unroll
          for (int j = 0; j < 4; ++j) {
            uint2 o; o.x = pack2(x[j].x, x[j].y); o.y = pack2(x[j].z, x[j].w);
            *(uint2*)((u16*)xdst + (size_t)t * DM + lane * 4 + 256 * j) = o;
          }
          float ss = 0.f;
#pragma unroll
          for (int j = 0; j < 4; ++j) ss += x[j].x * x[j].x + x[j].y * x[j].y + x[j].z * x[j].z + x[j].w * x[j].w;
          ss = wave_sum(ss);
          const float r2 = rsqrtf(ss * (1.f / 1024.f) + 1e-6f);
          const float* sh = modn + ci * 9216 + shift_idx * 1024;
          const float* sc = modn + ci * 9216 + scale_idx * 1024;
#pragma unroll
          for (int j = 0; j < 4; ++j) {
            int c = lane * 4 + 256 * j;
            float4 g4 = *(const float4*)(g2 + c), s4 = *(const float4*)(sc + c), h4 = *(const float4*)(sh + c);
            float h0 = x[j].x * r2 * g4.x * (1.f + s4.x) + h4.x;
            float h1 = x[j].y * r2 * g4.y * (1.f + s4.y) + h4.y;
            float h2 = x[j].z * r2 * g4.z * (1.f + s4.z) + h4.z;
            float h3 = x[j].w * r2 * g4.w * (1.f + s4.w) + h4.w;
            uint2 o; o.x = pack2(h0, h1); o.y = pack2(h2, h3);
            *(uint2*)(p.H + (size_t)t * DM + c) = o;
          }
        }
      }
    }
  }
}

enum { EPI_SWIGLU = 0, EPI_F32 = 1, EPI_EVIN = 2, EPI_ODIN = 3, EPI_POOL = 4, EPI_RES = 5 };
struct ResArgs { const float* gT; const float* modg; const float* g2; const float* modn; int gate; int shi; float gs; int kuse; int fin; };
using f32x4 = __attribute__((ext_vector_type(4))) float;

DI int lds_byte2(int r, int c) {
  int st = (r >> 4) * 2 + (c >> 5), ob = (r & 15) * 64 + (c & 31) * 2;
  return st * 1024 + (ob ^ (((ob >> 9) & 1) << 5));
}
DI void stage_rc2(int b, int& R, int& C) {
  int st = b >> 10, sb = b & 1023, swz = sb ^ (((sb >> 9) & 1) << 5);
  R = (st >> 1) * 16 + (swz >> 6);
  C = (st & 1) * 32 + ((swz & 63) >> 1);
}
#define WAIT_V0() asm volatile("s_waitcnt vmcnt(0)" ::: "memory")

#define LDS_RD4(a, b, c, d, addr, o0, o1, o2, o3) asm volatile( \
    "ds_read_b128 %0, %4 offset:%5\n\tds_read_b128 %1, %4 offset:%6\n\tds_read_b128 %2, %4 offset:%7\n\tds_read_b128 %3, %4 offset:%8\n\ts_waitcnt lgkmcnt(0)" \
    : "=&v"(a), "=&v"(b), "=&v"(c), "=&v"(d) : "v"(addr), "n"(o0), "n"(o1), "n"(o2), "n"(o3) : "memory")
template <int EPI, int MF, bool TAIL = false>
__device__ __forceinline__ void gemm_phase(const P& p, const u16* __restrict__ A, const u16* __restrict__ Bt, int K,
                                           int nMT, int nNT, void* outp, int ldc, char* smem, int vbid, int G, int tidx, int tlimit = 1 << 30, int tbase = 0, ResArgs ra = ResArgs{}) {
  constexpr int TILE_B = 32768, STAGE_B = 65536;
  const int wid = __builtin_amdgcn_readfirstlane(tidx >> 6), lane = tidx & 63, wr = wid >> 2, wc = wid & 3, fr = lane & 15, fq = lane >> 4;
  int sOff0;
  { int R, C; stage_rc2(wid * 1024 + lane * 16, R, C); sOff0 = R * K + C; }
  const unsigned sOffB = (unsigned)sOff0 * 2u;
  const int aOff0 = lds_byte2(wr * (16 * MF) + fr, fq * 8);
  const int bOff0 = lds_byte2(wc * 64 + fr, fq * 8);
  const int ntiles = TAIL ? tlimit : min(nMT * nNT, tlimit), nt = K >> 6;
#define GLDS_STAGE(AB, BB, buf, kt) do { _Pragma("unroll") for (int i = 0; i < 4; ++i) { \
      if (wid + 8 * i < 4 * MF) __builtin_amdgcn_global_load_lds((const unsigned*)((const char*)((AB) + (size_t)(i * 64) * K + (kt) * 64) + sOffCur), (unsigned*)(smem + (buf) * STAGE_B + wid * 1024 + i * 8192), 16, 0, 0); \
      __builtin_amdgcn_global_load_lds((const unsigned*)((const char*)((BB) + (size_t)(i * 64) * K + (kt) * 64) + sOffCur), (unsigned*)(smem + (buf) * STAGE_B + TILE_B + wid * 1024 + i * 8192), 16, 0, 0); } } while (0)
#define TILE_COORDS(T, BR, BC) do { const int ts_ = TAIL ? tbase + ((T) >> 1) : (T); \
      const int grp_ = ts_ / (8 * nNT), r2_ = ts_ - grp_ * 8 * nNT; \
      BR = (grp_ * 8 + (r2_ & 7)) * (TAIL ? 192 : 32 * MF) + (TAIL ? ((T) & 1) * 96 : 0); BC = (r2_ >> 3) * 256; } while (0)
  if (vbid < ntiles) {
    unsigned sOffCur = sOffB; asm volatile("" : "+v"(sOffCur));
    int br_, bc_; TILE_COORDS(vbid, br_, bc_);
    GLDS_STAGE(A + (size_t)br_ * K, Bt + (size_t)bc_ * K, 0, 0);
  }
  for (int tile = vbid; tile < ntiles; tile += G) {
    int brow, bcol; TILE_COORDS(tile, brow, bcol);
    unsigned sOffCur = sOffB; asm volatile("" : "+v"(sOffCur));
    const u16* Ab = A + (size_t)brow * K;
    const u16* Bb = Bt + (size_t)bcol * K;
    f32x4 acc[MF][4];
#pragma unroll
    for (int m = 0; m < MF; ++m)
#pragma unroll
      for (int n = 0; n < 4; ++n) { acc[m][n][0] = 0.f; acc[m][n][1] = 0.f; acc[m][n][2] = 0.f; acc[m][n][3] = 0.f; }
#define LDS_RD(dst, base, off) asm volatile("ds_read_b128 %0, %1 offset:%2" : "=v"(dst) : "v"(base), "n"(off))
    bf16x8 A0[MF], B0[4], A1[MF], B1[4];
    const unsigned lbase = (unsigned)(size_t)(smem);
    WAIT_V0(); __syncthreads();
    if (nt > 1) GLDS_STAGE(Ab, Bb, 1, 1);
    asm volatile("s_waitcnt lgkmcnt(0)" ::: "memory");
    {
      const unsigned la = lbase + aOff0, lb = lbase + TILE_B + bOff0;
#pragma unroll
      for (int n = 0; n < 4; ++n) LDS_RD(B0[n], lb, n * 2048);
#pragma unroll
      for (int m = 0; m < MF; ++m) LDS_RD(A0[m], la, m * 2048);
    }
    for (int t = 0; t < nt; ++t) {
      const int cur = t & 1;
      const unsigned la = lbase + cur * STAGE_B + aOff0, lb = lbase + cur * STAGE_B + TILE_B + bOff0;
      const unsigned lan = lbase + (cur ^ 1) * STAGE_B + aOff0, lbn = lbase + (cur ^ 1) * STAGE_B + TILE_B + bOff0;
#pragma unroll
      for (int n = 0; n < 4; ++n) LDS_RD(B1[n], lb, n * 2048 + 1024);
#pragma unroll
      for (int m = 0; m < MF; ++m) LDS_RD(A1[m], la, m * 2048 + 1024);
      __builtin_amdgcn_sched_barrier(0);
#pragma unroll
      for (int m = 0; m < MF; ++m) {
        if (m == 0) asm volatile("s_waitcnt lgkmcnt(%5)" : "+v"(A0[0]), "+v"(B0[0]), "+v"(B0[1]), "+v"(B0[2]), "+v"(B0[3]) : "n"(4 + MF + MF - 1));
        else asm volatile("s_waitcnt lgkmcnt(%1)" : "+v"(A0[m]) : "n"(4 + MF + MF - 1 - m));
#pragma unroll
        for (int n = 0; n < 4; ++n) acc[m][n] = __builtin_amdgcn_mfma_f32_16x16x32_bf16(A0[m], B0[n], acc[m][n], 0, 0, 0);
        __builtin_amdgcn_sched_barrier(0);
      }
      if (MF == 3) asm volatile("s_waitcnt lgkmcnt(0)" : "+v"(A1[0]), "+v"(A1[1]), "+v"(A1[MF - 1]), "+v"(B1[0]), "+v"(B1[1]), "+v"(B1[2]), "+v"(B1[3]));
      else if (MF == 6) asm volatile("s_waitcnt lgkmcnt(0)" : "+v"(A1[0]), "+v"(A1[1]), "+v"(A1[2]), "+v"(A1[3]), "+v"(A1[4]), "+v"(A1[MF - 1]), "+v"(B1[0]), "+v"(B1[1]), "+v"(B1[2]), "+v"(B1[3]));
      else asm volatile("s_waitcnt lgkmcnt(0)" : "+v"(A1[0]), "+v"(A1[1]), "+v"(A1[2]), "+v"(A1[3]), "+v"(A1[4]), "+v"(A1[5]), "+v"(A1[MF - 2]), "+v"(A1[MF - 1]), "+v"(B1[0]), "+v"(B1[1]), "+v"(B1[2]), "+v"(B1[3]));
      WAIT_V0(); __syncthreads();
      if (t + 2 < nt) { GLDS_STAGE(Ab, Bb, cur, t + 2); }
      else if (t + 1 == nt && tile + G < ntiles) {
        int br_, bc_; TILE_COORDS(tile + G, br_, bc_);
        GLDS_STAGE(A + (size_t)br_ * K, Bt + (size_t)bc_ * K, 0, 0);
      }
      if (t + 1 < nt) {
#pragma unroll
        for (int n = 0; n < 4; ++n) LDS_RD(B0[n], lbn, n * 2048);
#pragma unroll
        for (int m = 0; m < MF; ++m) LDS_RD(A0[m], lan, m * 2048);
      }
      __builtin_amdgcn_sched_barrier(0);
#pragma unroll
      for (int m = 0; m < MF; ++m) {
#pragma unroll
        for (int n = 0; n < 4; ++n) acc[m][n] = __builtin_amdgcn_mfma_f32_16x16x32_bf16(A1[m], B1[n], acc[m][n], 0, 0, 0);
      }
      __builtin_amdgcn_sched_barrier(0);
    }
#undef LDS_RD
    unsigned zl_ = 0u; asm volatile("" : "+v"(zl_));
    const int le = (int)__builtin_amdgcn_mbcnt_hi(~0u, __builtin_amdgcn_mbcnt_lo(~0u, zl_));
    const int fre = le & 15, fqe = le >> 4;
    float* Ew = (float*)(smem + STAGE_B + wid * 4352);
    const int r0 = brow + wr * (16 * MF), c0 = bcol + wc * 64;
    if (EPI == EPI_RES) {
      const int te = wid * 64 + le;
      float* rp = (float*)(smem + STAGE_B + 8 * 4352);
      float* rstat = rp + 192 * 4;
      const int mt = brow / 192, ntl = bcol >> 8;
      unsigned* flag = p.BAR + 3456 + mt * 32;
      const unsigned target = 4u * (unsigned)(ra.kuse + 1);
      float* xch0 = p.XCH + (size_t)brow * 4;
      float* xch1 = p.XCH + (size_t)(12288 + brow) * 4;
#define XCH_ST(ptr, v) __hip_atomic_store((ptr), (v), __ATOMIC_RELAXED, __HIP_MEMORY_SCOPE_AGENT)
#define XCH_LD(ptr) __hip_atomic_load((ptr), __ATOMIC_RELAXED, __HIP_MEMORY_SCOPE_AGENT)
#define ROW_EXCHANGE(FL) do { \
        asm volatile("s_waitcnt vmcnt(0)" ::: "memory"); \
        __syncthreads(); \
        if (te == 0) { \
          (void)__hip_atomic_fetch_add((FL), 1u, __ATOMIC_RELAXED, __HIP_MEMORY_SCOPE_AGENT); \
          unsigned sp_ = 0; \
          while (__hip_atomic_load((FL), __ATOMIC_RELAXED, __HIP_MEMORY_SCOPE_AGENT) < target) { __builtin_amdgcn_s_sleep(1); if (++sp_ > (1u << 22)) break; } \
        } \
        __syncthreads(); } while (0)
      const int c4 = (le & 15) * 4;
      u16* X16 = (u16*)p.X;
      uint2 xpre[MF][4];
      float4 mgpre[MF];
#pragma unroll
      for (int m = 0; m < MF; ++m) {
        const int rm = r0 + m * 16;
        const int ci = rm < MPR ? 0 : 1 + ((rm - MPR) >> 11);
        mgpre[m] = *(const float4*)(ra.modg + ci * 9216 + ra.gate * 1024 + c0 + c4);
#pragma unroll
        for (int ps = 0; ps < 4; ++ps)
          xpre[m][ps] = *(const uint2*)(X16 + (size_t)(brow + wr * 96 + m * 16 + (le >> 4) + 4 * ps) * DM + c0 + c4);
      }
#pragma unroll
      for (int m = 0; m < MF; ++m)
#pragma unroll
        for (int j = 0; j < 4; ++j) {
          float s = acc[m][0][j] * acc[m][0][j] + acc[m][1][j] * acc[m][1][j] + acc[m][2][j] * acc[m][2][j] + acc[m][3][j] * acc[m][3][j];
          s = row16_sum(s);
          if (fre == 0) rp[(wr * 96 + m * 16 + fqe * 4 + j) * 4 + wc] = s;
        }
      __syncthreads();
      if (te < 192) XCH_ST(xch0 + te * 4 + ntl, rp[te * 4] + rp[te * 4 + 1] + rp[te * 4 + 2] + rp[te * 4 + 3]);
      ROW_EXCHANGE(flag);
      if (te < 192) { const float qs = XCH_LD(xch0 + te * 4) + XCH_LD(xch0 + te * 4 + 1) + XCH_LD(xch0 + te * 4 + 2) + XCH_LD(xch0 + te * 4 + 3); rstat[te] = rsqrtf(qs * (1.f / 1024.f) + 1e-6f) * ra.gs; }
      __syncthreads();
      const float4 gT4 = *(const float4*)(ra.gT + c0 + c4);
      float4 xn[MF][4];
#pragma unroll
      for (int m = 0; m < MF; ++m) {
        const int rm = r0 + m * 16;
        const int ci = rm < MPR ? 0 : 1 + ((rm - MPR) >> 11);
        const float4 mg4 = mgpre[m];
#pragma unroll
        for (int n = 0; n < 4; ++n)
#pragma unroll
          for (int j = 0; j < 4; ++j) Ew[(fqe * 4 + j) * 68 + n * 16 + fre] = acc[m][n][j];
        f32x4 q0, q1, q2, q3;
        LDS_RD4(q0, q1, q2, q3, (unsigned)(size_t)(Ew + (le >> 4) * 68 + c4), 0, 1088, 2176, 3264);
#pragma unroll
        for (int ps = 0; ps < 4; ++ps) {
          const f32x4 qv = ps == 0 ? q0 : (ps == 1 ? q1 : (ps == 2 ? q2 : q3));
          const int rl = wr * 96 + m * 16 + (le >> 4) + 4 * ps;
          const size_t ro = (size_t)(brow + rl) * DM + c0 + c4;
          const float rs = rstat[rl];
          const uint2 xq = xpre[m][ps];
          float4 y;
          y.x = bflo(xq.x) + mg4.x * (qv[0] * rs * gT4.x); y.y = bfhi(xq.x) + mg4.y * (qv[1] * rs * gT4.y);
          y.z = bflo(xq.y) + mg4.z * (qv[2] * rs * gT4.z); y.w = bfhi(xq.y) + mg4.w * (qv[3] * rs * gT4.w);
          xn[m][ps] = y;
          if (ra.fin) { *(float4*)(p.out + ro) = y; }
          else {
            uint2 o; o.x = pack2(y.x, y.y); o.y = pack2(y.z, y.w);
            *(uint2*)(X16 + ro) = o;
            float s = y.x * y.x + y.y * y.y + y.z * y.z + y.w * y.w;
            s = row16_sum(s);
            if ((le & 15) == 0) rp[rl * 4 + wc] = s;
          }
        }
      }
      float4 shpre[MF], scpre[MF];
      float4 g24 = make_float4(0.f, 0.f, 0.f, 0.f);
      if (!ra.fin) {
        g24 = *(const float4*)(ra.g2 + c0 + c4);
#pragma unroll
        for (int m = 0; m < MF; ++m) {
          const int rm = r0 + m * 16;
          const int ci = rm < MPR ? 0 : 1 + ((rm - MPR) >> 11);
          shpre[m] = *(const float4*)(ra.modn + ci * 9216 + ra.shi * 1024 + c0 + c4);
          scpre[m] = *(const float4*)(ra.modn + ci * 9216 + (ra.shi + 1) * 1024 + c0 + c4);
        }
      }
      if (!ra.fin) {
        __syncthreads();
        if (te < 192) XCH_ST(xch1 + te * 4 + ntl, rp[te * 4] + rp[te * 4 + 1] + rp[te * 4 + 2] + rp[te * 4 + 3]);
        ROW_EXCHANGE(flag + 16);
        if (te < 192) { const float qs = XCH_LD(xch1 + te * 4) + XCH_LD(xch1 + te * 4 + 1) + XCH_LD(xch1 + te * 4 + 2) + XCH_LD(xch1 + te * 4 + 3); rstat[te] = rsqrtf(qs * (1.f / 1024.f) + 1e-6f); }
        __syncthreads();
#pragma unroll
        for (int m = 0; m < MF; ++m) {
          const float4 sh4 = shpre[m], sc4 = scpre[m];
#pragma unroll
          for (int ps = 0; ps < 4; ++ps) {
            const int rl = wr * 96 + m * 16 + (le >> 4) + 4 * ps;
            const float r2 = rstat[rl];
            const float4 y = xn[m][ps];
            uint2 o;
            o.x = pack2(y.x * r2 * g24.x * (1.f + sc4.x) + sh4.x, y.y * r2 * g24.y * (1.f + sc4.y) + sh4.y);
            o.y = pack2(y.z * r2 * g24.z * (1.f + sc4.z) + sh4.z, y.w * r2 * g24.w * (1.f + sc4.w) + sh4.w);
            *(uint2*)(p.H + (size_t)(brow + rl) * DM + c0 + c4) = o;
          }
        }
      }
#undef ROW_EXCHANGE
#undef XCH_ST
#undef XCH_LD
      continue;
    }
    constexpr int vlo = (EPI == EPI_EVIN) ? 1024 : 1152, vhi = (EPI == EPI_EVIN) ? 1536 : 1280;
    const bool isV = (EPI == EPI_EVIN || EPI == EPI_ODIN) && c0 >= vlo && c0 < vhi;
    float* sbase = nullptr; int hd = 0, nh = 8;
    if (EPI == EPI_EVIN) {
      if (c0 >= 512 && c0 < 1024) { sbase = p.out + OFF_SAK; hd = (c0 - 512) >> 6; }
      else if (c0 >= 1024 && c0 < 1536) { sbase = p.out + OFF_SAV; hd = (c0 - 1024) >> 6; }
    } else if (EPI == EPI_ODIN) {
      nh = 2;
      if (c0 >= 1152 && c0 < 1280) { sbase = p.out + OFF_SDV; hd = (c0 - 1152) >> 6; }
    }
    const int c4 = (le & 15) * 4;
    float4 psc = make_float4(1.f, 1.f, 1.f, 1.f);
    if (EPI == EPI_POOL) psc = *(const float4*)(p.od_pool_scale + c0 + c4);
    constexpr int ESZ = 2;
    char* orow = (EPI == EPI_SWIGLU)
        ? (char*)outp + ((size_t)(r0 + (le >> 3)) * ldc + (c0 >> 1) + (le & 7) * 4) * 2
        : (char*)outp + ((size_t)(r0 + (le >> 4)) * ldc + c0 + c4) * ESZ;
    const size_t rstride = (size_t)ldc * ESZ;
#pragma unroll
    for (int m = 0; m < MF; ++m) {
      asm volatile("" : "+v"(orow));
      const int rm = r0 + m * 16;
      float* srow = (sbase && rm < MPR) ? sbase + ((size_t)((rm >> 8) * nh + hd) * 256 + (rm & 255) + (le >> 4)) * 64 + c4 : nullptr;
      if (EPI == EPI_EVIN || EPI == EPI_ODIN) {
        if (isV) {
          const int t0 = rm + fqe * 4, kk16 = t0 & 15;
          u16* vb = p.VT + ((size_t)(((c0 - vlo) >> 6) * 384 + (t0 >> 5)) * 4 + ((t0 >> 4) & 1)) * 512 + (((kk16 >> 2) & 1) * 32) * 8 + (kk16 >> 3) * 4;
#pragma unroll
          for (int n = 0; n < 4; ++n) {
            const int dim = n * 16 + fre;
            uint2 o; o.x = pack2(acc[m][n][0], acc[m][n][1]); o.y = pack2(acc[m][n][2], acc[m][n][3]);
            *(uint2*)(vb + (dim >> 5) * 1024 + (dim & 31) * 8) = o;
          }
        }
      }
      if (EPI != EPI_SWIGLU) {
#pragma unroll
      for (int n = 0; n < 4; ++n)
#pragma unroll
        for (int j = 0; j < 4; ++j) Ew[(fqe * 4 + j) * 68 + n * 16 + fre] = acc[m][n][j];
      }
      if (EPI == EPI_EVIN) {
        if (c0 >= 512 && c0 < 1024) {
#pragma unroll
          for (int ps = 0; ps < 2; ++ps) {
            const int slot = le + 64 * ps, row = slot >> 3, ch = slot & 7;
            const float4 a = *(const float4*)(Ew + row * 68 + ch * 8), b4 = *(const float4*)(Ew + row * 68 + ch * 8 + 4);
            uint4 o; o.x = pack2(a.x, a.y); o.y = pack2(a.z, a.w); o.z = pack2(b4.x, b4.y); o.w = pack2(b4.z, b4.w);
            const int t = rm + row;
            *(uint4*)(p.KF + ((size_t)(((c0 - 512) >> 6) * 384 + (t >> 5)) * 4 + (ch >> 1)) * 512 + ((ch & 1) * 32 + (t & 31)) * 8) = o;
          }
        }
      }
      if (EPI == EPI_SWIGLU) {
        u16* ab = (u16*)outp + (size_t)(rm + fqe * 4) * ldc + (c0 >> 1) + fre;
#pragma unroll
        for (int j = 0; j < 4; ++j)
#pragma unroll
          for (int n = 0; n < 2; ++n) {
            const float g = acc[m][n][j], u = acc[m][n + 2][j];
            ab[(size_t)j * ldc + n * 16] = (u16)pack2(g * u * __builtin_amdgcn_rcpf(1.f + __expf(-g)), 0.f);
          }
      } else {
        f32x4 q0, q1, q2, q3;
        LDS_RD4(q0, q1, q2, q3, (unsigned)(size_t)(Ew + (le >> 4) * 68 + c4), 0, 1088, 2176, 3264);
#pragma unroll
        for (int ps = 0; ps < 4; ++ps) {
          const f32x4 qv = ps == 0 ? q0 : (ps == 1 ? q1 : (ps == 2 ? q2 : q3));
          float4 v = make_float4(qv[0], qv[1], qv[2], qv[3]);
          if (EPI == EPI_F32) {
            uint2 o; o.x = pack2(v.x, v.y); o.y = pack2(v.z, v.w);
            *(uint2*)(orow + (size_t)(4 * ps) * rstride) = o;
          } else if (EPI == EPI_POOL) {
            uint2 o; o.x = pack2(v.x * psc.x, v.y * psc.y); o.y = pack2(v.z * psc.z, v.w * psc.w);
            *(uint2*)(orow + (size_t)(4 * ps) * rstride) = o;
          } else {
            uint2 o; o.x = pack2(v.x, v.y); o.y = pack2(v.z, v.w);
            *(uint2*)(orow + (size_t)(4 * ps) * rstride) = o;
            if (srow) *(float4*)(srow + (4 * ps) * 64) = v;
          }
        }
      }
      orow += 16 * rstride;
    }
  }
#undef GLDS_STAGE
#undef TILE_COORDS
  __syncthreads();
}

struct Seg { const u16* KF; const u16* VF; int n; };

template <bool BIAS>
__device__ __forceinline__ void attn_core(const u16* __restrict__ Q, int ldq, Seg s0, Seg s1, f32x16& o0, f32x16& o1, float& m, float& l,
                                          const float* __restrict__ rpb_h, int qr, int qc0, int rs, int tidx) {
  const int lane = tidx & 63, l31 = lane & 31, lh = lane >> 5;
  bf16x8 bq[4];
#pragma unroll
  for (int kk = 0; kk < 4; ++kk) bq[kk] = *(const bf16x8*)(Q + (size_t)l31 * ldq + kk * 16 + lh * 8);
  m = -1e30f; l = 0.f;
#pragma unroll
  for (int e = 0; e < 16; ++e) { o0[e] = 0.f; o1[e] = 0.f; }
  const int qc = qc0 + l31;
  const int cs = min(max(qc - 8, 0), 48);
  const int nt0 = s0.n >> 5, ntot = nt0 + (s1.n >> 5);
  const u16* k0p = s0.KF + lane * 8;
  const u16* k1p = s1.KF + lane * 8;
  const u16* v0p = s0.VF + lane * 8;
  const u16* v1p = s1.VF + lane * 8;
  bf16x8 kA[4], kB[4], vA[4], vB[4];
#define KLOAD(dst, i_) do { const int j_ = min((i_), ntot - 1); const bool n1_ = j_ >= nt0; \
    const u16* Kp_ = n1_ ? k1p + (size_t)(j_ - nt0) * 2048 : k0p + (size_t)j_ * 2048; \
    _Pragma("unroll") for (int kk = 0; kk < 4; ++kk) dst[kk] = *(const bf16x8*)(Kp_ + kk * 512); } while (0)
#define VLOAD(dst, i_) do { const int j_ = min((i_), ntot - 1); const bool n1_ = j_ >= nt0; \
    const u16* vp_ = n1_ ? v1p + (size_t)(j_ - nt0) * 2048 : v0p + (size_t)j_ * 2048; \
    _Pragma("unroll") for (int q = 0; q < 4; ++q) dst[q] = *(const bf16x8*)(vp_ + q * 512); } while (0)
#define ATT_STEP(kf, vf, i_, kd_, vd_) do { \
    const bool in1 = (i_) >= nt0; const int kt = in1 ? (i_) - nt0 : (i_); \
    f32x16 sc; _Pragma("unroll") for (int e = 0; e < 16; ++e) sc[e] = 0.f; \
    _Pragma("unroll") for (int kk = 0; kk < 4; ++kk) sc = MFMA(kf[kk], bq[kk], sc); \
    KLOAD(kf, (i_) + (kd_)); \
    float mx = -1e30f; \
    _Pragma("unroll") for (int e = 0; e < 16; ++e) { \
      float v = sc[e] * 0.125f; \
      if (BIAS) { if (in1) { \
          const float* brow_ = rpb_h + (rs + (kt >> 1) - qr + 7) * 31;     \
          int kc = (kt & 1) * 32 + 8 * (e >> 2) + 4 * lh + (e & 3); \
          bool valid = (kc >= cs) && (kc < cs + 16); \
          unsigned co = (unsigned)min(max(kc - qc + 15, 0), 30); \
          float bv = brow_[co]; \
          v = valid ? v + bv : -1e30f; } } \
      sc[e] = v; mx = fmaxf(mx, v); \
      if (BIAS && (e & 3) == 3) __builtin_amdgcn_sched_barrier(0); } \
    mx = xor32_max(mx); \
    const float mnew = fmaxf(m, mx); \
    const float corr = __expf(m - mnew); \
    float rsum = 0.f; \
    _Pragma("unroll") for (int e = 0; e < 16; ++e) { float pv = __expf(sc[e] - mnew); sc[e] = pv; rsum += pv; } \
    rsum = xor32_sum(rsum); \
    l = l * corr + rsum; m = mnew; \
    _Pragma("unroll") for (int e = 0; e < 16; ++e) { o0[e] *= corr; o1[e] *= corr; } \
    uint4 t0, t1; \
    t0.x = pack2(sc[0], sc[1]); t0.y = pack2(sc[2], sc[3]); t0.z = pack2(sc[4], sc[5]); t0.w = pack2(sc[6], sc[7]); \
    t1.x = pack2(sc[8], sc[9]); t1.y = pack2(sc[10], sc[11]); t1.z = pack2(sc[12], sc[13]); t1.w = pack2(sc[14], sc[15]); \
    const bf16x8 pb0 = __builtin_bit_cast(bf16x8, t0), pb1 = __builtin_bit_cast(bf16x8, t1); \
    o0 = MFMA(vf[0], pb0, o0); o0 = MFMA(vf[1], pb1, o0); \
    o1 = MFMA(vf[2], pb0, o1); o1 = MFMA(vf[3], pb1, o1); \
    VLOAD(vf, (i_) + (vd_)); } while (0)
  KLOAD(kA, 0); VLOAD(vA, 0);
  if (!BIAS) { KLOAD(kB, 1); VLOAD(vB, 1); }
#pragma unroll 1
  for (int i = 0; i < ntot; i += 2) {
    if (BIAS) {
      ATT_STEP(kA, vA, i, 1, 1);
      ATT_STEP(kA, vA, i + 1, 1, 1);
    } else {
      ATT_STEP(kA, vA, i, 2, 2);
      ATT_STEP(kB, vB, i + 1, 2, 2);
    }
  }
#undef KLOAD
#undef VLOAD
#undef ATT_STEP
}

__device__ __forceinline__ void attn_store(const f32x16& o0, const f32x16& o1, float inv, u16* __restrict__ O, int ldo, int tidx) {
  const int lane = tidx & 63, l31 = lane & 31, lh = lane >> 5;
  u16* op = O + (size_t)l31 * ldo + 4 * lh;
#pragma unroll
  for (int q4 = 0; q4 < 4; ++q4) {
    uint2 a, b;
    a.x = pack2(o0[4 * q4] * inv, o0[4 * q4 + 1] * inv); a.y = pack2(o0[4 * q4 + 2] * inv, o0[4 * q4 + 3] * inv);
    b.x = pack2(o1[4 * q4] * inv, o1[4 * q4 + 1] * inv); b.y = pack2(o1[4 * q4 + 2] * inv, o1[4 * q4 + 3] * inv);
    *(uint2*)(op + 8 * q4) = a;
    *(uint2*)(op + 32 + 8 * q4) = b;
  }
}

template <bool BIAS>
__device__ __forceinline__ void attn_unit(const u16* __restrict__ Q, int ldq, Seg s0, Seg s1, u16* __restrict__ O, int ldo,
                                          const float* __restrict__ rpb_h, int qr, int qc0, int rs, int tidx) {
  f32x16 o0, o1; float m, l;
  attn_core<BIAS>(Q, ldq, s0, s1, o0, o1, m, l, rpb_h, qr, qc0, rs, tidx);
  attn_store(o0, o1, 1.f / l, O, ldo, tidx);
}

__device__ void mix_even(const P& p, int gw, int W, int tidx) {
  const int lane = tidx & 63;
  const u16* U = p.ACTU;
  u16* MO = p.H;
  for (int u0 = gw; u0 < 2048 + MTOK; u0 += W) {
   for (int sub = 0; sub < 2; ++sub) {
    int u;
    if (u0 < 1024) { if (sub) break; u = u0; }
    else if (u0 < 2048) { u = 1024 + 2 * (u0 - 1024) + sub; }
    else if (W != 2048) { if (sub) break; u = u0 + 1024; }
    else {
      if (gw < 1024) break;
      u = 3072 + (gw - 1024) + (2 * ((u0 - 2048) / W) + sub) * 1024;
    }
    if (u < 1024) {
      int b = u >> 9, h = (u >> 6) & 7, r = (u >> 1) & 31, hf = u & 1;
      int tb = MPR + b * 2048;
      int rs = min(max(r - 4, 0), 24);
      Seg s0 = { p.CAK + (size_t)((b * 8 + h) * 8) * 2048, p.CAVT + (size_t)((b * 8 + h) * 8) * 2048, 256 };
      const size_t lt = (size_t)(h * 384 + ((tb + rs * 64) >> 5)) * 2048;
      Seg s1 = { p.KF + lt, p.VT + lt, 512 };
      int q0 = tb + r * 64 + hf * 32;
      attn_unit<true>(U + (size_t)q0 * 3072 + h * 64, 3072, s0, s1, MO + (size_t)q0 * DM + h * 64, DM, p.ev_rpb + h * 465, r, hf * 32, rs, tidx);
    } else if (u < 3072) {
      int v = u - 1024; int b = v >> 6, h = (v >> 3) & 7, qb = v & 7;
      const size_t lt = (size_t)(h * 384 + b * 8) * 2048;
      Seg s0 = { p.KF + lt, p.VT + lt, 256 };
      Seg s1 = { s0.KF, s0.VF, 0 };
      int q0 = b * 256 + qb * 32;
      attn_unit<false>(U + (size_t)q0 * 3072 + h * 64, 3072, s0, s1, MO + (size_t)q0 * DM + h * 64, DM, nullptr, 0, 0, 0, tidx);
    } else {
      int t = u - 3072;
      int s, L;
      if (t < MPR) { s = t & 255; L = 256; } else { s = (t - MPR) & 2047; L = 2048; }
      const int c = lane * 8;
      float z[3][8];
#pragma unroll
      for (int d = 0; d < 3; ++d) {
        int sd = s + d - 1;
        if (sd >= 0 && sd < L) {
          const u16* row = U + (size_t)(t + d - 1) * 3072;
          uint4 cg4 = *(const uint4*)(row + 2048 + c), xb4 = *(const uint4*)(row + 2560 + c);
          z[d][0] = bflo(cg4.x) * bflo(xb4.x); z[d][1] = bfhi(cg4.x) * bfhi(xb4.x);
          z[d][2] = bflo(cg4.y) * bflo(xb4.y); z[d][3] = bfhi(cg4.y) * bfhi(xb4.y);
          z[d][4] = bflo(cg4.z) * bflo(xb4.z); z[d][5] = bfhi(cg4.z) * bfhi(xb4.z);
          z[d][6] = bflo(cg4.w) * bflo(xb4.w); z[d][7] = bfhi(cg4.w) * bfhi(xb4.w);
        } else {
#pragma unroll
          for (int j = 0; j < 8; ++j) z[d][j] = 0.f;
        }
      }
      uint4 bg4 = *(const uint4*)(U + (size_t)t * 3072 + 1536 + c);
      float bg[8] = { bflo(bg4.x), bfhi(bg4.x), bflo(bg4.y), bfhi(bg4.y), bflo(bg4.z), bfhi(bg4.z), bflo(bg4.w), bfhi(bg4.w) };
      float y[8];
#pragma unroll
      for (int j = 0; j < 8; ++j) {
        float w0 = p.ev_conv_w[c + j], w1 = p.ev_conv_w[512 + c + j], w2 = p.ev_conv_w[1024 + c + j];
        y[j] = bg[j] * (z[0][j] * w0 + z[1][j] * w1 + z[2][j] * w2 + p.ev_conv_b[c + j]);
      }
      uint4 o; o.x = pack2(y[0], y[1]); o.y = pack2(y[2], y[3]); o.z = pack2(y[4], y[5]); o.w = pack2(y[6], y[7]);
      *(uint4*)(MO + (size_t)t * DM + 512 + c) = o;
    }
   }
  }
}

__device__ void mix_odd_a(const P& p, int gw, int W, int tidx) {
  const int lane = tidx & 63;
  u16* U = p.ACTU;
  u16* POOLED = (u16*)p.T;
  const float invf = exp2f(-(float)((lane >> 1) & 15) * (13.287712379549449f / 16.f));
  for (int t = gw; t < MTOK; t += W) {
    const bool smp = t >= MPR;
    int s, L, base;
    if (!smp) { s = t & 255; L = 256; base = t - s; } else { s = (t - MPR) & 2047; L = 2048; base = t - s; }
    float cs_ = 1.f, sn_ = 0.f;
    if (smp) {
      float pos = (lane < 32) ? (float)(s >> 6) : (float)(s & 63);
      float ang = pos * invf;
      cs_ = __cosf(ang); sn_ = __sinf(ang);
    }
    u16* row = U + (size_t)t * 1280;
    const float qw = p.od_q_norm[lane], kw = p.od_k_norm[lane];
    u16 hv[10];
#pragma unroll
    for (int hd = 0; hd < 10; ++hd) hv[hd] = row[512 + hd * 64 + lane];
#pragma unroll
    for (int hd = 0; hd < 10; ++hd) {
      float v = bf2f(hv[hd]);
      float ss = wave_sum_dpp(v * v);
      float w = hd < 8 ? qw : kw;
      float nv = v * rsqrtf(ss * (1.f / 64.f) + 1e-6f) * w;
      float outv = nv;
      if (smp) {
        float pr = __builtin_bit_cast(float, __builtin_amdgcn_update_dpp(0, __builtin_bit_cast(int, nv), 0xB1, 0xF, 0xF, true));
        outv = (lane & 1) ? (pr * sn_ + nv * cs_) : (nv * cs_ - pr * sn_);
      } else if (hd >= 8) {
        int b = t >> 8;
        p.out[OFF_SDK + ((size_t)(b * 2 + (hd - 8)) * 256 + s) * 64 + lane] = nv;
      }
      if (hd < 8) row[512 + hd * 64 + lane] = (u16)pack2(outv, 0.f);
      else p.KF[((size_t)((hd - 8) * 384 + (t >> 5)) * 4 + (lane >> 4)) * 512 + (((lane >> 3) & 1) * 32 + (t & 31)) * 8 + (lane & 7)] = (u16)pack2(outv, 0.f);
    }
    {
      const int half = 1 << (lane >> 4);
      const int lo = max(s - half, 0), hi = min(s + half, L);
      const int c = lane * 8;
      float a[8];
#pragma unroll
      for (int j = 0; j < 8; ++j) a[j] = 0.f;
      uint4 wv[16];
#pragma unroll
      for (int j = 0; j < 16; ++j) {
        const int jj = lo + j;
        wv[j] = make_uint4(0u, 0u, 0u, 0u);
        if (jj < hi) wv[j] = *(const uint4*)(U + (size_t)(base + jj) * 1280 + c);
      }
#pragma unroll
      for (int j = 0; j < 16; ++j) {
        const uint4 v = wv[j];
        a[0] += bflo(v.x); a[1] += bfhi(v.x); a[2] += bflo(v.y); a[3] += bfhi(v.y);
        a[4] += bflo(v.z); a[5] += bfhi(v.z); a[6] += bflo(v.w); a[7] += bfhi(v.w);
      }
      const float rn = __builtin_amdgcn_rcpf((float)(hi - lo));
      uint4 sv = *(const uint4*)(U + (size_t)t * 1280 + c);
      uint4 o;
      o.x = pack2(a[0] * rn - bflo(sv.x), a[1] * rn - bfhi(sv.x));
      o.y = pack2(a[2] * rn - bflo(sv.y), a[3] * rn - bfhi(sv.y));
      o.z = pack2(a[4] * rn - bflo(sv.z), a[5] * rn - bfhi(sv.z));
      o.w = pack2(a[6] * rn - bflo(sv.w), a[7] * rn - bfhi(sv.w));
      *(uint4*)(POOLED + (size_t)t * 512 + c) = o;
    }
  }
}

__device__ void mix_odd_b(const P& p, int gw, int W, int tidx, char* smem) {
  const u16* U = p.ACTU;
  u16* MO = p.H;
  const int lane = tidx & 63, wave = tidx >> 6;
  for (int hu = gw; hu < 2048; hu += W) {
    const int v = hu >> 1, half = hu & 1;
    const int b = v >> 9, hq = (v >> 6) & 7, qb = v & 63, kvh = hq >> 2;
    const int tb = MPR + b * 2048;
    const size_t lt = (size_t)(kvh * 384 + (tb >> 5)) * 2048;
    Seg s0, s1;
    if (half == 0) {
      s0 = Seg{ p.CDK + (size_t)((b * 2 + kvh) * 8) * 2048, p.CDVT + (size_t)((b * 2 + kvh) * 8) * 2048, 256 };
      s1 = Seg{ p.KF + lt, p.VT + lt, 896 };
    } else {
      s0 = Seg{ p.KF + lt + (size_t)28 * 2048, p.VT + lt + (size_t)28 * 2048, 1152 };
      s1 = Seg{ p.KF + lt, p.VT + lt, 0 };
    }
    const int q0 = tb + qb * 32;
    f32x16 o0, o1; float m, l;
    attn_core<false>(U + (size_t)q0 * 1280 + 512 + hq * 64, 1280, s0, s1, o0, o1, m, l, nullptr, 0, 0, 0, tidx);
    float* cb = (float*)smem + (wave >> 1) * (34 * 64) + lane;
    if (half == 1) {
      cb[0] = m; cb[64] = l;
#pragma unroll
      for (int e = 0; e < 16; ++e) { cb[(2 + e) * 64] = o0[e]; cb[(18 + e) * 64] = o1[e]; }
    }
    __syncthreads();
    if (half == 0) {
      const float m2 = cb[0], l2 = cb[64];
      const float M = fmaxf(m, m2);
      const float a1 = __expf(m - M), a2 = __expf(m2 - M);
      const float inv = 1.f / (l * a1 + l2 * a2);
#pragma unroll
      for (int e = 0; e < 16; ++e) { o0[e] = o0[e] * a1 + cb[(2 + e) * 64] * a2; o1[e] = o1[e] * a1 + cb[(18 + e) * 64] * a2; }
      attn_store(o0, o1, inv, MO + (size_t)q0 * DM + 512 + hq * 64, DM, tidx);
    }
    __syncthreads();
  }
  for (int v = gw; v < 2048; v += W) {
    int b = v >> 6, hq = (v >> 3) & 7, qb = v & 7, kvh = hq >> 2;
    const size_t lt = (size_t)(kvh * 384 + b * 8) * 2048;
    Seg s0 = { p.KF + lt, p.VT + lt, 256 };
    Seg s1 = { s0.KF, s0.VF, 0 };
    int q0 = b * 256 + qb * 32;
    attn_unit<false>(U + (size_t)q0 * 1280 + 512 + hq * 64, 1280, s0, s1, MO + (size_t)q0 * DM + 512 + hq * 64, DM, nullptr, 0, 0, 0, tidx);
  }
}

#define XB_TMO      128
#define XB_XCNT(j)  (256  + 64 * (j))
#define XB_XSUB(j)  (1280 + 64 * (j))
#define XB_XGEN(j)  (2304 + 64 * (j))
#define XB_TOP      3328
#define XB_TOPGEN   3392
#define XCD_BAR_WORDS 3456
#define XB_SPIN_CAP (1u << 20)
#define LAS __attribute__((address_space(3)))
DI unsigned xb_ld(unsigned* p)              { return __hip_atomic_load(p, __ATOMIC_RELAXED, __HIP_MEMORY_SCOPE_AGENT); }
DI unsigned xb_add(unsigned* p, unsigned v) { return __hip_atomic_fetch_add(p, v, __ATOMIC_RELAXED, __HIP_MEMORY_SCOPE_AGENT); }
DI unsigned xb_xcc_id() { return (unsigned)__builtin_amdgcn_s_getreg((3 << 11) | 20) & 0xFu; }
#define XB_SPIN(cond, bar) do { unsigned _sp = 0; while (cond) { __builtin_amdgcn_s_sleep(1); \
    if ((++_sp & 255u) == 0u) { if (xb_ld(&(bar)[XB_TMO])) break; if (_sp > XB_SPIN_CAP) { atomicAdd(&(bar)[XB_TMO], 1u); break; } } } } while (0)
struct XcdBarrier { unsigned* bar; unsigned x; volatile LAS unsigned* st; };
DI XcdBarrier xcd_barrier_post(unsigned* bar, volatile LAS unsigned* st) {
  XcdBarrier b; b.bar = bar; b.x = xb_xcc_id(); b.st = st;
  if (threadIdx.x == 0) (void)xb_add(&bar[XB_XCNT(b.x)], 1u);
  return b;
}
DI void xcd_barrier_complete(unsigned* bar, unsigned x, unsigned& nloc, unsigned& nx) {
  const unsigned G = gridDim.x * gridDim.y * gridDim.z;
  unsigned sum, cnt, mine, sp = 0u;
  for (;;) {
    sum = 0u; cnt = 0u; mine = 0u;
#pragma unroll
    for (unsigned j = 0; j < 16; ++j) { const unsigned c = xb_ld(&bar[XB_XCNT(j)]); sum += c; cnt += (c > 0u) ? 1u : 0u; mine = (j == x) ? c : mine; }
    if (sum == G) break;
    __builtin_amdgcn_s_sleep(1);
    if ((++sp & 255u) == 0u) { if (xb_ld(&bar[XB_TMO])) break; if (sp > XB_SPIN_CAP) { atomicAdd(&bar[XB_TMO], 1u); break; } }
  }
  nloc = mine > 0u ? mine : 1u; nx = cnt > 0u ? cnt : 1u;
}
DI void xcd_barrier(const XcdBarrier& b, bool leader) {
  asm volatile("s_waitcnt vmcnt(0)" ::: "memory");
  __syncthreads();
  if (leader) {
    unsigned* bar = b.bar;
    __builtin_amdgcn_s_waitcnt(0);
    unsigned nloc = b.st[0], nx = b.st[1];
    if (nloc == 0u) { xcd_barrier_complete(bar, b.x, nloc, nx); b.st[0] = nloc; b.st[1] = nx; }
    const unsigned old = xb_add(&bar[XB_XSUB(b.x)], 1u);
    const unsigned gen = old / nloc;
    if (old + 1u == (gen + 1u) * nloc) {
      __builtin_amdgcn_fence(__ATOMIC_RELEASE, "agent");
      asm volatile("s_waitcnt vmcnt(0)" ::: "memory");
      const unsigned og = xb_add(&bar[XB_TOP], 1u);
      const unsigned tg = og / nx;
      if (og + 1u == (tg + 1u) * nx) xb_add(&bar[XB_TOPGEN], 1u);
      else XB_SPIN(xb_ld(&bar[XB_TOPGEN]) == tg, bar);
      __builtin_amdgcn_fence(__ATOMIC_ACQUIRE, "agent");
      xb_add(&bar[XB_XGEN(b.x)], 1u);
      asm volatile("s_waitcnt vmcnt(0)" ::: "memory");
    } else {
      XB_SPIN(xb_ld(&bar[XB_XGEN(b.x)]) == gen, bar);
      __builtin_amdgcn_fence(__ATOMIC_ACQUIRE, "agent");
      asm volatile("s_waitcnt vmcnt(0)" ::: "memory");
    }
  }
  __syncthreads();
}

constexpr int N_PHASES = 16;
#define GRID_SYNC() xcd_barrier(xb, wave_s == 0 && __builtin_amdgcn_mbcnt_hi(~0u, __builtin_amdgcn_mbcnt_lo(~0u, 0u)) == 0u)

#define LOADP() unsigned zop = 0u; asm volatile("" : "+v"(zop)); \
    const int tidx = wave_s * 64 + (int)__builtin_amdgcn_mbcnt_hi(~0u, __builtin_amdgcn_mbcnt_lo(~0u, zop)); \
    const int gw = vbid * (NTHR / 64) + wave_s; \
    PAK pa = pak0; asm volatile("" : "+s"(pa)); P p; \
    p.x_prompt = pa->in[0]; p.x_sample = pa->in[1]; p.cache_a_k = pa->in[2]; p.cache_a_v = pa->in[3]; p.cache_d_k = pa->in[4]; p.cache_d_v = pa->in[5]; \
    p.c = pa->in[6]; p.c_ctx = pa->in[7]; p.mod_w = pa->in[8]; p.mod_b = pa->in[9]; p.norm_w = pa->in[10]; p.ffn_w1 = pa->in[11]; p.ffn_w2 = pa->in[12]; \
    p.ev_w_in = pa->in[13]; p.ev_rpb = pa->in[14]; p.ev_conv_w = pa->in[15]; p.ev_conv_b = pa->in[16]; p.ev_w_out = pa->in[17]; \
    p.od_w_in = pa->in[18]; p.od_pool_w = pa->in[19]; p.od_pool_scale = pa->in[20]; p.od_q_norm = pa->in[21]; p.od_k_norm = pa->in[22]; p.od_w_out = pa->in[23]; \
    p.out = pa->out; \
    { char* ws = pa->ws; \
      p.W1T = (u16*)(ws + WO_W1T); p.W2T = (u16*)(ws + WO_W2T); p.EVIN = (u16*)(ws + WO_EVIN); p.EVOUT = (u16*)(ws + WO_EVOUT); \
      p.ODIN = (u16*)(ws + WO_ODIN); p.ODOUT = (u16*)(ws + WO_ODOUT); p.POOLW = (u16*)(ws + WO_POOLW); \
      p.CAK = (u16*)(ws + WO_CAK); p.CAVT = (u16*)(ws + WO_CAVT); p.CDK = (u16*)(ws + WO_CDK); p.CDVT = (u16*)(ws + WO_CDVT); \
      p.H = (u16*)(ws + WO_H); p.ACTU = (u16*)(ws + WO_ACTU); p.VT = (u16*)(ws + WO_VT); \
      p.MOD = (float*)(ws + WO_MOD); p.X = (float*)(ws + WO_X); p.T = (float*)(ws + WO_T); p.BAR = (unsigned*)(ws + WO_BAR); p.KF = (u16*)(ws + WO_KF); p.XCH = (float*)(ws + WO_XCH); }
typedef const __attribute__((address_space(4))) PA* PAK;
__global__ void __launch_bounds__(NTHR, 2) mega(PA pa_unused, int ph0, int ph1) {
  __shared__ __attribute__((aligned(1024))) char smem[LDS_BYTES];
  __shared__ uint4 xb_words;
  const int wave_s = __builtin_amdgcn_readfirstlane((int)(threadIdx.x >> 6));
  cg::grid_group grid = cg::this_grid();
  if (ph1 == 0x7fffffff) grid.sync();
  if (threadIdx.x == 0) xb_words = make_uint4(0u, 0u, 0u, 0u);
  __syncthreads();
  const PAK pak0 = (PAK)__builtin_amdgcn_kernarg_segment_ptr();
  const XcdBarrier xb = xcd_barrier_post((unsigned*)(pak0->ws + WO_BAR), (volatile LAS unsigned*)&xb_words);
  const int G = gridDim.x, bid = blockIdx.x;
  const int vbid = (G & 7) ? bid : ((bid & 7) * (G >> 3) + (bid >> 3));
  const int W = G * (NTHR / 64);
#ifndef REPMASK
#define REPMASK 0u
#endif
  for (int ph = ph0; ph < ph1; ++ph) {
   const int nrep = ((REPMASK >> ph) & 1u) ? 2 : 1;
   for (int rep = 0; rep < nrep; ++rep) {
    if (rep) { GRID_SYNC(); }
    if (ph == 0) {
      LOADP();
      prep_phase(p, smem, bid, G, tidx);
    } else if (ph == 1) {
      LOADP();
      r_phase<0>(p, true, false, nullptr, nullptr, 0, 0.f, true, p.norm_w, p.MOD, 0, 1, p.X, gw, W, tidx);
    } else {
      const int q = ph - 2;
      const int l = q / 7, s = q % 7;
#define NWMOD() const float* nw = p.norm_w + l * 6 * DM; const float* modl = p.MOD + l * 3 * 9216
      switch (s) {
        case 0: case 5: { LOADP();
          const int f = s == 0 ? 0 : 1;
          const u16* w1 = p.W1T + (size_t)(l * 2 + f) * 5632 * 1024;
          gemm_phase<EPI_SWIGLU, 6>(p, p.H, w1, 1024, 64, 22, p.ACTU, DFF, smem, vbid, G, tidx, 1280);
          gemm_phase<EPI_SWIGLU, 3, true>(p, p.H, w1, 1024, 64, 22, p.ACTU, DFF, smem, vbid, G, tidx, 256, 1280);
        } break;
        case 1: case 4: case 6: { LOADP(); NWMOD();
          const u16* A_ = s == 4 ? p.H : p.ACTU;
          const u16* B_ = s == 4 ? (l == 0 ? p.EVOUT : p.ODOUT) : p.W2T + (size_t)(l * 2 + (s == 1 ? 0 : 1)) * 1024 * 2816;
          ResArgs ra;
          ra.gT = nw + (s == 1 ? 1 : (s == 4 ? 3 : 5)) * DM;
          ra.modg = modl; ra.gate = s == 1 ? 2 : (s == 4 ? 5 : 8); ra.gs = s == 4 ? 1.0f : 0.5f;
          ra.fin = (s == 6 && l == 1) ? 1 : 0;
          ra.g2 = s == 1 ? nw + 2 * DM : (s == 4 ? nw + 4 * DM : p.norm_w + 6 * DM);
          ra.modn = s == 6 ? p.MOD + 3 * 9216 : modl;
          ra.shi = s == 1 ? 3 : (s == 4 ? 6 : 0);
          ra.kuse = 3 * l + (s == 1 ? 0 : (s == 4 ? 1 : 2));
          gemm_phase<EPI_RES, 6>(p, A_, B_, s == 4 ? 1024 : DFF, 64, 4, nullptr, DM, smem, vbid, G, tidx, 1 << 30, 0, ra);
        } break;
        case 2: { LOADP();
          if (l == 0) gemm_phase<EPI_EVIN, 6>(p, p.H, p.EVIN, 1024, 64, 12, p.ACTU, 3072, smem, vbid, G, tidx);
          else {
            gemm_phase<EPI_ODIN, 6>(p, p.H, p.ODIN, 1024, 64, 5, p.ACTU, 1280, smem, vbid, G, tidx, 256);
            gemm_phase<EPI_ODIN, 3, true>(p, p.H, p.ODIN, 1024, 64, 5, p.ACTU, 1280, smem, vbid, G, tidx, 128, 256);
            GRID_SYNC();
            mix_odd_a(p, gw, W, tidx);
          }
        } break;
        case 3: { LOADP();
          if (l == 0) mix_even(p, gw, W, tidx);
          else {
            gemm_phase<EPI_POOL, 3>(p, (const u16*)p.T, p.POOLW, 512, 128, 2, p.H, DM, smem, vbid, G, tidx);
            mix_odd_b(p, gw, W, tidx, smem);
          }
        } break;
      }
    }
   }
    if (ph + 1 < ph1) { GRID_SYNC(); }
#ifdef EXTRA_SYNCS
    if (ph == 1) { for (int es = 0; es < EXTRA_SYNCS; ++es) { GRID_SYNC(); } }
#endif
  }
}

extern "C" void kernel_launch(void* const* d_in, const int* in_sizes, int n_in, void* d_out, int out_size,
                              void* d_ws, size_t ws_size, hipStream_t stream) {
  static int grid_blocks = 0;
  if (!grid_blocks) {
    int dev = 0, cus = 0, per_cu = 0;
    hipGetDevice(&dev);
    hipDeviceGetAttribute(&cus, hipDeviceAttributeMultiprocessorCount, dev);
    hipOccupancyMaxActiveBlocksPerMultiprocessor(&per_cu, mega, NTHR, 0);
    if (per_cu > 1) per_cu = 1;
    if (per_cu < 1) per_cu = 1;
    grid_blocks = cus * per_cu;
  }
  PA p{};
  for (int i = 0; i < 24; ++i) p.in[i] = (const float*)d_in[i];
  p.out = (float*)d_out;
  p.ws = (char*)d_ws;
  if (WO_END > ws_size) { fprintf(stderr, "workspace too small: need %zu have %zu\n", (size_t)WO_END, ws_size); return; }
  (void)hipMemsetAsync(p.ws + WO_BAR, 0, (size_t)(XCD_BAR_WORDS + 2048) * 4, stream);
  int ph0 = 0, ph1 = N_PHASES;
  void* args[] = { &p, &ph0, &ph1 };
  hipError_t e = hipLaunchCooperativeKernel((void*)mega, dim3(grid_blocks), dim3(NTHR), args, 0, stream);
  if (e != hipSuccess) fprintf(stderr, "cooperative launch failed: %s (grid %d)\n", hipGetErrorString(e), grid_blocks);
}
```

```cpp
#include <hip/hip_runtime.h>
#include <hip/hip_cooperative_groups.h>
#include <cstdio>
namespace cg = cooperative_groups;

typedef unsigned short u16;
using bf16x8 = __attribute__((ext_vector_type(8))) short;
using s16x4  = __attribute__((ext_vector_type(4))) short;
using f32x16 = __attribute__((ext_vector_type(16))) float;
#define DI __device__ __forceinline__
#define MFMA(a, b, c) __builtin_amdgcn_mfma_f32_32x32x16_bf16((a), (b), (c), 0, 0, 0)

constexpr int MTOK = 12288;
constexpr int MPR  = 8192;
constexpr int DM   = 1024;
constexpr int DFF  = 2816;
constexpr int NTHR = 512;
constexpr int LDS_BYTES = 131072;
constexpr int SROW = 72;

constexpr size_t OFF_SAK = 12582912, OFF_SAV = 16777216, OFF_SDK = 20971520, OFF_SDV = 22020096;

struct P {
  const float *x_prompt, *x_sample, *cache_a_k, *cache_a_v, *cache_d_k, *cache_d_v, *c, *c_ctx;
  const float *mod_w, *mod_b, *norm_w, *ffn_w1, *ffn_w2, *ev_w_in, *ev_rpb, *ev_conv_w, *ev_conv_b, *ev_w_out;
  const float *od_w_in, *od_pool_w, *od_pool_scale, *od_q_norm, *od_k_norm, *od_w_out;
  float* out;
  u16 *W1T, *W2T, *EVIN, *EVOUT, *ODIN, *ODOUT, *POOLW, *CAK, *CAVT, *CDK, *CDVT, *H, *ACTU, *VT, *KF;
  float *MOD, *X, *T;
  unsigned* BAR;
  float* XCH;
};
struct PA {
  const float* in[24];
  float* out;
  char* ws;
};
constexpr size_t al256(size_t b) { return (b + 255) & ~(size_t)255; }
constexpr size_t WO_W1T = 0;
constexpr size_t WO_W2T = WO_W1T + al256((size_t)4 * 5632 * 1024 * 2);
constexpr size_t WO_EVIN = WO_W2T + al256((size_t)4 * 1024 * 2816 * 2);
constexpr size_t WO_EVOUT = WO_EVIN + al256((size_t)3072 * 1024 * 2);
constexpr size_t WO_ODIN = WO_EVOUT + al256((size_t)1024 * 1024 * 2);
constexpr size_t WO_ODOUT = WO_ODIN + al256((size_t)1280 * 1024 * 2);
constexpr size_t WO_POOLW = WO_ODOUT + al256((size_t)1024 * 1024 * 2);
constexpr size_t WO_CAK = WO_POOLW + al256((size_t)512 * 512 * 2);
constexpr size_t WO_CAVT = WO_CAK + al256((size_t)262144 * 2);
constexpr size_t WO_CDK = WO_CAVT + al256((size_t)262144 * 2);
constexpr size_t WO_CDVT = WO_CDK + al256((size_t)65536 * 2);
constexpr size_t WO_H = WO_CDVT + al256((size_t)65536 * 2);
constexpr size_t WO_ACTU = WO_H + al256((size_t)12288 * 1024 * 2);
constexpr size_t WO_VT = WO_ACTU + al256((size_t)12288 * 3072 * 2);
constexpr size_t WO_MOD = WO_VT + al256((size_t)512 * 12288 * 2);
constexpr size_t WO_X = WO_MOD + al256((size_t)2 * 3 * 9216 * 4);
constexpr size_t WO_T = WO_X + al256((size_t)12288 * 1024 * 4);
constexpr size_t WO_BAR = WO_T + al256((size_t)12288 * 1024 * 4);
constexpr size_t WO_KF = WO_BAR + al256((size_t)(3456 + 2048) * 4);
constexpr size_t WO_XCH = WO_KF + al256((size_t)512 * 12288 * 2);
constexpr size_t WO_END = WO_XCH + al256((size_t)2 * 12288 * 4 * 4);

DI u16 f2bf(float x) { unsigned u = __float_as_uint(x); u += 0x7fffu + ((u >> 16) & 1u); return (u16)(u >> 16); }
DI float bf2f(u16 v) { return __uint_as_float(((unsigned)v) << 16); }
DI unsigned pack2(float a, float b) { unsigned r; asm("v_cvt_pk_bf16_f32 %0, %1, %2" : "=v"(r) : "v"(a), "v"(b)); return r; }
DI float row16_sum(float v) {
  v += __builtin_bit_cast(float, __builtin_amdgcn_update_dpp(0, __builtin_bit_cast(int, v), 0xB1, 0xF, 0xF, true));
  v += __builtin_bit_cast(float, __builtin_amdgcn_update_dpp(0, __builtin_bit_cast(int, v), 0x4E, 0xF, 0xF, true));
  v += __builtin_bit_cast(float, __builtin_amdgcn_update_dpp(0, __builtin_bit_cast(int, v), 0x141, 0xF, 0xF, true));
  v += __builtin_bit_cast(float, __builtin_amdgcn_update_dpp(0, __builtin_bit_cast(int, v), 0x140, 0xF, 0xF, true));
  return v;
}
DI float xor32_max(float v) { float a = v, b = v; asm volatile("s_nop 1\n\tv_permlane32_swap_b32 %0, %1" : "+v"(a), "+v"(b)); return fmaxf(a, b); }
DI float xor32_sum(float v) { float a = v, b = v; asm volatile("s_nop 1\n\tv_permlane32_swap_b32 %0, %1" : "+v"(a), "+v"(b)); return a + b; }
DI float xor16_sum(float v) { float a = v, b = v; asm volatile("s_nop 1\n\tv_permlane16_swap_b32 %0, %1" : "+v"(a), "+v"(b)); return a + b; }
DI float wave_sum(float v) {
#pragma unroll
  for (int o = 32; o > 0; o >>= 1) v += __shfl_xor(v, o);
  return v;
}
DI float wave_sum_dpp(float v) {
  return xor32_sum(xor16_sum(row16_sum(v)));
}
DI float bflo(unsigned u) { return __uint_as_float(u << 16); }
DI float bfhi(unsigned u) { return __uint_as_float(u & 0xffff0000u); }

__device__ void mod_item(const P& p, int it, char* smem, int tidx) {
  float* sS = (float*)smem;
  float* red = sS + 3072;
  const int tid = tidx;
  const int l = it / 144, n0 = (it % 144) * 64;
  for (int i = tid; i < 3072; i += 256) {
    int r = i >> 10, k = i & 1023;
    float v = r == 0 ? p.c_ctx[k] : p.c[(r - 1) * 1024 + k];
    sS[i] = v / (1.f + expf(-v));
  }
  __syncthreads();
  const int kq = tid >> 4, cq = tid & 15;
  const float* w = p.mod_w + (size_t)l * 1024 * 9216 + (size_t)(kq * 64) * 9216 + n0 + cq * 4;
  float a00 = 0, a01 = 0, a02 = 0, a03 = 0, a10 = 0, a11 = 0, a12 = 0, a13 = 0, a20 = 0, a21 = 0, a22 = 0, a23 = 0;
#pragma unroll 1
  for (int k0 = 0; k0 < 64; k0 += 8) {
    float4 wv[8];
#pragma unroll
    for (int k = 0; k < 8; ++k) wv[k] = *(const float4*)(w + (size_t)(k0 + k) * 9216);
#pragma unroll
    for (int k = 0; k < 8; ++k) {
      float4 w4 = wv[k];
      float s0 = sS[kq * 64 + k0 + k], s1 = sS[1024 + kq * 64 + k0 + k], s2 = sS[2048 + kq * 64 + k0 + k];
      a00 += s0 * w4.x; a01 += s0 * w4.y; a02 += s0 * w4.z; a03 += s0 * w4.w;
      a10 += s1 * w4.x; a11 += s1 * w4.y; a12 += s1 * w4.z; a13 += s1 * w4.w;
      a20 += s2 * w4.x; a21 += s2 * w4.y; a22 += s2 * w4.z; a23 += s2 * w4.w;
    }
  }
  float* r0 = red + (kq * 3 + 0) * 64 + cq * 4;
  r0[0] = a00; r0[1] = a01; r0[2] = a02; r0[3] = a03;
  r0[64] = a10; r0[65] = a11; r0[66] = a12; r0[67] = a13;
  r0[128] = a20; r0[129] = a21; r0[130] = a22; r0[131] = a23;
  __syncthreads();
  if (tid < 192) {
    int r = tid >> 6, n = tid & 63;
    float s = p.mod_b[l * 9216 + n0 + n];
#pragma unroll
    for (int q = 0; q < 16; ++q) s += red[(q * 3 + r) * 64 + n];
    p.MOD[(l * 3 + r) * 9216 + n0 + n] = s;
  }
  __syncthreads();
}

struct TrItem { const float* src; u16* dst; int N, Kd, k0, n0, perm; };
DI TrItem tr_decode(const P& p, int idx) {
  TrItem t; t.perm = 0; int kt, nt;
  if (idx < 2816) { int mat = idx / 704, r = idx % 704; kt = r / 44; nt = r % 44; t.src = p.ffn_w1 + (size_t)mat * 1024 * 5632; t.N = 5632; t.Kd = 1024; t.dst = p.W1T + (size_t)mat * 5632 * 1024; t.perm = 1; }
  else if (idx < 4224) { int r0 = idx - 2816; int mat = r0 / 352, r = r0 % 352; kt = r / 8; nt = r % 8; t.src = p.ffn_w2 + (size_t)mat * 2816 * 1024; t.N = 1024; t.Kd = 2816; t.dst = p.W2T + (size_t)mat * 1024 * 2816; }
  else if (idx < 4608) { int r = idx - 4224; kt = r / 24; nt = r % 24; t.src = p.ev_w_in; t.N = 3072; t.Kd = 1024; t.dst = p.EVIN; }
  else if (idx < 4736) { int r = idx - 4608; kt = r / 8; nt = r % 8; t.src = p.ev_w_out; t.N = 1024; t.Kd = 1024; t.dst = p.EVOUT; }
  else if (idx < 4896) { int r = idx - 4736; kt = r / 10; nt = r % 10; t.src = p.od_w_in; t.N = 1280; t.Kd = 1024; t.dst = p.ODIN; }
  else if (idx < 5024) { int r = idx - 4896; kt = r / 8; nt = r % 8; t.src = p.od_w_out; t.N = 1024; t.Kd = 1024; t.dst = p.ODOUT; }
  else { int r = idx - 5024; int mat = r >> 1; kt = r & 1; nt = 0; t.src = p.od_pool_w + mat * 16384; t.N = 128; t.Kd = 512; t.dst = p.POOLW + (size_t)(mat * 128) * 512 + mat * 128; }
  t.k0 = kt * 64; t.n0 = nt * 128;
  return t;
}

__device__ void prep_phase(const P& p, char* smem_all, int bid, int G, int tid512) {
  constexpr int N_MOD = 288, N_TR = 5032, N_CC = 448;
  const int half = tid512 >> 8, tid = tid512 & 255;
  char* smem = smem_all + half * 36864;
  for (int pi = bid; pi < N_MOD / 2; pi += G) mod_item(p, 2 * pi + half, smem, tid);
  {
    float* tl = (float*)smem;
    const int r = tid >> 5, c4 = (tid & 31) * 4;
    float4 v[8];
    int tp = bid;
    TrItem cur{};
    if (tp < N_TR / 2) {
      cur = tr_decode(p, 2 * tp + half);
      const float* sp = cur.src + (size_t)(cur.k0 + r) * cur.N + cur.n0 + c4;
#pragma unroll
      for (int q = 0; q < 8; ++q) v[q] = *(const float4*)(sp + (size_t)(8 * q) * cur.N);
    }
    for (; tp < N_TR / 2; tp += G) {
      float* tpp = tl + r * 129 + c4;
#pragma unroll
      for (int q = 0; q < 8; ++q) { tpp[q * 8 * 129] = v[q].x; tpp[q * 8 * 129 + 1] = v[q].y; tpp[q * 8 * 129 + 2] = v[q].z; tpp[q * 8 * 129 + 3] = v[q].w; }
      __syncthreads();
      const TrItem me = cur;
      if (tp + G < N_TR / 2) {
        cur = tr_decode(p, 2 * (tp + G) + half);
        const float* sp = cur.src + (size_t)(cur.k0 + r) * cur.N + cur.n0 + c4;
#pragma unroll
        for (int q = 0; q < 8; ++q) v[q] = *(const float4*)(sp + (size_t)(8 * q) * cur.N);
      }
#pragma unroll
      for (int q = 0; q < 4; ++q) {
        int nn = (tid >> 3) + 32 * q, kc = tid & 7;
        int n = me.n0 + nn, nd = n;
        if (me.perm) nd = n < DFF ? ((n >> 5) * 64 + (n & 31)) : ((((n - DFF) >> 5) * 64) + 32 + ((n - DFF) & 31));
        const float* t = tl + (kc * 8) * 129 + nn;
        uint4 o;
        o.x = pack2(t[0], t[129]); o.y = pack2(t[258], t[387]); o.z = pack2(t[516], t[645]); o.w = pack2(t[774], t[903]);
        *(uint4*)(me.dst + (size_t)nd * me.Kd + me.k0 + kc * 8) = o;
      }
      __syncthreads();
    }
  }
  for (int pi = bid; pi < N_CC / 2; pi += G) {
    const int idx = 2 * pi + half;
    {
      int e0 = idx * 2048 + tid * 8;
#pragma unroll 8
      for (int j = 0; j < 8; ++j) {
        int e = e0 + j;
        if (e < 589824 && (e < 262144 || e >= 524288)) {
          const bool isA = e < 262144; const int q = isA ? e : e - 524288;
          const int x = q & 7, ln = (q >> 3) & 63, sub = (q >> 9) & 3, T = (q >> 11) & 7, bh = q >> 14;
          const int key = T * 32 + (ln & 31), d = sub * 16 + (ln >> 5) * 8 + x;
          const float v = (isA ? p.cache_a_k : p.cache_d_k)[(bh * 256 + key) * 64 + d];
          (isA ? p.CAK : p.CDK)[q] = f2bf(v);
        } else if (e < 655360) {
          const bool isA = e < 524288; const int q = isA ? e - 262144 : e - 589824;
          const int x = q & 7, ln = (q >> 3) & 63, sub = (q >> 9) & 3, T = (q >> 11) & 7, bh = q >> 14;
          const int dim = (sub >> 1) * 32 + (ln & 31), key = T * 32 + 16 * (sub & 1) + 8 * (x >> 2) + 4 * (ln >> 5) + (x & 3);
          const float v = (isA ? p.cache_a_v : p.cache_d_v)[(bh * 256 + key) * 64 + dim];
          (isA ? p.CAVT : p.CDVT)[q] = f2bf(v);
        }
        else { int q = e - 655360; int n = q >> 9, k = q & 511; if ((n >> 7) != (k >> 7)) p.POOLW[q] = 0; }
      }
    }
  }
}

template <int RMODE>
__device__ void r_phase(const P& p, bool first_unused, bool hasT_unused, const float* gT, const float* modg, int gate_idx, float gscale,
                        bool writeH, const float* g2, const float* modn, int shift_idx, int scale_idx, float* xdst, int gw, int W, int tidx) {
  const int lane = tidx & 63;
  constexpr bool first = RMODE == 0, hasT = RMODE != 0;
  constexpr int NR = 6;
  for (int t0 = gw; t0 < MTOK; t0 += NR * W) {
    float4 xf[NR][4];
    uint2 xq[NR][4], tq[NR][4];
#pragma unroll
    for (int r = 0; r < NR; ++r) {
      const int t = t0 + r * W;
      if (t < MTOK) {
        if (first) {
          const float* xs = t < MPR ? p.x_prompt + (size_t)t * DM : p.x_sample + (size_t)(t - MPR) * DM;
#pragma unroll
          for (int j = 0; j < 4; ++j) xf[r][j] = *(const float4*)(xs + lane * 4 + 256 * j);
        } else {
          const u16* xs = (const u16*)p.X + (size_t)t * DM;
          const u16* ts = (const u16*)p.T + (size_t)t * DM;
#pragma unroll
          for (int j = 0; j < 4; ++j) { xq[r][j] = *(const uint2*)(xs + lane * 4 + 256 * j); tq[r][j] = *(const uint2*)(ts + lane * 4 + 256 * j); }
        }
      }
    }
#pragma unroll
    for (int r = 0; r < NR; ++r) {
      const int t = t0 + r * W;
      if (t < MTOK) {
        const int ci = t < MPR ? 0 : 1 + ((t - MPR) >> 11);
        float4 x[4];
        if (first) {
#pragma unroll
          for (int j = 0; j < 4; ++j) x[j] = xf[r][j];
        } else {
#pragma unroll
          for (int j = 0; j < 4; ++j) x[j] = make_float4(bflo(xq[r][j].x), bfhi(xq[r][j].x), bflo(xq[r][j].y), bfhi(xq[r][j].y));
        }
        if (hasT) {
          float4 tv[4];
          float ss = 0.f;
#pragma unroll
          for (int j = 0; j < 4; ++j) {
            tv[j] = make_float4(bflo(tq[r][j].x), bfhi(tq[r][j].x), bflo(tq[r][j].y), bfhi(tq[r][j].y));
            ss += tv[j].x * tv[j].x + tv[j].y * tv[j].y + tv[j].z * tv[j].z + tv[j].w * tv[j].w;
          }
          ss = wave_sum(ss);
          const float rs = rsqrtf(ss * (1.f / 1024.f) + 1e-6f) * gscale;
          const float* mg = modg + ci * 9216 + gate_idx * 1024;
#pragma unroll
          for (int j = 0; j < 4; ++j) {
            int c = lane * 4 + 256 * j;
            float4 g4 = *(const float4*)(gT + c), m4 = *(const float4*)(mg + c);
            x[j].x += m4.x * (tv[j].x * rs * g4.x); x[j].y += m4.y * (tv[j].y * rs * g4.y);
            x[j].z += m4.z * (tv[j].z * rs * g4.z); x[j].w += m4.w * (tv[j].w * rs * g4.w);
          }
        }
        if (RMODE == 2) {
#pragma unroll
          for (int j = 0; j < 4; ++j) *(float4*)(xdst + (size_t)t * DM + lane * 4 + 256 * j) = x[j];
        } else {
#pragma unroll
          for (int j = 0; j < 4; ++j) {
            uint2 o; o.x = pack2(x[j].x, x[j].y); o.y = pack2(x[j].z, x[j].w);
            *(uint2*)((u16*)xdst + (size_t)t * DM + lane * 4 + 256 * j) = o;
          }
          float ss = 0.f;
#pragma unroll
          for (int j = 0; j < 4; ++j) ss += x[j].x * x[j].x + x[j].y * x[j].y + x[j].z * x[j].z + x[j].w * x[j].w;
          ss = wave_sum(ss);
          const float r2 = rsqrtf(ss * (1.f / 1024.f) + 1e-6f);
          const float* sh = modn + ci * 9216 + shift_idx * 1024;
          const float* sc = modn + ci * 9216 + scale_idx * 1024;
#pragma unroll
          for (int j = 0; j < 4; ++j) {
            int c = lane * 4 + 256 * j;
            float4 g4 = *(const float4*)(g2 + c), s4 = *(const float4*)(sc + c), h4 = *(const float4*)(sh + c);
            float h0 = x[j].x * r2 * g4.x * (1.f + s4.x) + h4.x;
            float h1 = x[j].y * r2 * g4.y * (1.f + s4.y) + h4.y;
            float h2 = x[j].z * r2 * g4.z * (1.f + s4.z) + h4.z;
            float h3 = x[j].w * r2 * g4.w * (1.f + s4.w) + h4.w;
            uint2 o; o.x = pack2(h0, h1); o.y = pack2(h2, h3);
            *(uint2*)(p.H + (size_t)t * DM + c) = o;
          }
        }
      }
    }
  }
}

enum { EPI_SWIGLU = 0, EPI_F32 = 1, EPI_EVIN = 2, EPI_ODIN = 3, EPI_POOL = 4, EPI_RES = 5 };
struct ResArgs { const float* gT; const float* modg; const float* g2; const float* modn; int gate; int shi; float gs; int kuse; int fin; };
using f32x4 = __attribute__((ext_vector_type(4))) float;

DI int lds_byte2(int r, int c) {
  int st = (r >> 4) * 2 + (c >> 5), ob = (r & 15) * 64 + (c & 31) * 2;
  return st * 1024 + (ob ^ (((ob >> 9) & 1) << 5));
}
DI void stage_rc2(int b, int& R, int& C) {
  int st = b >> 10, sb = b & 1023, swz = sb ^ (((sb >> 9) & 1) << 5);
  R = (st >> 1) * 16 + (swz >> 6);
  C = (st & 1) * 32 + ((swz & 63) >> 1);
}
#define WAIT_V0() asm volatile("s_waitcnt vmcnt(0)" ::: "memory")

#define LDS_RD4(a, b, c, d, addr, o0, o1, o2, o3) asm volatile( \
    "ds_read_b128 %0, %4 offset:%5\n\tds_read_b128 %1, %4 offset:%6\n\tds_read_b128 %2, %4 offset:%7\n\tds_read_b128 %3, %4 offset:%8\n\ts_waitcnt lgkmcnt(0)" \
    : "=&v"(a), "=&v"(b), "=&v"(c), "=&v"(d) : "v"(addr), "n"(o0), "n"(o1), "n"(o2), "n"(o3) : "memory")
template <int EPI, int MF, bool TAIL = false>
__device__ __forceinline__ void gemm_phase(const P& p, const u16* __restrict__ A, const u16* __restrict__ Bt, int K,
                                           int nMT, int nNT, void* outp, int ldc, char* smem, int vbid, int G, int tidx, int tlimit = 1 << 30, int tbase = 0, ResArgs ra = ResArgs{}) {
  constexpr int TILE_B = 32768, STAGE_B = 65536;
  const int wid = __builtin_amdgcn_readfirstlane(tidx >> 6), lane = tidx & 63, wr = wid >> 2, wc = wid & 3, fr = lane & 15, fq = lane >> 4;
  int sOff0;
  { int R, C; stage_rc2(wid * 1024 + lane * 16, R, C); sOff0 = R * K + C; }
  const unsigned sOffB = (unsigned)sOff0 * 2u;
  const int aOff0 = lds_byte2(wr * (16 * MF) + fr, fq * 8);
  const int bOff0 = lds_byte2(wc * 64 + fr, fq * 8);
  const int ntiles = TAIL ? tlimit : min(nMT * nNT, tlimit), nt = K >> 6;
#define GLDS_STAGE(AB, BB, buf, kt) do { _Pragma("unroll") for (int i = 0; i < 4; ++i) { \
      if (wid + 8 * i < 4 * MF) __builtin_amdgcn_global_load_lds((const unsigned*)((const char*)((AB) + (size_t)(i * 64) * K + (kt) * 64) + sOffCur), (unsigned*)(smem + (buf) * STAGE_B + wid * 1024 + i * 8192), 16, 0, 0); \
      __builtin_amdgcn_global_load_lds((const unsigned*)((const char*)((BB) + (size_t)(i * 64) * K + (kt) * 64) + sOffCur), (unsigned*)(smem + (buf) * STAGE_B + TILE_B + wid * 1024 + i * 8192), 16, 0, 0); } } while (0)
#define TILE_COORDS(T, BR, BC) do { const int ts_ = TAIL ? tbase + ((T) >> 1) : (T); \
      const int grp_ = ts_ / (8 * nNT), r2_ = ts_ - grp_ * 8 * nNT; \
      BR = (grp_ * 8 + (r2_ & 7)) * (TAIL ? 192 : 32 * MF) + (TAIL ? ((T) & 1) * 96 : 0); BC = (r2_ >> 3) * 256; } while (0)
  if (vbid < ntiles) {
    unsigned sOffCur = sOffB; asm volatile("" : "+v"(sOffCur));
    int br_, bc_; TILE_COORDS(vbid, br_, bc_);
    GLDS_STAGE(A + (size_t)br_ * K, Bt + (size_t)bc_ * K, 0, 0);
  }
  for (int tile = vbid; tile < ntiles; tile += G) {
    int brow, bcol; TILE_COORDS(tile, brow, bcol);
    unsigned sOffCur = sOffB; asm volatile("" : "+v"(sOffCur));
    const u16* Ab = A + (size_t)brow * K;
    const u16* Bb = Bt + (size_t)bcol * K;
    f32x4 acc[MF][4];
#pragma unroll
    for (int m = 0; m < MF; ++m)
#pragma unroll
      for (int n = 0; n < 4; ++n) { acc[m][n][0] = 0.f; acc[m][n][1] = 0.f; acc[m][n][2] = 0.f; acc[m][n][3] = 0.f; }
#define LDS_RD(dst, base, off) asm volatile("ds_read_b128 %0, %1 offset:%2" : "=v"(dst) : "v"(base), "n"(off))
    bf16x8 A0[MF], B0[4], A1[MF], B1[4];
    const unsigned lbase = (unsigned)(size_t)(smem);
    WAIT_V0(); __syncthreads();
    if (nt > 1) GLDS_STAGE(Ab, Bb, 1, 1);
    asm volatile("s_waitcnt lgkmcnt(0)" ::: "memory");
    {
      const unsigned la = lbase + aOff0, lb = lbase + TILE_B + bOff0;
#pragma unroll
      for (int n = 0; n < 4; ++n) LDS_RD(B0[n], lb, n * 2048);
#pragma unroll
      for (int m = 0; m < MF; ++m) LDS_RD(A0[m], la, m * 2048);
    }
    for (int t = 0; t < nt; ++t) {
      const int cur = t & 1;
      const unsigned la = lbase + cur * STAGE_B + aOff0, lb = lbase + cur * STAGE_B + TILE_B + bOff0;
      const unsigned lan = lbase + (cur ^ 1) * STAGE_B + aOff0, lbn = lbase + (cur ^ 1) * STAGE_B + TILE_B + bOff0;
#pragma unroll
      for (int n = 0; n < 4; ++n) LDS_RD(B1[n], lb, n * 2048 + 1024);
#pragma unroll
      for (int m = 0; m < MF; ++m) LDS_RD(A1[m], la, m * 2048 + 1024);
      __builtin_amdgcn_sched_barrier(0);
#pragma unroll
      for (int m = 0; m < MF; ++m) {
        if (m == 0) asm volatile("s_waitcnt lgkmcnt(%5)" : "+v"(A0[0]), "+v"(B0[0]), "+v"(B0[1]), "+v"(B0[2]), "+v"(B0[3]) : "n"(4 + MF + MF - 1));
        else asm volatile("s_waitcnt lgkmcnt(%1)" : "+v"(A0[m]) : "n"(4 + MF + MF - 1 - m));
#pragma unroll
        for (int n = 0; n < 4; ++n) acc[m][n] = __builtin_amdgcn_mfma_f32_16x16x32_bf16(A0[m], B0[n], acc[m][n], 0, 0, 0);
        __builtin_amdgcn_sched_barrier(0);
      }
      if (MF == 3) asm volatile("s_waitcnt lgkmcnt(0)" : "+v"(A1[0]), "+v"(A1[1]), "+v"(A1[MF - 1]), "+v"(B1[0]), "+v"(B1[1]), "+v"(B1[2]), "+v"(B1[3]));
      else if (MF == 6) asm volatile("s_waitcnt lgkmcnt(0)" : "+v"(A1[0]), "+v"(A1[1]), "+v"(A1[2]), "+v"(A1[3]), "+v"(A1[4]), "+v"(A1[MF - 1]), "+v"(B1[0]), "+v"(B1[1]), "+v"(B1[2]), "+v"(B1[3]));
      else asm volatile("s_waitcnt lgkmcnt(0)" : "+v"(A1[0]), "+v"(A1[1]), "+v"(A1[2]), "+v"(A1[3]), "+v"(A1[4]), "+v"(A1[5]), "+v"(A1[MF - 2]), "+v"(A1[MF - 1]), "+v"(B1[0]), "+v"(B1[1]), "+v"(B1[2]), "+v"(B1[3]));
      WAIT_V0(); __syncthreads();
      if (t + 2 < nt) { GLDS_STAGE(Ab, Bb, cur, t + 2); }
      else if (t + 1 == nt && tile + G < ntiles) {
        int br_, bc_; TILE_COORDS(tile + G, br_, bc_);
        GLDS_STAGE(A + (size_t)br_ * K, Bt + (size_t)bc_ * K, 0, 0);
      }
      if (t + 1 < nt) {
#pragma unroll
        for (int n = 0; n < 4; ++n) LDS_RD(B0[n], lbn, n * 2048);
#pragma unroll
        for (int m = 0; m < MF; ++m) LDS_RD(A0[m], lan, m * 2048);
      }
      __builtin_amdgcn_sched_barrier(0);
#pragma unroll
      for (int m = 0; m < MF; ++m) {
#pragma unroll
        for (int n = 0; n < 4; ++n) acc[m][n] = __builtin_amdgcn_mfma_f32_16x16x32_bf16(A1[m], B1[n], acc[m][n], 0, 0, 0);
      }
      __builtin_amdgcn_sched_barrier(0);
    }
#undef LDS_RD
    unsigned zl_ = 0u; asm volatile("" : "+v"(zl_));
    const int le = (int)__builtin_amdgcn_mbcnt_hi(~0u, __builtin_amdgcn_mbcnt_lo(~0u, zl_));
    const int fre = le & 15, fqe = le >> 4;
    float* Ew = (float*)(smem + STAGE_B + wid * 4352);
    const int r0 = brow + wr * (16 * MF), c0 = bcol + wc * 64;
    if (EPI == EPI_RES) {
      const int te = wid * 64 + le;
      float* rp = (float*)(smem + STAGE_B + 8 * 4352);
      float* rstat = rp + 192 * 4;
      const int mt = brow / 192, ntl = bcol >> 8;
      unsigned* flag = p.BAR + 3456 + mt * 32;
      const unsigned target = 4u * (unsigned)(ra.kuse + 1);
      float* xch0 = p.XCH + (size_t)brow * 4;
      float* xch1 = p.XCH + (size_t)(12288 + brow) * 4;
#define XCH_ST(ptr, v) __hip_atomic_store((ptr), (v), __ATOMIC_RELAXED, __HIP_MEMORY_SCOPE_AGENT)
#define XCH_LD(ptr) __hip_atomic_load((ptr), __ATOMIC_RELAXED, __HIP_MEMORY_SCOPE_AGENT)
#define ROW_ARRIVE(FL) do { \
        asm volatile("s_waitcnt vmcnt(0)" ::: "memory"); \
        __syncthreads(); \
        if (te == 0) (void)__hip_atomic_fetch_add((FL), 1u, __ATOMIC_RELAXED, __HIP_MEMORY_SCOPE_AGENT); } while (0)
#define ROW_WAIT(FL) do { \
        if (te == 0) { unsigned sp_ = 0; \
          while (__hip_atomic_load((FL), __ATOMIC_RELAXED, __HIP_MEMORY_SCOPE_AGENT) < target) { __builtin_amdgcn_s_sleep(1); if (++sp_ > (1u << 22)) break; } } \
        __syncthreads(); } while (0)
#define ROW_EXCHANGE(FL) do { \
        asm volatile("s_waitcnt vmcnt(0)" ::: "memory"); \
        __syncthreads(); \
        if (te == 0) { \
          (void)__hip_atomic_fetch_add((FL), 1u, __ATOMIC_RELAXED, __HIP_MEMORY_SCOPE_AGENT); \
          unsigned sp_ = 0; \
          while (__hip_atomic_load((FL), __ATOMIC_RELAXED, __HIP_MEMORY_SCOPE_AGENT) < target) { __builtin_amdgcn_s_sleep(1); if (++sp_ > (1u << 22)) break; } \
        } \
        __syncthreads(); } while (0)
      const int c4 = (le & 15) * 4;
      u16* X16 = (u16*)p.X;
      uint2 xpre[MF][4];
      float4 mgpre[MF];
#pragma unroll
      for (int m = 0; m < MF; ++m) {
        const int rm = r0 + m * 16;
        const int ci = rm < MPR ? 0 : 1 + ((rm - MPR) >> 11);
        mgpre[m] = *(const float4*)(ra.modg + ci * 9216 + ra.gate * 1024 + c0 + c4);
#pragma unroll
        for (int ps = 0; ps < 4; ++ps)
          xpre[m][ps] = *(const uint2*)(X16 + (size_t)(brow + wr * 96 + m * 16 + (le >> 4) + 4 * ps) * DM + c0 + c4);
      }
#pragma unroll
      for (int m = 0; m < MF; ++m)
#pragma unroll
        for (int j = 0; j < 4; ++j) {
          float s = acc[m][0][j] * acc[m][0][j] + acc[m][1][j] * acc[m][1][j] + acc[m][2][j] * acc[m][2][j] + acc[m][3][j] * acc[m][3][j];
          s = row16_sum(s);
          if (fre == 0) rp[(wr * 96 + m * 16 + fqe * 4 + j) * 4 + wc] = s;
        }
      __syncthreads();
      if (te < 192) XCH_ST(xch0 + te * 4 + ntl, rp[te * 4] + rp[te * 4 + 1] + rp[te * 4 + 2] + rp[te * 4 + 3]);
      ROW_ARRIVE(flag);
      f32x4 tq[MF][4];
#pragma unroll
      for (int m = 0; m < MF; ++m) {
#pragma unroll
        for (int n = 0; n < 4; ++n)
#pragma unroll
          for (int j = 0; j < 4; ++j) Ew[(fqe * 4 + j) * 68 + n * 16 + fre] = acc[m][n][j];
        LDS_RD4(tq[m][0], tq[m][1], tq[m][2], tq[m][3], (unsigned)(size_t)(Ew + (le >> 4) * 68 + c4), 0, 1088, 2176, 3264);
      }
      ROW_WAIT(flag);
      if (te < 192) { const float qs = XCH_LD(xch0 + te * 4) + XCH_LD(xch0 + te * 4 + 1) + XCH_LD(xch0 + te * 4 + 2) + XCH_LD(xch0 + te * 4 + 3); rstat[te] = rsqrtf(qs * (1.f / 1024.f) + 1e-6f) * ra.gs; }
      __syncthreads();
      const float4 gT4 = *(const float4*)(ra.gT + c0 + c4);
      float4 xn[MF][4];
#pragma unroll
      for (int m = 0; m < MF; ++m) {
        const int rm = r0 + m * 16;
        const int ci = rm < MPR ? 0 : 1 + ((rm - MPR) >> 11);
        const float4 mg4 = mgpre[m];
#pragma unroll
        for (int ps = 0; ps < 4; ++ps) {
          const f32x4 qv = tq[m][ps];
          const int rl = wr * 96 + m * 16 + (le >> 4) + 4 * ps;
          const size_t ro = (size_t)(brow + rl) * DM + c0 + c4;
          const float rs = rstat[rl];
          const uint2 xq = xpre[m][ps];
          float4 y;
          y.x = bflo(xq.x) + mg4.x * (qv[0] * rs * gT4.x); y.y = bfhi(xq.x) + mg4.y * (qv[1] * rs * gT4.y);
          y.z = bflo(xq.y) + mg4.z * (qv[2] * rs * gT4.z); y.w = bfhi(xq.y) + mg4.w * (qv[3] * rs * gT4.w);
          xn[m][ps] = y;
          if (ra.fin) { *(float4*)(p.out + ro) = y; }
          else {
            uint2 o; o.x = pack2(y.x, y.y); o.y = pack2(y.z, y.w);
            *(uint2*)(X16 + ro) = o;
            float s = y.x * y.x + y.y * y.y + y.z * y.z + y.w * y.w;
            s = row16_sum(s);
            if ((le & 15) == 0) rp[rl * 4 + wc] = s;
          }
        }
      }
      float4 shpre[MF], scpre[MF];
      float4 g24 = make_float4(0.f, 0.f, 0.f, 0.f);
      if (!ra.fin) {
        g24 = *(const float4*)(ra.g2 + c0 + c4);
#pragma unroll
        for (int m = 0; m < MF; ++m) {
          const int rm = r0 + m * 16;
          const int ci = rm < MPR ? 0 : 1 + ((rm - MPR) >> 11);
          shpre[m] = *(const float4*)(ra.modn + ci * 9216 + ra.shi * 1024 + c0 + c4);
          scpre[m] = *(const float4*)(ra.modn + ci * 9216 + (ra.shi + 1) * 1024 + c0 + c4);
        }
      }
      if (!ra.fin) {
        __syncthreads();
        if (te < 192) XCH_ST(xch1 + te * 4 + ntl, rp[te * 4] + rp[te * 4 + 1] + rp[te * 4 + 2] + rp[te * 4 + 3]);
        ROW_EXCHANGE(flag + 16);
        if (te < 192) { const float qs = XCH_LD(xch1 + te * 4) + XCH_LD(xch1 + te * 4 + 1) + XCH_LD(xch1 + te * 4 + 2) + XCH_LD(xch1 + te * 4 + 3); rstat[te] = rsqrtf(qs * (1.f / 1024.f) + 1e-6f); }
        __syncthreads();
#pragma unroll
        for (int m = 0; m < MF; ++m) {
          const float4 sh4 = shpre[m], sc4 = scpre[m];
#pragma unroll
          for (int ps = 0; ps < 4; ++ps) {
            const int rl = wr * 96 + m * 16 + (le >> 4) + 4 * ps;
            const float r2 = rstat[rl];
            const float4 y = xn[m][ps];
            uint2 o;
            o.x = pack2(y.x * r2 * g24.x * (1.f + sc4.x) + sh4.x, y.y * r2 * g24.y * (1.f + sc4.y) + sh4.y);
            o.y = pack2(y.z * r2 * g24.z * (1.f + sc4.z) + sh4.z, y.w * r2 * g24.w * (1.f + sc4.w) + sh4.w);
            *(uint2*)(p.H + (size_t)(brow + rl) * DM + c0 + c4) = o;
          }
        }
      }
#undef ROW_EXCHANGE
#undef ROW_ARRIVE
#undef ROW_WAIT
#undef XCH_ST
#undef XCH_LD
      continue;
    }
    constexpr int vlo = (EPI == EPI_EVIN) ? 1024 : 1152, vhi = (EPI == EPI_EVIN) ? 1536 : 1280;
    const bool isV = (EPI == EPI_EVIN || EPI == EPI_ODIN) && c0 >= vlo && c0 < vhi;
    float* sbase = nullptr; int hd = 0, nh = 8;
    if (EPI == EPI_EVIN) {
      if (c0 >= 512 && c0 < 1024) { sbase = p.out + OFF_SAK; hd = (c0 - 512) >> 6; }
      else if (c0 >= 1024 && c0 < 1536) { sbase = p.out + OFF_SAV; hd = (c0 - 1024) >> 6; }
    } else if (EPI == EPI_ODIN) {
      nh = 2;
      if (c0 >= 1152 && c0 < 1280) { sbase = p.out + OFF_SDV; hd = (c0 - 1152) >> 6; }
    }
    const int c4 = (le & 15) * 4;
    float4 psc = make_float4(1.f, 1.f, 1.f, 1.f);
    if (EPI == EPI_POOL) psc = *(const float4*)(p.od_pool_scale + c0 + c4);
    constexpr int ESZ = 2;
    char* orow = (EPI == EPI_SWIGLU)
        ? (char*)outp + ((size_t)(r0 + (le >> 3)) * ldc + (c0 >> 1) + (le & 7) * 4) * 2
        : (char*)outp + ((size_t)(r0 + (le >> 4)) * ldc + c0 + c4) * ESZ;
    const size_t rstride = (size_t)ldc * ESZ;
#pragma unroll
    for (int m = 0; m < MF; ++m) {
      asm volatile("" : "+v"(orow));
      const int rm = r0 + m * 16;
      float* srow = (sbase && rm < MPR) ? sbase + ((size_t)((rm >> 8) * nh + hd) * 256 + (rm & 255) + (le >> 4)) * 64 + c4 : nullptr;
      if (EPI == EPI_EVIN || EPI == EPI_ODIN) {
        if (isV) {
          const int t0 = rm + fqe * 4, kk16 = t0 & 15;
          u16* vb = p.VT + ((size_t)(((c0 - vlo) >> 6) * 384 + (t0 >> 5)) * 4 + ((t0 >> 4) & 1)) * 512 + (((kk16 >> 2) & 1) * 32) * 8 + (kk16 >> 3) * 4;
#pragma unroll
          for (int n = 0; n < 4; ++n) {
            const int dim = n * 16 + fre;
            uint2 o; o.x = pack2(acc[m][n][0], acc[m][n][1]); o.y = pack2(acc[m][n][2], acc[m][n][3]);
            *(uint2*)(vb + (dim >> 5) * 1024 + (dim & 31) * 8) = o;
          }
        }
      }
      if (EPI != EPI_SWIGLU) {
#pragma unroll
      for (int n = 0; n < 4; ++n)
#pragma unroll
        for (int j = 0; j < 4; ++j) Ew[(fqe * 4 + j) * 68 + n * 16 + fre] = acc[m][n][j];
      }
      if (EPI == EPI_EVIN) {
        if (c0 >= 512 && c0 < 1024) {
#pragma unroll
          for (int ps = 0; ps < 2; ++ps) {
            const int slot = le + 64 * ps, row = slot >> 3, ch = slot & 7;
            const float4 a = *(const float4*)(Ew + row * 68 + ch * 8), b4 = *(const float4*)(Ew + row * 68 + ch * 8 + 4);
            uint4 o; o.x = pack2(a.x, a.y); o.y = pack2(a.z, a.w); o.z = pack2(b4.x, b4.y); o.w = pack2(b4.z, b4.w);
            const int t = rm + row;
            *(uint4*)(p.KF + ((size_t)(((c0 - 512) >> 6) * 384 + (t >> 5)) * 4 + (ch >> 1)) * 512 + ((ch & 1) * 32 + (t & 31)) * 8) = o;
          }
        }
      }
      if (EPI == EPI_SWIGLU) {
        u16* ab = (u16*)outp + (size_t)(rm + fqe * 4) * ldc + (c0 >> 1) + fre;
#pragma unroll
        for (int j = 0; j < 4; ++j)
#pragma unroll
          for (int n = 0; n < 2; ++n) {
            const float g = acc[m][n][j], u = acc[m][n + 2][j];
            ab[(size_t)j * ldc + n * 16] = (u16)pack2(g * u * __builtin_amdgcn_rcpf(1.f + __expf(-g)), 0.f);
          }
      } else {
        f32x4 q0, q1, q2, q3;
        LDS_RD4(q0, q1, q2, q3, (unsigned)(size_t)(Ew + (le >> 4) * 68 + c4), 0, 1088, 2176, 3264);
#pragma unroll
        for (int ps = 0; ps < 4; ++ps) {
          const f32x4 qv = ps == 0 ? q0 : (ps == 1 ? q1 : (ps == 2 ? q2 : q3));
          float4 v = make_float4(qv[0], qv[1], qv[2], qv[3]);
          if (EPI == EPI_F32) {
            uint2 o; o.x = pack2(v.x, v.y); o.y = pack2(v.z, v.w);
            *(uint2*)(orow + (size_t)(4 * ps) * rstride) = o;
          } else if (EPI == EPI_POOL) {
            uint2 o; o.x = pack2(v.x * psc.x, v.y * psc.y); o.y = pack2(v.z * psc.z, v.w * psc.w);
            *(uint2*)(orow + (size_t)(4 * ps) * rstride) = o;
          } else {
            uint2 o; o.x = pack2(v.x, v.y); o.y = pack2(v.z, v.w);
            *(uint2*)(orow + (size_t)(4 * ps) * rstride) = o;
            if (srow) *(float4*)(srow + (4 * ps) * 64) = v;
          }
        }
      }
      orow += 16 * rstride;
    }
  }
#undef GLDS_STAGE
#undef TILE_COORDS
  __syncthreads();
}

struct Seg { const u16* KF; const u16* VF; int n; };

template <bool BIAS>
__device__ __forceinline__ void attn_core(const u16* __restrict__ Q, int ldq, Seg s0, Seg s1, f32x16& o0, f32x16& o1, float& m, float& l,
                                          const float* __restrict__ rpb_h, int qr, int qc0, int rs, int tidx) {
  const int lane = tidx & 63, l31 = lane & 31, lh = lane >> 5;
  bf16x8 bq[4];
#pragma unroll
  for (int kk = 0; kk < 4; ++kk) bq[kk] = *(const bf16x8*)(Q + (size_t)l31 * ldq + kk * 16 + lh * 8);
  m = -1e30f; l = 0.f;
#pragma unroll
  for (int e = 0; e < 16; ++e) { o0[e] = 0.f; o1[e] = 0.f; }
  const int qc = qc0 + l31;
  const int cs = min(max(qc - 8, 0), 48);
  const int nt0 = s0.n >> 5, ntot = nt0 + (s1.n >> 5);
  const u16* k0p = s0.KF + lane * 8;
  const u16* k1p = s1.KF + lane * 8;
  const u16* v0p = s0.VF + lane * 8;
  const u16* v1p = s1.VF + lane * 8;
  bf16x8 kA[4], kB[4], vA[4], vB[4];
#define KLOAD(dst, i_) do { const int j_ = min((i_), ntot - 1); const bool n1_ = j_ >= nt0; \
    const u16* Kp_ = n1_ ? k1p + (size_t)(j_ - nt0) * 2048 : k0p + (size_t)j_ * 2048; \
    _Pragma("unroll") for (int kk = 0; kk < 4; ++kk) dst[kk] = *(const bf16x8*)(Kp_ + kk * 512); } while (0)
#define VLOAD(dst, i_) do { const int j_ = min((i_), ntot - 1); const bool n1_ = j_ >= nt0; \
    const u16* vp_ = n1_ ? v1p + (size_t)(j_ - nt0) * 2048 : v0p + (size_t)j_ * 2048; \
    _Pragma("unroll") for (int q = 0; q < 4; ++q) dst[q] = *(const bf16x8*)(vp_ + q * 512); } while (0)
#define ATT_STEP(kf, vf, i_, kd_, vd_) do { \
    const bool in1 = (i_) >= nt0; const int kt = in1 ? (i_) - nt0 : (i_); \
    f32x16 sc; _Pragma("unroll") for (int e = 0; e < 16; ++e) sc[e] = 0.f; \
    _Pragma("unroll") for (int kk = 0; kk < 4; ++kk) sc = MFMA(kf[kk], bq[kk], sc); \
    KLOAD(kf, (i_) + (kd_)); \
    float mx = -1e30f; \
    _Pragma("unroll") for (int e = 0; e < 16; ++e) { \
      float v = sc[e] * 0.125f; \
      if (BIAS) { if (in1) { \
          const float* brow_ = rpb_h + (rs + (kt >> 1) - qr + 7) * 31;     \
          int kc = (kt & 1) * 32 + 8 * (e >> 2) + 4 * lh + (e & 3); \
          bool valid = (kc >= cs) && (kc < cs + 16); \
          unsigned co = (unsigned)min(max(kc - qc + 15, 0), 30); \
          float bv = brow_[co]; \
          v = valid ? v + bv : -1e30f; } } \
      sc[e] = v; mx = fmaxf(mx, v); \
      if (BIAS && (e & 3) == 3) __builtin_amdgcn_sched_barrier(0); } \
    mx = xor32_max(mx); \
    const float mnew = fmaxf(m, mx); \
    const float corr = __expf(m - mnew); \
    float rsum = 0.f; \
    _Pragma("unroll") for (int e = 0; e < 16; ++e) { float pv = __expf(sc[e] - mnew); sc[e] = pv; rsum += pv; } \
    rsum = xor32_sum(rsum); \
    l = l * corr + rsum; m = mnew; \
    _Pragma("unroll") for (int e = 0; e < 16; ++e) { o0[e] *= corr; o1[e] *= corr; } \
    uint4 t0, t1; \
    t0.x = pack2(sc[0], sc[1]); t0.y = pack2(sc[2], sc[3]); t0.z = pack2(sc[4], sc[5]); t0.w = pack2(sc[6], sc[7]); \
    t1.x = pack2(sc[8], sc[9]); t1.y = pack2(sc[10], sc[11]); t1.z = pack2(sc[12], sc[13]); t1.w = pack2(sc[14], sc[15]); \
    const bf16x8 pb0 = __builtin_bit_cast(bf16x8, t0), pb1 = __builtin_bit_cast(bf16x8, t1); \
    o0 = MFMA(vf[0], pb0, o0); o0 = MFMA(vf[1], pb1, o0); \
    o1 = MFMA(vf[2], pb0, o1); o1 = MFMA(vf[3], pb1, o1); \
    VLOAD(vf, (i_) + (vd_)); } while (0)
  KLOAD(kA, 0); VLOAD(vA, 0);
  if (!BIAS) { KLOAD(kB, 1); VLOAD(vB, 1); }
#pragma unroll 1
  for (int i = 0; i < ntot; i += 2) {
    if (BIAS) {
      ATT_STEP(kA, vA, i, 1, 1);
      ATT_STEP(kA, vA, i + 1, 1, 1);
    } else {
      ATT_STEP(kA, vA, i, 2, 2);
      ATT_STEP(kB, vB, i + 1, 2, 2);
    }
  }
#undef KLOAD
#undef VLOAD
#undef ATT_STEP
}

__device__ __forceinline__ void attn_store(const f32x16& o0, const f32x16& o1, float inv, u16* __restrict__ O, int ldo, int tidx) {
  const int lane = tidx & 63, l31 = lane & 31, lh = lane >> 5;
  u16* op = O + (size_t)l31 * ldo + 4 * lh;
#pragma unroll
  for (int q4 = 0; q4 < 4; ++q4) {
    uint2 a, b;
    a.x = pack2(o0[4 * q4] * inv, o0[4 * q4 + 1] * inv); a.y = pack2(o0[4 * q4 + 2] * inv, o0[4 * q4 + 3] * inv);
    b.x = pack2(o1[4 * q4] * inv, o1[4 * q4 + 1] * inv); b.y = pack2(o1[4 * q4 + 2] * inv, o1[4 * q4 + 3] * inv);
    *(uint2*)(op + 8 * q4) = a;
    *(uint2*)(op + 32 + 8 * q4) = b;
  }
}

template <bool BIAS>
__device__ __forceinline__ void attn_unit(const u16* __restrict__ Q, int ldq, Seg s0, Seg s1, u16* __restrict__ O, int ldo,
                                          const float* __restrict__ rpb_h, int qr, int qc0, int rs, int tidx) {
  f32x16 o0, o1; float m, l;
  attn_core<BIAS>(Q, ldq, s0, s1, o0, o1, m, l, rpb_h, qr, qc0, rs, tidx);
  attn_store(o0, o1, 1.f / l, O, ldo, tidx);
}

__device__ void mix_even(const P& p, int gw, int W, int tidx) {
  const int lane = tidx & 63;
  const u16* U = p.ACTU;
  u16* MO = p.H;
  for (int u0 = gw; u0 < 2048 + MTOK; u0 += W) {
   for (int sub = 0; sub < 2; ++sub) {
    int u;
    if (u0 < 1024) { if (sub) break; u = u0; }
    else if (u0 < 2048) { u = 1024 + 2 * (u0 - 1024) + sub; }
    else if (W != 2048) { if (sub) break; u = u0 + 1024; }
    else {
      if (gw < 1024) break;
      u = 3072 + (gw - 1024) + (2 * ((u0 - 2048) / W) + sub) * 1024;
    }
    if (u < 1024) {
      int b = u >> 9, h = (u >> 6) & 7, r = (u >> 1) & 31, hf = u & 1;
      int tb = MPR + b * 2048;
      int rs = min(max(r - 4, 0), 24);
      Seg s0 = { p.CAK + (size_t)((b * 8 + h) * 8) * 2048, p.CAVT + (size_t)((b * 8 + h) * 8) * 2048, 256 };
      const size_t lt = (size_t)(h * 384 + ((tb + rs * 64) >> 5)) * 2048;
      Seg s1 = { p.KF + lt, p.VT + lt, 512 };
      int q0 = tb + r * 64 + hf * 32;
      attn_unit<true>(U + (size_t)q0 * 3072 + h * 64, 3072, s0, s1, MO + (size_t)q0 * DM + h * 64, DM, p.ev_rpb + h * 465, r, hf * 32, rs, tidx);
    } else if (u < 3072) {
      int v = u - 1024; int b = v >> 6, h = (v >> 3) & 7, qb = v & 7;
      const size_t lt = (size_t)(h * 384 + b * 8) * 2048;
      Seg s0 = { p.KF + lt, p.VT + lt, 256 };
      Seg s1 = { s0.KF, s0.VF, 0 };
      int q0 = b * 256 + qb * 32;
      attn_unit<false>(U + (size_t)q0 * 3072 + h * 64, 3072, s0, s1, MO + (size_t)q0 * DM + h * 64, DM, nullptr, 0, 0, 0, tidx);
    } else {
      int t = u - 3072;
      int s, L;
      if (t < MPR) { s = t & 255; L = 256; } else { s = (t - MPR) & 2047; L = 2048; }
      const int c = lane * 8;
      float z[3][8];
#pragma unroll
      for (int d = 0; d < 3; ++d) {
        int sd = s + d - 1;
        if (sd >= 0 && sd < L) {
          const u16* row = U + (size_t)(t + d - 1) * 3072;
          uint4 cg4 = *(const uint4*)(row + 2048 + c), xb4 = *(const uint4*)(row + 2560 + c);
          z[d][0] = bflo(cg4.x) * bflo(xb4.x); z[d][1] = bfhi(cg4.x) * bfhi(xb4.x);
          z[d][2] = bflo(cg4.y) * bflo(xb4.y); z[d][3] = bfhi(cg4.y) * bfhi(xb4.y);
          z[d][4] = bflo(cg4.z) * bflo(xb4.z); z[d][5] = bfhi(cg4.z) * bfhi(xb4.z);
          z[d][6] = bflo(cg4.w) * bflo(xb4.w); z[d][7] = bfhi(cg4.w) * bfhi(xb4.w);
        } else {
#pragma unroll
          for (int j = 0; j < 8; ++j) z[d][j] = 0.f;
        }
      }
      uint4 bg4 = *(const uint4*)(U + (size_t)t * 3072 + 1536 + c);
      float bg[8] = { bflo(bg4.x), bfhi(bg4.x), bflo(bg4.y), bfhi(bg4.y), bflo(bg4.z), bfhi(bg4.z), bflo(bg4.w), bfhi(bg4.w) };
      float y[8];
#pragma unroll
      for (int j = 0; j < 8; ++j) {
        float w0 = p.ev_conv_w[c + j], w1 = p.ev_conv_w[512 + c + j], w2 = p.ev_conv_w[1024 + c + j];
        y[j] = bg[j] * (z[0][j] * w0 + z[1][j] * w1 + z[2][j] * w2 + p.ev_conv_b[c + j]);
      }
      uint4 o; o.x = pack2(y[0], y[1]); o.y = pack2(y[2], y[3]); o.z = pack2(y[4], y[5]); o.w = pack2(y[6], y[7]);
      *(uint4*)(MO + (size_t)t * DM + 512 + c) = o;
    }
   }
  }
}

__device__ void mix_odd_a(const P& p, int gw, int W, int tidx) {
  const int lane = tidx & 63;
  u16* U = p.ACTU;
  u16* POOLED = (u16*)p.T;
  const float invf = exp2f(-(float)((lane >> 1) & 15) * (13.287712379549449f / 16.f));
  for (int t = gw; t < MTOK; t += W) {
    const bool smp = t >= MPR;
    int s, L, base;
    if (!smp) { s = t & 255; L = 256; base = t - s; } else { s = (t - MPR) & 2047; L = 2048; base = t - s; }
    float cs_ = 1.f, sn_ = 0.f;
    if (smp) {
      float pos = (lane < 32) ? (float)(s >> 6) : (float)(s & 63);
      float ang = pos * invf;
      cs_ = __cosf(ang); sn_ = __sinf(ang);
    }
    u16* row = U + (size_t)t * 1280;
    const float qw = p.od_q_norm[lane], kw = p.od_k_norm[lane];
    u16 hv[10];
#pragma unroll
    for (int hd = 0; hd < 10; ++hd) hv[hd] = row[512 + hd * 64 + lane];
#pragma unroll
    for (int hd = 0; hd < 10; ++hd) {
      float v = bf2f(hv[hd]);
      float ss = wave_sum_dpp(v * v);
      float w = hd < 8 ? qw : kw;
      float nv = v * rsqrtf(ss * (1.f / 64.f) + 1e-6f) * w;
      float outv = nv;
      if (smp) {
        float pr = __builtin_bit_cast(float, __builtin_amdgcn_update_dpp(0, __builtin_bit_cast(int, nv), 0xB1, 0xF, 0xF, true));
        outv = (lane & 1) ? (pr * sn_ + nv * cs_) : (nv * cs_ - pr * sn_);
      } else if (hd >= 8) {
        int b = t >> 8;
        p.out[OFF_SDK + ((size_t)(b * 2 + (hd - 8)) * 256 + s) * 64 + lane] = nv;
      }
      if (hd < 8) row[512 + hd * 64 + lane] = (u16)pack2(outv, 0.f);
      else p.KF[((size_t)((hd - 8) * 384 + (t >> 5)) * 4 + (lane >> 4)) * 512 + (((lane >> 3) & 1) * 32 + (t & 31)) * 8 + (lane & 7)] = (u16)pack2(outv, 0.f);
    }
    {
      const int half = 1 << (lane >> 4);
      const int lo = max(s - half, 0), hi = min(s + half, L);
      const int c = lane * 8;
      float a[8];
#pragma unroll
      for (int j = 0; j < 8; ++j) a[j] = 0.f;
      uint4 wv[16];
#pragma unroll
      for (int j = 0; j < 16; ++j) {
        const int jj = lo + j;
        wv[j] = make_uint4(0u, 0u, 0u, 0u);
        if (jj < hi) wv[j] = *(const uint4*)(U + (size_t)(base + jj) * 1280 + c);
      }
#pragma unroll
      for (int j = 0; j < 16; ++j) {
        const uint4 v = wv[j];
        a[0] += bflo(v.x); a[1] += bfhi(v.x); a[2] += bflo(v.y); a[3] += bfhi(v.y);
        a[4] += bflo(v.z); a[5] += bfhi(v.z); a[6] += bflo(v.w); a[7] += bfhi(v.w);
      }
      const float rn = __builtin_amdgcn_rcpf((float)(hi - lo));
      uint4 sv = *(const uint4*)(U + (size_t)t * 1280 + c);
      uint4 o;
      o.x = pack2(a[0] * rn - bflo(sv.x), a[1] * rn - bfhi(sv.x));
      o.y = pack2(a[2] * rn - bflo(sv.y), a[3] * rn - bfhi(sv.y));
      o.z = pack2(a[4] * rn - bflo(sv.z), a[5] * rn - bfhi(sv.z));
      o.w = pack2(a[6] * rn - bflo(sv.w), a[7] * rn - bfhi(sv.w));
      *(uint4*)(POOLED + (size_t)t * 512 + c) = o;
    }
  }
}

__device__ void mix_odd_b(const P& p, int gw, int W, int tidx, char* smem) {
  const u16* U = p.ACTU;
  u16* MO = p.H;
  const int lane = tidx & 63, wave = tidx >> 6;
  for (int hu = gw; hu < 2048; hu += W) {
    const int v = hu >> 1, half = hu & 1;
    const int b = v >> 9, hq = (v >> 6) & 7, qb = v & 63, kvh = hq >> 2;
    const int tb = MPR + b * 2048;
    const size_t lt = (size_t)(kvh * 384 + (tb >> 5)) * 2048;
    Seg s0, s1;
    if (half == 0) {
      s0 = Seg{ p.CDK + (size_t)((b * 2 + kvh) * 8) * 2048, p.CDVT + (size_t)((b * 2 + kvh) * 8) * 2048, 256 };
      s1 = Seg{ p.KF + lt, p.VT + lt, 896 };
    } else {
      s0 = Seg{ p.KF + lt + (size_t)28 * 2048, p.VT + lt + (size_t)28 * 2048, 1152 };
      s1 = Seg{ p.KF + lt, p.VT + lt, 0 };
    }
    const int q0 = tb + qb * 32;
    f32x16 o0, o1; float m, l;
    attn_core<false>(U + (size_t)q0 * 1280 + 512 + hq * 64, 1280, s0, s1, o0, o1, m, l, nullptr, 0, 0, 0, tidx);
    float* cb = (float*)smem + (wave >> 1) * (34 * 64) + lane;
    if (half == 1) {
      cb[0] = m; cb[64] = l;
#pragma unroll
      for (int e = 0; e < 16; ++e) { cb[(2 + e) * 64] = o0[e]; cb[(18 + e) * 64] = o1[e]; }
    }
    __syncthreads();
    if (half == 0) {
      const float m2 = cb[0], l2 = cb[64];
      const float M = fmaxf(m, m2);
      const float a1 = __expf(m - M), a2 = __expf(m2 - M);
      const float inv = 1.f / (l * a1 + l2 * a2);
#pragma unroll
      for (int e = 0; e < 16; ++e) { o0[e] = o0[e] * a1 + cb[(2 + e) * 64] * a2; o1[e] = o1[e] * a1 + cb[(18 + e) * 64] * a2; }
      attn_store(o0, o1, inv, MO + (size_t)q0 * DM + 512 + hq * 64, DM, tidx);
    }
    __syncthreads();
  }
  for (int v = gw; v < 2048; v += W) {
    int b = v >> 6, hq = (v >> 3) & 7, qb = v & 7, kvh = hq >> 2;
    const size_t lt = (size_t)(kvh * 384 + b * 8) * 2048;
    Seg s0 = { p.KF + lt, p.VT + lt, 256 };
    Seg s1 = { s0.KF, s0.VF, 0 };
    int q0 = b * 256 + qb * 32;
    attn_unit<false>(U + (size_t)q0 * 1280 + 512 + hq * 64, 1280, s0, s1, MO + (size_t)q0 * DM + 512 + hq * 64, DM, nullptr, 0, 0, 0, tidx);
  }
}

#define XB_TMO      128
#define XB_XCNT(j)  (256  + 64 * (j))
#define XB_XSUB(j)  (1280 + 64 * (j))
#define XB_XGEN(j)  (2304 + 64 * (j))
#define XB_TOP      3328
#define XB_TOPGEN   3392
#define XCD_BAR_WORDS 3456
#define XB_SPIN_CAP (1u << 20)
#define LAS __attribute__((address_space(3)))
DI unsigned xb_ld(unsigned* p)              { return __hip_atomic_load(p, __ATOMIC_RELAXED, __HIP_MEMORY_SCOPE_AGENT); }
DI unsigned xb_add(unsigned* p, unsigned v) { return __hip_atomic_fetch_add(p, v, __ATOMIC_RELAXED, __HIP_MEMORY_SCOPE_AGENT); }
DI unsigned xb_xcc_id() { return (unsigned)__builtin_amdgcn_s_getreg((3 << 11) | 20) & 0xFu; }
#define XB_SPIN(cond, bar) do { unsigned _sp = 0; while (cond) { __builtin_amdgcn_s_sleep(1); \
    if ((++_sp & 255u) == 0u) { if (xb_ld(&(bar)[XB_TMO])) break; if (_sp > XB_SPIN_CAP) { atomicAdd(&(bar)[XB_TMO], 1u); break; } } } } while (0)
struct XcdBarrier { unsigned* bar; unsigned x; volatile LAS unsigned* st; };
DI XcdBarrier xcd_barrier_post(unsigned* bar, volatile LAS unsigned* st) {
  XcdBarrier b; b.bar = bar; b.x = xb_xcc_id(); b.st = st;
  if (threadIdx.x == 0) (void)xb_add(&bar[XB_XCNT(b.x)], 1u);
  return b;
}
DI void xcd_barrier_complete(unsigned* bar, unsigned x, unsigned& nloc, unsigned& nx) {
  const unsigned G = gridDim.x * gridDim.y * gridDim.z;
  unsigned sum, cnt, mine, sp = 0u;
  for (;;) {
    sum = 0u; cnt = 0u; mine = 0u;
#pragma unroll
    for (unsigned j = 0; j < 16; ++j) { const unsigned c = xb_ld(&bar[XB_XCNT(j)]); sum += c; cnt += (c > 0u) ? 1u : 0u; mine = (j == x) ? c : mine; }
    if (sum == G) break;
    __builtin_amdgcn_s_sleep(1);
    if ((++sp & 255u) == 0u) { if (xb_ld(&bar[XB_TMO])) break; if (sp > XB_SPIN_CAP) { atomicAdd(&bar[XB_TMO], 1u); break; } }
  }
  nloc = mine > 0u ? mine : 1u; nx = cnt > 0u ? cnt : 1u;
}
DI void xcd_barrier(const XcdBarrier& b, bool leader) {
  asm volatile("s_waitcnt vmcnt(0)" ::: "memory");
  __syncthreads();
  if (leader) {
    unsigned* bar = b.bar;
    __builtin_amdgcn_s_waitcnt(0);
    unsigned nloc = b.st[0], nx = b.st[1];
    if (nloc == 0u) { xcd_barrier_complete(bar, b.x, nloc, nx); b.st[0] = nloc; b.st[1] = nx; }
    const unsigned old = xb_add(&bar[XB_XSUB(b.x)], 1u);
    const unsigned gen = old / nloc;
    if (old + 1u == (gen + 1u) * nloc) {
      __builtin_amdgcn_fence(__ATOMIC_RELEASE, "agent");
      asm volatile("s_waitcnt vmcnt(0)" ::: "memory");
      const unsigned og = xb_add(&bar[XB_TOP], 1u);
      const unsigned tg = og / nx;
      if (og + 1u == (tg + 1u) * nx) xb_add(&bar[XB_TOPGEN], 1u);
      else XB_SPIN(xb_ld(&bar[XB_TOPGEN]) == tg, bar);
      __builtin_amdgcn_fence(__ATOMIC_ACQUIRE, "agent");
      xb_add(&bar[XB_XGEN(b.x)], 1u);
      asm volatile("s_waitcnt vmcnt(0)" ::: "memory");
    } else {
      XB_SPIN(xb_ld(&bar[XB_XGEN(b.x)]) == gen, bar);
      __builtin_amdgcn_fence(__ATOMIC_ACQUIRE, "agent");
      asm volatile("s_waitcnt vmcnt(0)" ::: "memory");
    }
  }
  __syncthreads();
}

constexpr int N_PHASES = 16;
#define GRID_SYNC() xcd_barrier(xb, wave_s == 0 && __builtin_amdgcn_mbcnt_hi(~0u, __builtin_amdgcn_mbcnt_lo(~0u, 0u)) == 0u)

#define LOADP() unsigned zop = 0u; asm volatile("" : "+v"(zop)); \
    const int tidx = wave_s * 64 + (int)__builtin_amdgcn_mbcnt_hi(~0u, __builtin_amdgcn_mbcnt_lo(~0u, zop)); \
    const int gw = vbid * (NTHR / 64) + wave_s; \
    PAK pa = pak0; asm volatile("" : "+s"(pa)); P p; \
    p.x_prompt = pa->in[0]; p.x_sample = pa->in[1]; p.cache_a_k = pa->in[2]; p.cache_a_v = pa->in[3]; p.cache_d_k = pa->in[4]; p.cache_d_v = pa->in[5]; \
    p.c = pa->in[6]; p.c_ctx = pa->in[7]; p.mod_w = pa->in[8]; p.mod_b = pa->in[9]; p.norm_w = pa->in[10]; p.ffn_w1 = pa->in[11]; p.ffn_w2 = pa->in[12]; \
    p.ev_w_in = pa->in[13]; p.ev_rpb = pa->in[14]; p.ev_conv_w = pa->in[15]; p.ev_conv_b = pa->in[16]; p.ev_w_out = pa->in[17]; \
    p.od_w_in = pa->in[18]; p.od_pool_w = pa->in[19]; p.od_pool_scale = pa->in[20]; p.od_q_norm = pa->in[21]; p.od_k_norm = pa->in[22]; p.od_w_out = pa->in[23]; \
    p.out = pa->out; \
    { char* ws = pa->ws; \
      p.W1T = (u16*)(ws + WO_W1T); p.W2T = (u16*)(ws + WO_W2T); p.EVIN = (u16*)(ws + WO_EVIN); p.EVOUT = (u16*)(ws + WO_EVOUT); \
      p.ODIN = (u16*)(ws + WO_ODIN); p.ODOUT = (u16*)(ws + WO_ODOUT); p.POOLW = (u16*)(ws + WO_POOLW); \
      p.CAK = (u16*)(ws + WO_CAK); p.CAVT = (u16*)(ws + WO_CAVT); p.CDK = (u16*)(ws + WO_CDK); p.CDVT = (u16*)(ws + WO_CDVT); \
      p.H = (u16*)(ws + WO_H); p.ACTU = (u16*)(ws + WO_ACTU); p.VT = (u16*)(ws + WO_VT); \
      p.MOD = (float*)(ws + WO_MOD); p.X = (float*)(ws + WO_X); p.T = (float*)(ws + WO_T); p.BAR = (unsigned*)(ws + WO_BAR); p.KF = (u16*)(ws + WO_KF); p.XCH = (float*)(ws + WO_XCH); }
typedef const __attribute__((address_space(4))) PA* PAK;
__global__ void __launch_bounds__(NTHR, 2) mega(PA pa_unused, int ph0, int ph1) {
  __shared__ __attribute__((aligned(1024))) char smem[LDS_BYTES];
  __shared__ uint4 xb_words;
  const int wave_s = __builtin_amdgcn_readfirstlane((int)(threadIdx.x >> 6));
  cg::grid_group grid = cg::this_grid();
  if (ph1 == 0x7fffffff) grid.sync();
  if (threadIdx.x == 0) xb_words = make_uint4(0u, 0u, 0u, 0u);
  __syncthreads();
  const PAK pak0 = (PAK)__builtin_amdgcn_kernarg_segment_ptr();
  const XcdBarrier xb = xcd_barrier_post((unsigned*)(pak0->ws + WO_BAR), (volatile LAS unsigned*)&xb_words);
  const int G = gridDim.x, bid = blockIdx.x;
  const int vbid = (G & 7) ? bid : ((bid & 7) * (G >> 3) + (bid >> 3));
  const int W = G * (NTHR / 64);
#ifndef REPMASK
#define REPMASK 0u
#endif
  for (int ph = ph0; ph < ph1; ++ph) {
   const int nrep = ((REPMASK >> ph) & 1u) ? 2 : 1;
   for (int rep = 0; rep < nrep; ++rep) {
    if (rep) { GRID_SYNC(); }
    if (ph == 0) {
      LOADP();
      prep_phase(p, smem, bid, G, tidx);
    } else if (ph == 1) {
      LOADP();
      r_phase<0>(p, true, false, nullptr, nullptr, 0, 0.f, true, p.norm_w, p.MOD, 0, 1, p.X, gw, W, tidx);
    } else {
      const int q = ph - 2;
      const int l = q / 7, s = q % 7;
#define NWMOD() const float* nw = p.norm_w + l * 6 * DM; const float* modl = p.MOD + l * 3 * 9216
      switch (s) {
        case 0: case 5: { LOADP();
          const int f = s == 0 ? 0 : 1;
          const u16* w1 = p.W1T + (size_t)(l * 2 + f) * 5632 * 1024;
          gemm_phase<EPI_SWIGLU, 6>(p, p.H, w1, 1024, 64, 22, p.ACTU, DFF, smem, vbid, G, tidx, 1280);
          gemm_phase<EPI_SWIGLU, 3, true>(p, p.H, w1, 1024, 64, 22, p.ACTU, DFF, smem, vbid, G, tidx, 256, 1280);
        } break;
        case 1: case 4: case 6: { LOADP(); NWMOD();
          const u16* A_ = s == 4 ? p.H : p.ACTU;
          const u16* B_ = s == 4 ? (l == 0 ? p.EVOUT : p.ODOUT) : p.W2T + (size_t)(l * 2 + (s == 1 ? 0 : 1)) * 1024 * 2816;
          ResArgs ra;
          ra.gT = nw + (s == 1 ? 1 : (s == 4 ? 3 : 5)) * DM;
          ra.modg = modl; ra.gate = s == 1 ? 2 : (s == 4 ? 5 : 8); ra.gs = s == 4 ? 1.0f : 0.5f;
          ra.fin = (s == 6 && l == 1) ? 1 : 0;
          ra.g2 = s == 1 ? nw + 2 * DM : (s == 4 ? nw + 4 * DM : p.norm_w + 6 * DM);
          ra.modn = s == 6 ? p.MOD + 3 * 9216 : modl;
          ra.shi = s == 1 ? 3 : (s == 4 ? 6 : 0);
          ra.kuse = 3 * l + (s == 1 ? 0 : (s == 4 ? 1 : 2));
          gemm_phase<EPI_RES, 6>(p, A_, B_, s == 4 ? 1024 : DFF, 64, 4, nullptr, DM, smem, vbid, G, tidx, 1 << 30, 0, ra);
        } break;
        case 2: { LOADP();
          if (l == 0) gemm_phase<EPI_EVIN, 6>(p, p.H, p.EVIN, 1024, 64, 12, p.ACTU, 3072, smem, vbid, G, tidx);
          else {
            gemm_phase<EPI_ODIN, 6>(p, p.H, p.ODIN, 1024, 64, 5, p.ACTU, 1280, smem, vbid, G, tidx, 256);
            gemm_phase<EPI_ODIN, 3, true>(p, p.H, p.ODIN, 1024, 64, 5, p.ACTU, 1280, smem, vbid, G, tidx, 128, 256);
            GRID_SYNC();
            mix_odd_a(p, gw, W, tidx);
          }
        } break;
        case 3: { LOADP();
          if (l == 0) mix_even(p, gw, W, tidx);
          else {
            gemm_phase<EPI_POOL, 3>(p, (const u16*)p.T, p.POOLW, 512, 128, 2, p.H, DM, smem, vbid, G, tidx);
            mix_odd_b(p, gw, W, tidx, smem);
          }
        } break;
      }
    }
   }
    if (ph + 1 < ph1) { GRID_SYNC(); }
#ifdef EXTRA_SYNCS
    if (ph == 1) { for (int es = 0; es < EXTRA_SYNCS; ++es) { GRID_SYNC(); } }
#endif
  }
}

extern "C" void kernel_launch(void* const* d_in, const int* in_sizes, int n_in, void* d_out, int out_size,
                              void* d_ws, size_t ws_size, hipStream_t stream) {
  static int grid_blocks = 0;
  if (!grid_blocks) {
    int dev = 0, cus = 0, per_cu = 0;
    hipGetDevice(&dev);
    hipDeviceGetAttribute(&cus, hipDeviceAttributeMultiprocessorCount, dev);
    hipOccupancyMaxActiveBlocksPerMultiprocessor(&per_cu, mega, NTHR, 0);
    if (per_cu > 1) per_cu = 1;
    if (per_cu < 1) per_cu = 1;
    grid_blocks = cus * per_cu;
  }
  PA p{};
  for (int i = 0; i < 24; ++i) p.in[i] = (const float*)d_in[i];
  p.out = (float*)d_out;
  p.ws = (char*)d_ws;
  if (WO_END > ws_size) { fprintf(stderr, "workspace too small: need %zu have %zu\n", (size_t)WO_END, ws_size); return; }
  (void)hipMemsetAsync(p.ws + WO_BAR, 0, (size_t)(XCD_BAR_WORDS + 2048) * 4, stream);
  int ph0 = 0, ph1 = N_PHASES;
  void* args[] = { &p, &ph0, &ph1 };
  hipError_t e = hipLaunchCooperativeKernel((void*)mega, dim3(grid_blocks), dim3(NTHR), args, 0, stream);
  if (e != hipSuccess) fprintf(stderr, "cooperative launch failed: %s (grid %d)\n", hipGetErrorString(e), grid_blocks);
}
```
